# Optimizing an MI355X kernel written in HIP

```python
import math
import jax, jax.numpy as jnp
from jax import lax
import numpy as np

D_MODEL = 1024
BATCH = 16
SEQ = 2048
DEPTH = 2

MIX_WIDTH = 384
N_BRANCH = 3
S5_GROUP = 16
S5_GROUPS = MIX_WIDTH // S5_GROUP
S5_STATE = 64
S5_DT_MIN = 1e-3
S5_DT_MAX = 1e-1
SB_HEAD_DIM = 64
SB_HEADS = MIX_WIDTH // SB_HEAD_DIM
Q_BLOCK = 128
LRU_BLOCKS = 6
LRU_BLOCK = MIX_WIDTH // LRU_BLOCKS
CONV_WIDTH = 4
LRU_C = 8.0
IN_WIDTH = 6 * MIX_WIDTH + N_BRANCH * D_MODEL
SPLITS = [MIX_WIDTH * i for i in range(1, 7)]
D_FF = 2816
N_EXPERTS = 8
TOP_K = 2
D_FF_EXPERT = 3584
N_DENSE = (DEPTH + 1) // 2
N_MOE = DEPTH // 2
RMS_EPS = 1e-6

kernel_name = 'hybrid_s5_stickbreak_rglru_moe'


def rms_norm(x, g):
    xf = x.astype(jnp.float32)
    y = xf * lax.rsqrt(jnp.mean(xf * xf, axis=-1, keepdims=True) + RMS_EPS)
    return (y * g.astype(jnp.float32)).astype(x.dtype)


def _cmul(ar, ai, br, bi):
    return ar * br - ai * bi, ar * bi + ai * br


def s5_mixer(u, lam_re, lam_im, log_dt, b_re, b_im, c_re, c_im, d, w_glu, b_glu):
    Bsz, T, W = u.shape
    f32 = jnp.float32
    lam_re = lam_re.astype(f32)
    lam_im = lam_im.astype(f32)
    dt = jnp.exp(log_dt.astype(f32))[:, None]
    ea = jnp.exp(lam_re * dt)
    abar_re = ea * jnp.cos(lam_im * dt)
    abar_im = ea * jnp.sin(lam_im * dt)
    den = lam_re * lam_re + lam_im * lam_im
    nr = abar_re - 1.0
    coef_re = (nr * lam_re + abar_im * lam_im) / den
    coef_im = (abar_im * lam_re - nr * lam_im) / den
    bbar_re, bbar_im = _cmul(coef_re[..., None], coef_im[..., None],
                             b_re.astype(f32), b_im.astype(f32))
    ug = u.astype(f32).reshape(Bsz, T, S5_GROUPS, S5_GROUP)
    bu_re = jnp.einsum('btgh,gph->btgp', ug, bbar_re)
    bu_im = jnp.einsum('btgh,gph->btgp', ug, bbar_im)
    a_re = jnp.broadcast_to(abar_re, bu_re.shape)
    a_im = jnp.broadcast_to(abar_im, bu_im.shape)

    def combine(e1, e2):
        a1r, a1i, b1r, b1i = e1
        a2r, a2i, b2r, b2i = e2
        ar, ai = _cmul(a2r, a2i, a1r, a1i)
        br, bi = _cmul(a2r, a2i, b1r, b1i)
        return ar, ai, br + b2r, bi + b2i

    _, _, s_re, s_im = lax.associative_scan(combine, (a_re, a_im, bu_re, bu_im), axis=1)
    y = (jnp.einsum('btgp,ghp->btgh', s_re, c_re.astype(f32))
         - jnp.einsum('btgp,ghp->btgh', s_im, c_im.astype(f32)))
    y = y.reshape(Bsz, T, W) + d.astype(f32) * u.astype(f32)
    y = jax.nn.gelu(y).astype(u.dtype)
    return y * jax.nn.sigmoid(y @ w_glu + b_glu)


def stick_breaking_attention(q, k, v):
    Bsz, T, H, Dh = q.shape
    nb = T // Q_BLOCK
    scale = Dh ** -0.5
    qb = q.reshape(Bsz, nb, Q_BLOCK, H, Dh).transpose(1, 0, 2, 3, 4)
    key_pos = jnp.arange(T)

    def block(args):
        qi, i = args
        z = jnp.einsum('bqhd,bkhd->bhqk', qi, k).astype(jnp.float32) * scale
        q_pos = i * Q_BLOCK + jnp.arange(Q_BLOCK)
        causal = key_pos[None, :] < q_pos[:, None]
        log_beta = jax.nn.log_sigmoid(z)
        log_1m = jnp.where(causal, jax.nn.log_sigmoid(-z), 0.0)
        rest = lax.cumsum(log_1m, axis=3, reverse=True) - log_1m
        w = jnp.where(causal, jnp.exp(log_beta + rest), 0.0)
        return jnp.einsum('bhqk,bkhd->bqhd', w.astype(v.dtype), v)

    out = lax.map(block, (qb, jnp.arange(nb)))
    return out.transpose(1, 0, 2, 3, 4).reshape(Bsz, T, H * Dh)


def rglru_branch(xb, yb, conv_w, conv_b, w_a, b_a, w_x, b_x, lam):
    Bsz, T, W = xb.shape
    xc = lax.conv_general_dilated(xb, conv_w[:, None, :], window_strides=(1,),
                                  padding=[(CONV_WIDTH - 1, 0)],
                                  dimension_numbers=('NWC', 'WIO', 'NWC'),
                                  feature_group_count=W) + conv_b
    xh = xc.reshape(Bsz, T, LRU_BLOCKS, LRU_BLOCK)
    r = jax.nn.sigmoid(jnp.einsum('bthi,hij->bthj', xh, w_a).reshape(Bsz, T, W) + b_a)
    ig = jax.nn.sigmoid(jnp.einsum('bthi,hij->bthj', xh, w_x).reshape(Bsz, T, W) + b_x)
    log_a = LRU_C * r.astype(jnp.float32) * jax.nn.log_sigmoid(lam.astype(jnp.float32))
    a = jnp.exp(log_a)
    b = jnp.sqrt(-jnp.expm1(2.0 * log_a)) * (ig * xc).astype(jnp.float32)

    def combine(e1, e2):
        a1, b1 = e1
        a2, b2 = e2
        return a1 * a2, a2 * b1 + b2

    _, h = lax.associative_scan(combine, (a, b), axis=1)
    return h.astype(xb.dtype) * jax.nn.gelu(yb)


def swiglu(h, w_gate, w_up, w_down):
    return (jax.nn.silu(h @ w_gate) * (h @ w_up)) @ w_down


def moe_swiglu(h, router_w, router_b, w_gate, w_up, w_down):
    Bsz, T, D = h.shape
    hf = h.reshape(-1, D)
    logits = (hf @ router_w).astype(jnp.float32) + router_b.astype(jnp.float32)
    top_vals, top_idx = lax.top_k(logits, TOP_K)
    top_w = jax.nn.softmax(top_vals, axis=-1)
    comb = jnp.sum(jax.nn.one_hot(top_idx, N_EXPERTS, dtype=jnp.float32) * top_w[..., None],
                   axis=1).astype(h.dtype)
    out = jnp.zeros_like(hf)
    for e in range(N_EXPERTS):
        out = out + comb[:, e:e + 1] * swiglu(hf, w_gate[e], w_up[e], w_down[e])
    return out.reshape(Bsz, T, D)


def setup_inputs(seed: int = 0) -> dict:
    key = jax.random.key(seed)
    ks = iter(jax.random.split(key, 40))
    f32 = jnp.float32

    def nrm(shape, scale):
        return jax.random.normal(next(ks), shape, f32) * scale

    W, G, P, H = MIX_WIDTH, S5_GROUPS, S5_STATE, S5_GROUP
    a8 = jax.random.uniform(next(ks), (DEPTH, W), f32, 0.9, 0.999)
    a_lru = a8 ** (1.0 / LRU_C)
    return {
        'x': nrm((BATCH, SEQ, D_MODEL), 1.0),
        'mix_norm_g': 1.0 + nrm((DEPTH, D_MODEL), 0.02),
        'w_in': nrm((DEPTH, D_MODEL, IN_WIDTH), D_MODEL ** -0.5),
        'gate_b': nrm((DEPTH, N_BRANCH * D_MODEL), 0.02),
        's5_lambda_re': -0.5 + nrm((DEPTH, G, P), 0.01),
        's5_lambda_im': jnp.pi * jnp.arange(P, dtype=f32) + nrm((DEPTH, G, P), 0.01),
        's5_log_dt': jax.random.uniform(next(ks), (DEPTH, G), f32,
                                        math.log(S5_DT_MIN), math.log(S5_DT_MAX)),
        's5_b_re': nrm((DEPTH, G, P, H), (2.0 * H) ** -0.5),
        's5_b_im': nrm((DEPTH, G, P, H), (2.0 * H) ** -0.5),
        's5_c_re': nrm((DEPTH, G, H, P), P ** -0.5),
        's5_c_im': nrm((DEPTH, G, H, P), P ** -0.5),
        's5_d': nrm((DEPTH, W), 1.0),
        's5_w_glu': nrm((DEPTH, W, W), W ** -0.5),
        's5_b_glu': nrm((DEPTH, W), 0.02),
        'conv_w': nrm((DEPTH, CONV_WIDTH, W), CONV_WIDTH ** -0.5),
        'conv_b': nrm((DEPTH, W), 0.02),
        'lru_w_a': nrm((DEPTH, LRU_BLOCKS, LRU_BLOCK, LRU_BLOCK), LRU_BLOCK ** -0.5),
        'lru_b_a': nrm((DEPTH, W), 0.02),
        'lru_w_x': nrm((DEPTH, LRU_BLOCKS, LRU_BLOCK, LRU_BLOCK), LRU_BLOCK ** -0.5),
        'lru_b_x': nrm((DEPTH, W), 0.02),
        'lru_lambda': jnp.log(a_lru) - jnp.log1p(-a_lru),
        'w_branch': nrm((DEPTH, N_BRANCH, W, D_MODEL), W ** -0.5),
        'w_out': nrm((DEPTH, D_MODEL, D_MODEL), D_MODEL ** -0.5),
        'ffn_norm_g': 1.0 + nrm((DEPTH, D_MODEL), 0.02),
        'ffn_w_gate': nrm((N_DENSE, D_MODEL, D_FF), D_MODEL ** -0.5),
        'ffn_w_up': nrm((N_DENSE, D_MODEL, D_FF), D_MODEL ** -0.5),
        'ffn_w_down': nrm((N_DENSE, D_FF, D_MODEL), D_FF ** -0.5),
        'router_w': nrm((N_MOE, D_MODEL, N_EXPERTS), D_MODEL ** -0.5),
        'router_b': nrm((N_MOE, N_EXPERTS), 0.01),
        'moe_w_gate': nrm((N_MOE, N_EXPERTS, D_MODEL, D_FF_EXPERT), D_MODEL ** -0.5),
        'moe_w_up': nrm((N_MOE, N_EXPERTS, D_MODEL, D_FF_EXPERT), D_MODEL ** -0.5),
        'moe_w_down': nrm((N_MOE, N_EXPERTS, D_FF_EXPERT, D_MODEL), D_FF_EXPERT ** -0.5),
        'final_norm_g': 1.0 + nrm((D_MODEL,), 0.02),
    }


def reference(x, mix_norm_g, w_in, gate_b, s5_lambda_re, s5_lambda_im, s5_log_dt,
              s5_b_re, s5_b_im, s5_c_re, s5_c_im, s5_d, s5_w_glu, s5_b_glu,
              conv_w, conv_b, lru_w_a, lru_b_a, lru_w_x, lru_b_x, lru_lambda,
              w_branch, w_out, ffn_norm_g, ffn_w_gate, ffn_w_up, ffn_w_down,
              router_w, router_b, moe_w_gate, moe_w_up, moe_w_down, final_norm_g):
    Bsz, T, _ = x.shape
    for layer in range(DEPTH):
        h = rms_norm(x, mix_norm_g[layer])
        proj = h @ w_in[layer]
        u_s5, q, k, v, x_lru, y_lru, g = jnp.split(proj, SPLITS, axis=-1)
        a_out = s5_mixer(u_s5, s5_lambda_re[layer], s5_lambda_im[layer], s5_log_dt[layer],
                         s5_b_re[layer], s5_b_im[layer], s5_c_re[layer], s5_c_im[layer],
                         s5_d[layer], s5_w_glu[layer], s5_b_glu[layer])
        hs = (Bsz, T, SB_HEADS, SB_HEAD_DIM)
        b_out = stick_breaking_attention(q.reshape(hs), k.reshape(hs), v.reshape(hs))
        c_out = rglru_branch(x_lru, y_lru, conv_w[layer], conv_b[layer], lru_w_a[layer],
                             lru_b_a[layer], lru_w_x[layer], lru_b_x[layer], lru_lambda[layer])
        branches = jnp.stack([a_out, b_out, c_out], axis=2)
        br_d = jnp.einsum('btnw,nwd->btnd', branches, w_branch[layer])
        gates = jax.nn.sigmoid(g + gate_b[layer]).reshape(Bsz, T, N_BRANCH, D_MODEL)
        merged = jnp.sum(gates * br_d, axis=2)
        x = x + merged @ w_out[layer]
        h = rms_norm(x, ffn_norm_g[layer])
        if layer % 2 == 0:
            j = layer // 2
            x = x + swiglu(h, ffn_w_gate[j], ffn_w_up[j], ffn_w_down[j])
        else:
            j = layer // 2
            x = x + moe_swiglu(h, router_w[j], router_b[j], moe_w_gate[j],
                               moe_w_up[j], moe_w_down[j])
    return rms_norm(x, final_norm_g)
```

```cpp
#include <hip/hip_runtime.h>
#include <cstdio>
#include <cstdint>
namespace pg8 {
#define PG8_LAS __attribute__((address_space(3)))
typedef unsigned short bf16_t;
typedef short bf16x8 __attribute__((ext_vector_type(8)));
typedef float f32x4 __attribute__((ext_vector_type(4)));
typedef unsigned u32x4 __attribute__((ext_vector_type(4)));
constexpr int BM = 256, BK = 64, HALF = 128, HTB = HALF * BK * 2  , STAGE_BYTES = 8 * HTB, NXCD = 8, WGM = 8;

__host__ __device__ __forceinline__ int lds_byte(int r, int c) { const int st = (r >> 4) * 2 + (c >> 5), rr = r & 15, cc = c & 31, ob = rr * 64 + cc * 2; return st * 1024 + (ob ^ (((ob >> 9) & 1) << 5)); }
__host__ __device__ __forceinline__ void stage_rc(int b, int& R, int& C) { const int st = b / 1024, sb = b % 1024, swz = sb ^ (((sb >> 9) & 1) << 5); R = (st >> 1) * 16 + swz / 64; C = (st & 1) * 32 + (swz % 64) / 2; }
__host__ __device__ __forceinline__ int perm32(int rho) { const int n = rho >> 4, i = rho & 15; return 8 * (i >> 2) + 4 * n + (i & 3); }

struct Unit { int pm, pn; };
struct Gemm { const bf16_t* A; const bf16_t* Bt; int M, N, K; };

struct StaticOrder {
    int nM, nN, nwg, G, c;
    __host__ __device__ void init(int M, int N, int G_, int c_) { nM = M / BM; nN = N / BM; nwg = nM * nN; G = G_; c = c_; }
    __host__ __device__ bool next(int i, Unit& u) const {
        const long L = (long)i * G + c; if (L >= nwg) return false;
        int wgid = (int)L; { const int q = nwg / NXCD, r = nwg % NXCD, xcd = wgid % NXCD, off = wgid / NXCD; wgid = (xcd < r ? xcd * (q + 1) : r * (q + 1) + (xcd - r) * q) + off; }
        const int nig = WGM * nN, gid = wgid / nig, fm = gid * WGM, gsz = (nM - fm) < WGM ? (nM - fm) : WGM;
        u.pm = fm + ((wgid % nig) % gsz); u.pn = (wgid % nig) / gsz; return true;
    }
    __device__ __forceinline__ void a_ready(const Unit&) const {}
    __device__ __forceinline__ void done(const Unit&) const {}
};

__device__ __forceinline__ unsigned cvt_pk_bf16(float lo, float hi) { unsigned r; asm volatile("v_cvt_pk_bf16_f32 %0, %1, %2" : "=v"(r) : "v"(lo), "v"(hi)); return r; }
typedef float f32x2 __attribute__((ext_vector_type(2)));
__device__ __forceinline__ f32x2 gelu_pk(f32x2 v) {
    const f32x2 av = __builtin_elementwise_abs(v), d = av * 0.2316418882f + 1.0f;
    f32x2 t; t.x = __builtin_amdgcn_rcpf(d.x); t.y = __builtin_amdgcn_rcpf(d.y);
    f32x2 q = t * 0.5307027145f + (-0.7265760135f); q = q * t + 0.7107068705f; q = q * t + (-0.142248368f); q = q * t + 0.127414796f; q = q * t;
    const f32x2 s = (v * v) * (-0.72134752044f);
    f32x2 e; e.x = __builtin_amdgcn_exp2f(s.x); e.y = __builtin_amdgcn_exp2f(s.y);
    const f32x2 m = v * (q * e), r = v - m;
    f32x2 o; o.x = v.x < 0.f ? m.x : r.x; o.y = v.y < 0.f ? m.y : r.y; return o;
}

template <int ACT  > struct EpiBf16 {
    static constexpr bool PERM = true, AFTER_DRAIN = false; static_assert(ACT == 0 || ACT == 1, "EpiBf16: ACT is 0 (none) or 1 (gelu_pk)");
    bf16_t* O; int ldc; const float* bias; int split_cols; size_t split_stride; float scale0;
    __device__ __forceinline__ void operator()(const f32x4 (&acc)[2][2][4][2], const Unit& u, int wr, int wc, int fr, int fq) const {
        const int row0 = u.pm * BM + wr * 64 + fr; int colt = u.pn * BM; bf16_t* base = O;
        float sc = 1.f; if (split_cols) { const int t = colt / split_cols; base += (size_t)t * split_stride; colt -= t * split_cols; if (t == 0) sc = scale0; }
        const int col0 = colt + wc * 32 + 8 * fq, bcol0 = u.pn * BM + wc * 32 + 8 * fq;
        f32x4 bv[2][2];
#pragma unroll
        for (int bj = 0; bj < 2; ++bj)
#pragma unroll
            for (int n = 0; n < 2; ++n) bv[bj][n] = bias ? *(const f32x4*)(bias + bcol0 + bj * HALF + 4 * n) : (f32x4){0.f, 0.f, 0.f, 0.f};
#pragma unroll
        for (int ai = 0; ai < 2; ++ai)
#pragma unroll
            for (int m = 0; m < 4; ++m) { bf16_t* rowp = base + (size_t)(row0 + ai * HALF + m * 16) * ldc + col0;
#pragma unroll
                for (int bj = 0; bj < 2; ++bj) { f32x4 v0 = acc[ai][bj][m][0] + bv[bj][0], v1 = acc[ai][bj][m][1] + bv[bj][1];
                    if (ACT == 1) { f32x2 a = gelu_pk((f32x2){v0[0], v0[1]}), b = gelu_pk((f32x2){v0[2], v0[3]}), c = gelu_pk((f32x2){v1[0], v1[1]}), d = gelu_pk((f32x2){v1[2], v1[3]});
                        v0 = (f32x4){a.x, a.y, b.x, b.y}; v1 = (f32x4){c.x, c.y, d.x, d.y}; }
                    v0 = v0 * sc; v1 = v1 * sc; u32x4 w; w.x = cvt_pk_bf16(v0[0], v0[1]); w.y = cvt_pk_bf16(v0[2], v0[3]); w.z = cvt_pk_bf16(v1[0], v1[1]); w.w = cvt_pk_bf16(v1[2], v1[3]);
                    *(u32x4*)(rowp + bj * HALF) = w; } }
    }
};
constexpr int NTOK = 32768;
__device__ __forceinline__ float sigm(float x) { return __builtin_amdgcn_rcpf(1.0f + __expf(-x)); }
__device__ __forceinline__ float bf_lo(unsigned u) { return __uint_as_float(u << 16); }
__device__ __forceinline__ float bf_hi(unsigned u) { return __uint_as_float(u & 0xffff0000u); }
typedef __bf16 bf16x2c __attribute__((ext_vector_type(2)));
__device__ __forceinline__ unsigned cvt2(float lo, float hi) { const f32x2 v = {lo, hi}; return __builtin_bit_cast(unsigned, __builtin_convertvector(v, bf16x2c)); }
__device__ __forceinline__ u32x4 pack8(const f32x4& v0, const f32x4& v1) { u32x4 w; w.x = cvt2(v0[0], v0[1]); w.y = cvt2(v0[2], v0[3]); w.z = cvt2(v1[0], v1[1]); w.w = cvt2(v1[2], v1[3]); return w; }
__device__ __forceinline__ void unpack8(const u32x4& w, f32x4& v0, f32x4& v1) { v0 = (f32x4){bf_lo(w.x), bf_hi(w.x), bf_lo(w.y), bf_hi(w.y)}; v1 = (f32x4){bf_lo(w.z), bf_hi(w.z), bf_lo(w.w), bf_hi(w.w)}; }

#ifndef MK_SIG
#define MK_SIG sigm
#endif
struct EpiInProj {
    static constexpr bool PERM = true, AFTER_DRAIN = false;
    bf16_t* P6; bf16_t* G; const float* gate_b;
    __device__ __forceinline__ void operator()(const f32x4 (&acc)[2][2][4][2], const Unit& u, int wr, int wc, int fr, int fq) const {
        const int row0 = u.pm * BM + wr * 64 + fr;
        if (u.pn < 9) {
#pragma unroll
            for (int bj = 0; bj < 2; ++bj) {
                const int c = u.pn * BM + bj * HALF + wc * 32 + 8 * fq;
                const int blk = c / 384, off = c - blk * 384, dblk = (0x254310 >> (4 * blk)) & 0xf;
                bf16_t* base = P6 + (size_t)dblk * ((size_t)NTOK * 384) + off;
#pragma unroll
                for (int ai = 0; ai < 2; ++ai)
#pragma unroll
                    for (int m = 0; m < 4; ++m) { const int row = row0 + ai * HALF + m * 16; *(u32x4*)(base + (size_t)row * 384) = pack8(acc[ai][bj][m][0], acc[ai][bj][m][1]); }
            }
        } else {
#pragma unroll
            for (int bj = 0; bj < 2; ++bj) {
                const int cg = u.pn * BM + bj * HALF + wc * 32 + 8 * fq - 2304;
                const f32x4 b0 = *(const f32x4*)(gate_b + cg), b1 = *(const f32x4*)(gate_b + cg + 4);
#pragma unroll
                for (int ai = 0; ai < 2; ++ai)
#pragma unroll
                    for (int m = 0; m < 4; ++m) { const int row = row0 + ai * HALF + m * 16; f32x4 v0 = acc[ai][bj][m][0] + b0, v1 = acc[ai][bj][m][1] + b1;
#pragma unroll
                        for (int j = 0; j < 4; ++j) { v0[j] = MK_SIG(v0[j]); v1[j] = MK_SIG(v1[j]); }
                        *(u32x4*)(G + (size_t)row * 3072 + cg) = pack8(v0, v1); }
            }
        }
    }
};
struct EpiGlu {
    static constexpr bool PERM = true, AFTER_DRAIN = false;
    const bf16_t* Y5; bf16_t* OUT; const float* b_glu;
    __device__ __forceinline__ void operator()(const f32x4 (&acc)[2][2][4][2], const Unit& u, int wr, int wc, int fr, int fq) const {
        const int row0 = u.pm * BM + wr * 64 + fr;
#pragma unroll
        for (int bj = 0; bj < 2; ++bj) {
            const int c = u.pn * BM + bj * HALF + wc * 32 + 8 * fq;
            if (c < 384) {
                const f32x4 b0 = *(const f32x4*)(b_glu + c), b1 = *(const f32x4*)(b_glu + c + 4);
#pragma unroll
                for (int ai = 0; ai < 2; ++ai)
#pragma unroll
                    for (int m = 0; m < 4; ++m) { const int row = row0 + ai * HALF + m * 16; f32x4 v0 = acc[ai][bj][m][0] + b0, v1 = acc[ai][bj][m][1] + b1, y0, y1;
                        unpack8(*(const u32x4*)(Y5 + (size_t)row * 384 + c), y0, y1);
#pragma unroll
                        for (int j = 0; j < 4; ++j) { v0[j] = y0[j] * sigm(v0[j]); v1[j] = y1[j] * sigm(v1[j]); }
                        *(u32x4*)(OUT + (size_t)row * 384 + c) = pack8(v0, v1); asm volatile("" ::: "memory"); }
            }
        }
    }
};
struct EpiMerged {
    static constexpr bool PERM = true, AFTER_DRAIN = false;
    const bf16_t* G; bf16_t* MG;
    __device__ __forceinline__ void operator()(const f32x4 (&acc)[2][2][4][2], const Unit& u, int wr, int wc, int fr, int fq) const {
        const int n = u.pm >> 7, pm = u.pm & 127, pn = u.pn & 3;
        const int row0 = pm * BM + wr * 64 + fr;
#pragma unroll
        for (int bj = 0; bj < 2; ++bj) {
            const int c = pn * BM + bj * HALF + wc * 32 + 8 * fq;
#pragma unroll
            for (int ai = 0; ai < 2; ++ai)
#pragma unroll
                for (int m = 0; m < 4; ++m) { const int row = row0 + ai * HALF + m * 16; f32x4 g0, g1;
                    unpack8(*(const u32x4*)(G + (size_t)row * 3072 + n * 1024 + c), g0, g1);
                    f32x4 v0 = g0 * acc[ai][bj][m][0], v1 = g1 * acc[ai][bj][m][1];
                    if (n > 0) { f32x4 p0, p1; unpack8(*(const u32x4*)(MG + (size_t)row * 1024 + c), p0, p1); v0 += p0; v1 += p1; }
                    *(u32x4*)(MG + (size_t)row * 1024 + c) = pack8(v0, v1); asm volatile("" ::: "memory"); }
        }
    }
};
struct EpiResid {
    static constexpr bool PERM = false, AFTER_DRAIN = false;
    const float* base; float* out;
    __device__ __forceinline__ void operator()(const f32x4 (&acc)[2][2][4][2], const Unit& u, int wr, int wc, int fr, int fq) const {
        const int row0 = u.pm * BM + wr * 64 + fr, col0 = u.pn * BM + wc * 32 + 4 * fq;
#pragma unroll
        for (int ai = 0; ai < 2; ++ai)
#pragma unroll
            for (int m = 0; m < 4; ++m) { const size_t off = (size_t)(row0 + ai * HALF + m * 16) * 1024 + col0;
#pragma unroll
                for (int bj = 0; bj < 2; ++bj)
#pragma unroll
                    for (int n = 0; n < 2; ++n) { const f32x4 bs = *(const f32x4*)(base + off + bj * HALF + n * 16); *(f32x4*)(out + off + bj * HALF + n * 16) = bs + acc[ai][bj][m][n]; } asm volatile("" ::: "memory"); }
    }
};
struct EpiSwiglu {
    static constexpr bool PERM = true, AFTER_DRAIN = false;
    bf16_t* ACT; int ld; int nct;
    __device__ __forceinline__ void operator()(const f32x4 (&acc)[2][2][4][2], const Unit& u, int wr, int wc, int fr, int fq) const {
        const int row0 = u.pm * BM + wr * 64 + fr, c = (u.pn % nct) * HALF + wc * 32 + 8 * fq;
#pragma unroll
        for (int ai = 0; ai < 2; ++ai)
#pragma unroll
            for (int m = 0; m < 4; ++m) { const int row = row0 + ai * HALF + m * 16; f32x4 v0, v1;
#pragma unroll
                for (int j = 0; j < 4; ++j) { const float g0 = acc[ai][0][m][0][j], g1 = acc[ai][0][m][1][j]; v0[j] = g0 * sigm(g0) * acc[ai][1][m][0][j]; v1[j] = g1 * sigm(g1) * acc[ai][1][m][1][j]; }
                *(u32x4*)(ACT + (size_t)row * ld + c) = pack8(v0, v1); }
    }
};
struct EpiMoeDown {
    static constexpr bool PERM = false, AFTER_DRAIN = false;
    float* X; const int* tok; const float* wt;
    __device__ __forceinline__ void operator()(const f32x4 (&acc)[2][2][4][2], const Unit& u, int wr, int wc, int fr, int fq) const {
        const int slot0 = u.pm * BM + wr * 64 + fr, col0 = (u.pn & 3) * BM + wc * 32 + 4 * fq;
#pragma unroll
        for (int ai = 0; ai < 2; ++ai)
#pragma unroll
            for (int m = 0; m < 4; ++m) { const int slot = slot0 + ai * HALF + m * 16; const int t = tok[slot];
                if (t >= 0) { const float w = wt[slot]; float* rowp = X + (size_t)t * 1024 + col0;
#pragma unroll
                    for (int bj = 0; bj < 2; ++bj)
#pragma unroll
                        for (int n = 0; n < 2; ++n) { const f32x4 bs = *(const f32x4*)(rowp + bj * HALF + n * 16); *(f32x4*)(rowp + bj * HALF + n * 16) = bs + w * acc[ai][bj][m][n]; } } asm volatile("" ::: "memory"); }
    }
};
struct MergedOrder {
    StaticOrder so;
    __device__ bool next(int i, Unit& u) const { Unit t; if (!so.next(i / 3, t)) return false; const int n = i % 3; u.pm = n * 128 + t.pm; u.pn = n * 4 + t.pn; return true; }
    __device__ __forceinline__ void a_ready(const Unit&) const {}
    __device__ __forceinline__ void done(const Unit&) const {}
};
struct MoeOrder {
    StaticOrder so; const PG8_LAS int* tileExp;
    __device__ bool next(int i, Unit& u) const { Unit t; if (!so.next(i, t)) return false; u.pm = t.pm; u.pn = tileExp[t.pm] * so.nN + t.pn; return true; }
    __device__ __forceinline__ void a_ready(const Unit&) const {}
    __device__ __forceinline__ void done(const Unit&) const {}
};
template <class Epi, class Sched, bool ALIGN_EPI = false, bool SP2 = false>
__device__ __forceinline__ void gemm_phase(PG8_LAS unsigned char* lds, const Gemm g, const Sched& S, const Epi& E) {
    int tid_l = threadIdx.x; asm volatile("" : "+v"(tid_l));
    const int tid = tid_l, wid = __builtin_amdgcn_readfirstlane(tid >> 6), lane = tid & 63, wr = wid >> 2, wc = wid & 3, fr = lane & 15, fq = lane >> 4;
    int K_l = g.K; asm volatile("" : "+s"(K_l));
    const int K = K_l, nt = K / BK;
    unsigned voffA[2], voffB[2];
#pragma unroll
    for (int i = 0; i < 2; ++i) { int R, C; stage_rc(tid * 16 + i * 8192, R, C); const int Rb = Epi::PERM ? ((R & ~31) + perm32(R & 31)) : R;
        voffA[i] = (unsigned)(R * K + C) * 2u; voffB[i] = (unsigned)(Rb * K + C) * 2u; }
    const size_t kstep = (size_t)(BK * 2);
    const size_t hstep = (size_t)HALF * K * 2;
    const size_t tstep = 2 * hstep;
    const unsigned ldsw = (unsigned)wid * 1024u;
    const int aoff = lds_byte(wr * 64 + fr, fq * 8), boff = lds_byte(wc * 32 + fr, fq * 8);
#define PG8_SA(b, h) (((b) * 2 + (h)) * HTB)
#define PG8_SB(b, h) ((4 + (b) * 2 + (h)) * HTB)
#define PG8_STAGE(bufoff, gbase, voff) do { _Pragma("unroll") for (int _i = 0; _i < 2; ++_i) \
        __builtin_amdgcn_global_load_lds((const unsigned*)((const char*)(gbase) + (voff)[_i]), (PG8_LAS unsigned*)(lds + (bufoff) + ldsw + _i * 8192), 16, 0, 0); } while (0)
#define PG8_LDA(dst, b, h) do { _Pragma("unroll") for (int m = 0; m < 4; ++m) _Pragma("unroll") for (int k = 0; k < 2; ++k) dst[m][k] = *(const PG8_LAS bf16x8*)(lds + PG8_SA(b, h) + aoff + m * 2048 + k * 1024); } while (0)
#define PG8_LDB(dst, b, h) do { _Pragma("unroll") for (int n = 0; n < 2; ++n) _Pragma("unroll") for (int k = 0; k < 2; ++k) dst[n][k] = *(const PG8_LAS bf16x8*)(lds + PG8_SB(b, h) + boff + n * 2048 + k * 1024); } while (0)
#define PG8_MMA(ai, bj, At, Bt) do { __builtin_amdgcn_s_setprio(1); _Pragma("unroll") for (int m = 0; m < 4; ++m) _Pragma("unroll") for (int n = 0; n < 2; ++n) _Pragma("unroll") for (int k = 0; k < 2; ++k) \
        acc[ai][bj][m][n] = __builtin_amdgcn_mfma_f32_16x16x32_bf16(Bt[n][k], At[m][k], acc[ai][bj][m][n], 0, 0, 0); __builtin_amdgcn_s_setprio(0); } while (0)
#define PG8_WAIT_V(n) asm volatile("s_waitcnt vmcnt(" #n ")" ::: "memory")
#define PG8_WAIT_L(n) asm volatile("s_waitcnt lgkmcnt(" #n ")" ::: "memory")
#define PG8_BAR __builtin_amdgcn_s_barrier()
#define PG8_SCHED __builtin_amdgcn_sched_barrier(0)
    Unit cur, nxt; int ui = 0;
    if (!S.next(0, cur)) return;
    f32x4 acc[2][2][4][2];
#pragma unroll
    for (int a = 0; a < 2; ++a)
#pragma unroll
        for (int b = 0; b < 2; ++b)
#pragma unroll
            for (int m = 0; m < 4; ++m)
#pragma unroll
                for (int n = 0; n < 2; ++n) acc[a][b][m][n] = (f32x4){0.f, 0.f, 0.f, 0.f};
    bf16x8 At[4][2], B0[2][2], B1[2][2];
    const char* cA = (const char*)g.A + (size_t)cur.pm * tstep; const char* cB = (const char*)g.Bt + (size_t)cur.pn * tstep;
    S.a_ready(cur);
    if constexpr (SP2) {
        PG8_STAGE(PG8_SB(0, 0), cB, voffB); PG8_STAGE(PG8_SB(0, 1), cB + hstep, voffB); PG8_STAGE(PG8_SA(0, 0), cA, voffA); PG8_STAGE(PG8_SA(0, 1), cA + hstep, voffA);
        if (wr == 1) PG8_BAR;
        PG8_WAIT_V(2); PG8_BAR;
        PG8_STAGE(PG8_SB(1, 0), cB + kstep, voffB); PG8_STAGE(PG8_SA(1, 0), cA + kstep, voffA); PG8_STAGE(PG8_SB(1, 1), cB + hstep + kstep, voffB);
        PG8_WAIT_V(6); PG8_BAR;
    } else {
        PG8_STAGE(PG8_SB(0, 0), cB, voffB); PG8_STAGE(PG8_SA(0, 0), cA, voffA); PG8_STAGE(PG8_SB(0, 1), cB + hstep, voffB); PG8_STAGE(PG8_SA(0, 1), cA + hstep, voffA);
        if (wr == 1) PG8_BAR;
        PG8_WAIT_V(4); PG8_BAR;
        PG8_STAGE(PG8_SB(1, 0), cB + kstep, voffB); PG8_STAGE(PG8_SA(1, 0), cA + kstep, voffA); PG8_STAGE(PG8_SB(1, 1), cB + hstep + kstep, voffB);
        PG8_WAIT_V(6); PG8_BAR;
    }
    for (;;) {
        const bool has_next = S.next(ui + 1, nxt);
        const char* nA = has_next ? (const char*)g.A + (size_t)nxt.pm * tstep : cA; const char* nB = has_next ? (const char*)g.Bt + (size_t)nxt.pn * tstep : cB;
        for (int t = 0; t < nt; t += 2) {
            const bool last = (t == nt - 2);
            const char* a1 = cA + (size_t)(t + 1) * kstep;
            const char* a2 = last ? nA : cA + (size_t)(t + 2) * kstep; const char* b2 = last ? nB : cB + (size_t)(t + 2) * kstep;
            const char* a3 = a2 + kstep; const char* b3 = b2 + kstep;
            if (last && has_next) S.a_ready(nxt);
            if constexpr (SP2) {
            PG8_LDB(B0, 0, 0); PG8_LDB(B1, 0, 1); PG8_SCHED; PG8_LDA(At, 0, 0); PG8_STAGE(PG8_SA(1, 1), a1 + hstep, voffA);
            PG8_WAIT_V(8); PG8_WAIT_L(0); PG8_BAR; PG8_MMA(0, 0, At, B0); PG8_MMA(0, 1, At, B1); PG8_BAR; PG8_SCHED;
            PG8_LDA(At, 0, 1); PG8_STAGE(PG8_SB(0, 0), b2, voffB); PG8_STAGE(PG8_SB(0, 1), b2 + hstep, voffB); PG8_STAGE(PG8_SA(0, 0), a2, voffA);
            PG8_WAIT_V(8); PG8_WAIT_L(0); PG8_BAR; PG8_MMA(1, 0, At, B0); PG8_MMA(1, 1, At, B1); PG8_BAR; PG8_SCHED;
            PG8_LDB(B0, 1, 0); PG8_LDB(B1, 1, 1); PG8_SCHED; PG8_LDA(At, 1, 0); PG8_STAGE(PG8_SA(0, 1), a2 + hstep, voffA);
            PG8_WAIT_V(8); PG8_WAIT_L(0); PG8_BAR; PG8_MMA(0, 0, At, B0); PG8_MMA(0, 1, At, B1); PG8_BAR; PG8_SCHED;
            PG8_LDA(At, 1, 1); PG8_STAGE(PG8_SB(1, 0), b3, voffB); PG8_STAGE(PG8_SB(1, 1), b3 + hstep, voffB); PG8_STAGE(PG8_SA(1, 0), a3, voffA);
            PG8_WAIT_V(8); PG8_WAIT_L(0); PG8_BAR; PG8_MMA(1, 0, At, B0); PG8_MMA(1, 1, At, B1); PG8_BAR; PG8_SCHED;
            } else {
            PG8_LDB(B0, 0, 0); PG8_SCHED; PG8_LDA(At, 0, 0); PG8_STAGE(PG8_SA(1, 1), a1 + hstep, voffA);
            PG8_WAIT_L(8); PG8_BAR; PG8_WAIT_L(0); PG8_MMA(0, 0, At, B0); PG8_BAR; PG8_SCHED;
            PG8_LDB(B1, 0, 1); PG8_STAGE(PG8_SB(0, 0), b2, voffB);
            PG8_BAR; PG8_WAIT_L(0); PG8_MMA(0, 1, At, B1); PG8_BAR;
            PG8_LDA(At, 0, 1); PG8_STAGE(PG8_SA(0, 0), a2, voffA);
            PG8_BAR; PG8_WAIT_L(0); PG8_MMA(1, 0, At, B0); PG8_BAR; PG8_SCHED;
            PG8_STAGE(PG8_SB(0, 1), b2 + hstep, voffB);
            PG8_WAIT_V(6); PG8_BAR; PG8_MMA(1, 1, At, B1); PG8_BAR;
            PG8_LDB(B0, 1, 0); PG8_SCHED; PG8_LDA(At, 1, 0); PG8_STAGE(PG8_SA(0, 1), a2 + hstep, voffA);
            PG8_WAIT_L(8); PG8_BAR; PG8_WAIT_L(0); PG8_MMA(0, 0, At, B0); PG8_BAR; PG8_SCHED;
            PG8_LDB(B1, 1, 1); PG8_STAGE(PG8_SB(1, 0), b3, voffB);
            PG8_BAR; PG8_WAIT_L(0); PG8_MMA(0, 1, At, B1); PG8_BAR;
            PG8_LDA(At, 1, 1); PG8_STAGE(PG8_SA(1, 0), a3, voffA);
            PG8_BAR; PG8_WAIT_L(0); PG8_MMA(1, 0, At, B0); PG8_BAR; PG8_SCHED;
            PG8_STAGE(PG8_SB(1, 1), b3 + hstep, voffB);
            PG8_WAIT_V(6); PG8_BAR; PG8_MMA(1, 1, At, B1); PG8_BAR;
            }
        }
        if constexpr (ALIGN_EPI) { if (wr == 0) PG8_BAR; }
        if constexpr (!Epi::AFTER_DRAIN) { E(acc, cur, wr, wc, fr, fq); S.done(cur); }
        if (!has_next) break;
#pragma unroll
        for (int a = 0; a < 2; ++a)
#pragma unroll
            for (int b = 0; b < 2; ++b)
#pragma unroll
                for (int m = 0; m < 4; ++m)
#pragma unroll
                    for (int n = 0; n < 2; ++n) acc[a][b][m][n] = (f32x4){0.f, 0.f, 0.f, 0.f};
        cur = nxt; cA = nA; cB = nB; ++ui;
        if constexpr (ALIGN_EPI) { if (wr == 1) PG8_BAR; }
    }
    PG8_WAIT_V(0);
    if constexpr (!ALIGN_EPI) { if (wr == 0) PG8_BAR; }
    PG8_BAR;
    if constexpr (Epi::AFTER_DRAIN) { E.fused(acc, cur, wr, wc, fr, fq, lds, wid, lane); S.done(cur); }
#undef PG8_SA
#undef PG8_SB
#undef PG8_STAGE
#undef PG8_LDA
#undef PG8_LDB
#undef PG8_MMA
#undef PG8_WAIT_V
#undef PG8_WAIT_L
#undef PG8_BAR
#undef PG8_SCHED
}
}

#define GAS __attribute__((address_space(1)))
#define LAS __attribute__((address_space(3)))
typedef unsigned short bf16;
typedef unsigned v4u __attribute__((ext_vector_type(4)));
typedef unsigned v2u __attribute__((ext_vector_type(2)));
typedef float f32x4 __attribute__((ext_vector_type(4)));
#define LDS_WAIT() asm volatile("s_waitcnt lgkmcnt(0)" ::: "memory")
#define VM_WAIT() asm volatile("s_waitcnt vmcnt(0)" ::: "memory")

constexpr int NWAVES = 8, NTHR = 512;
constexpr int D = 1024, NB = 16, T = 2048, NT = NB * T, W = 384, INW = 5376, DFF = 2816, NE = 8, DFE = 3584, NG = 24, NP = 64, NH = 16;
constexpr float RMS_EPS = 1e-6f;
constexpr int MAXT = 136;
static_assert(NT == pg8::NTOK, "token count");

constexpr size_t MiB = 1u << 20;
constexpr size_t WS_CTL = 0, CTL_ZERO_BYTES = 65536;
constexpr size_t WS_MISC = 1 * MiB;
constexpr size_t MS_S5PAR = 0, MS_AGG = 524288, MS_ROUTE = 1572864, MS_HIST = 2097152, MS_TOK = 2162688, MS_WTS = 2621440;
constexpr size_t WS_W = 5 * MiB;
constexpr size_t W_IN = 0, W_GLU = W_IN + (size_t)2 * INW * D * 2, W_BR = W_GLU + (size_t)2 * 512 * W * 2, W_OUT = W_BR + (size_t)2 * 3 * D * W * 2,
                 W_FGU = W_OUT + (size_t)2 * D * D * 2, W_FD = W_FGU + (size_t)2 * DFF * D * 2, W_END = W_FD + (size_t)D * DFF * 2;
static_assert(W_END <= 47 * MiB, "weights region");
constexpr size_t WS_H = 52 * MiB, WS_Y5 = 116 * MiB, WS_P6 = 140 * MiB, WS_G = 284 * MiB;
constexpr size_t P6_BLK = (size_t)NT * W * 2;
constexpr size_t WS_DACT = WS_P6;
constexpr size_t WS_MWGU = 5 * MiB, WS_MWD = 117 * MiB, WS_H2 = 173 * MiB, WS_HP = 237 * MiB, WS_ACT = 305 * MiB, WS_NEED = 543 * MiB;
static_assert(WS_MWGU + (size_t)NE * 2 * DFE * D * 2 <= WS_MWD && WS_MWD + (size_t)NE * D * DFE * 2 <= WS_H2 && WS_HP + (size_t)MAXT * 256 * D * 2 <= WS_ACT && WS_ACT + (size_t)MAXT * 256 * DFE * 2 <= WS_NEED, "moe map");
constexpr int CW_BAR = 4096;
constexpr int RING_BYTES = 131072, MISC_OFF = RING_BYTES + 320, LDS_BYTES = 147456;
constexpr int MT_OFF = MISC_OFF + 128;
constexpr int MT_TEXP = 0, MT_NT = 2 * MAXT, MT_OFFS = MT_NT + 2, MT_BASE = MT_OFFS + 16, MT_TOT = MT_BASE + 16, MT_LE = MT_TOT + 16, MT_WORDS = MT_LE + 256;
static_assert(MT_OFF + MT_WORDS * 4 <= LDS_BYTES, "LDS map");

#define XB_TMO      128
#define XB_XCNT(j)  (256  + 64 * (j))
#define XB_XSUB(j)  (1280 + 64 * (j))
#define XB_XGEN(j)  (2304 + 64 * (j))
#define XB_TOP      3328
#define XB_TOPGEN   3392
#define XCD_BAR_WORDS 3456
#define XB_SPIN_CAP (1u << 18)
__device__ __forceinline__ unsigned xb_ld(unsigned* p)              { return __hip_atomic_load(p, __ATOMIC_RELAXED, __HIP_MEMORY_SCOPE_AGENT); }
__device__ __forceinline__ unsigned xb_add(unsigned* p, unsigned v) { return __hip_atomic_fetch_add(p, v, __ATOMIC_RELAXED, __HIP_MEMORY_SCOPE_AGENT); }
__device__ __forceinline__ unsigned xb_xcc_id() { return (unsigned)__builtin_amdgcn_s_getreg((3 << 11) | 20) & 0xFu; }
#define XB_SPIN(cond, bar) do { unsigned _sp = 0; while (cond) { __builtin_amdgcn_s_sleep(1); \
    if ((++_sp & 255u) == 0u) { if (xb_ld(&(bar)[XB_TMO])) break; if (_sp > XB_SPIN_CAP) { atomicAdd(&(bar)[XB_TMO], 1u); break; } } } } while (0)
struct XcdBarrier { unsigned* bar; unsigned x; volatile LAS unsigned* st; };
__device__ __forceinline__ XcdBarrier xcd_barrier_post(unsigned* bar, volatile LAS unsigned* st) {
    XcdBarrier b; b.bar = bar; b.x = xb_xcc_id(); b.st = st;
    if (threadIdx.x == 0) (void)xb_add(&bar[XB_XCNT(b.x)], 1u);
    return b;
}
__device__ __forceinline__ void xcd_barrier_complete(unsigned* bar, unsigned x, unsigned& nloc, unsigned& nx) {
    const unsigned G = gridDim.x * gridDim.y * gridDim.z;
    unsigned sum, cnt, mine, sp = 0u;
    for (;;) {
        sum = 0u; cnt = 0u; mine = 0u;
#pragma unroll
        for (unsigned j = 0; j < 16; ++j) { const unsigned c = xb_ld(&bar[XB_XCNT(j)]); sum += c; cnt += (c > 0u) ? 1u : 0u; mine = (j == x) ? c : mine; }
        if (sum == G) break;
        __builtin_amdgcn_s_sleep(1);
        if ((++sp & 255u) == 0u) { if (xb_ld(&bar[XB_TMO])) break; if (sp > XB_SPIN_CAP) { atomicAdd(&bar[XB_TMO], 1u); break; } }
    }
    nloc = mine > 0u ? mine : 1u; nx = cnt > 0u ? cnt : 1u;
}
__device__ __forceinline__ void xcd_barrier(const XcdBarrier& b) {
    asm volatile("s_waitcnt vmcnt(0)" ::: "memory");
    __syncthreads();
    if (threadIdx.x == 0) {
        unsigned* bar = b.bar;
        __builtin_amdgcn_s_waitcnt(0);
        const unsigned nloc = b.st[0], nx = b.st[1];
        const unsigned old = xb_add(&bar[XB_XSUB(b.x)], 1u);
        const unsigned gen = old / nloc;
        if (old + 1u == (gen + 1u) * nloc) {
            __builtin_amdgcn_fence(__ATOMIC_RELEASE, "agent");
            asm volatile("s_waitcnt vmcnt(0)" ::: "memory");
            const unsigned og = xb_add(&bar[XB_TOP], 1u);
            const unsigned tg = og / nx;
            if (og + 1u == (tg + 1u) * nx) xb_add(&bar[XB_TOPGEN], 1u);
            else XB_SPIN(xb_ld(&bar[XB_TOPGEN]) == tg, bar);
            __builtin_amdgcn_fence(__ATOMIC_ACQUIRE, "agent");
            xb_add(&bar[XB_XGEN(b.x)], 1u);
            asm volatile("s_waitcnt vmcnt(0)" ::: "memory");
        } else {
            XB_SPIN(xb_ld(&bar[XB_XGEN(b.x)]) == gen, bar);
            __builtin_amdgcn_fence(__ATOMIC_ACQUIRE, "agent");
            asm volatile("s_waitcnt vmcnt(0)" ::: "memory");
        }
    }
    __syncthreads();
}

__device__ __forceinline__ void xcd_barrier_census(const XcdBarrier& b) {
    if (threadIdx.x == 0) { unsigned nloc, nx; xcd_barrier_complete(b.bar, b.x, nloc, nx); b.st[0] = nloc; b.st[1] = nx; }
    __syncthreads();
}

__device__ __forceinline__ unsigned f2bf(float f) { unsigned u = __builtin_bit_cast(unsigned, f); return (u + 0x7fffu + ((u >> 16) & 1u)) >> 16; }
__device__ __forceinline__ unsigned pk2(float lo, float hi) { return f2bf(lo) | (f2bf(hi) << 16); }
__device__ __forceinline__ float bf2f(unsigned short b) { return __uint_as_float(((unsigned)b) << 16); }
__device__ __forceinline__ float wave_sum(float v) {
#pragma unroll
    for (int o = 1; o < 64; o <<= 1) v += __shfl_xor(v, o);
    return v;
}
__device__ __forceinline__ float rdlane(float v, int l) { return __int_as_float(__builtin_amdgcn_readlane(__float_as_int(v), l)); }
__device__ __forceinline__ float sigmf(float x) { return 1.0f / (1.0f + __expf(-x)); }
__device__ __forceinline__ float gelu_tanh(float x) { const float z = 0.7978845608028654f * (x + 0.044715f * x * x * x); return x * sigmf(2.0f * z); }
__device__ __forceinline__ float softplusf(float z) { return fmaxf(z, 0.f) + log1pf(__expf(-fabsf(z))); }

__device__ __forceinline__ void tr_item(const float* W, int K, int N, bf16* WT, int kind, int aux, LAS float* scr, int item, int lane) {
    const int nblk = N / 32, kb = item / nblk, nb = item - kb * nblk, k0 = 64 * kb, n0 = 32 * nb;
    const int drow0 = (kind == 0) ? (aux + n0) : (256 * (n0 >> 7) + aux + (n0 & 127));
#pragma unroll 8
    for (int i = 0; i < 32; ++i) { const int kk = 2 * i + (lane >> 5); scr[kk * 33 + (lane & 31)] = W[(size_t)(k0 + kk) * N + n0 + (lane & 31)]; }
    LDS_WAIT();
    const int c = lane & 7;
#pragma unroll
    for (int j = 0; j < 4; ++j) { const int n = (lane >> 3) + 8 * j; const LAS float* s = scr + (8 * c) * 33 + n;
        v4u o; o.x = pk2(s[0 * 33], s[1 * 33]); o.y = pk2(s[2 * 33], s[3 * 33]); o.z = pk2(s[4 * 33], s[5 * 33]); o.w = pk2(s[6 * 33], s[7 * 33]);
        *(GAS v4u*)(WT + (size_t)(drow0 + n) * K + k0 + 8 * c) = o; }
    LDS_WAIT();
}
__device__ __forceinline__ void rms_row(const float* xrow, const float* gain, bf16* orow, int lane, f32x4 (&v)[4]) {
    const f32x4* xr = (const f32x4*)xrow + lane; const f32x4* gr = (const f32x4*)gain + lane;
    float s = 0.f;
#pragma unroll
    for (int j = 0; j < 4; ++j) { v[j] = xr[64 * j]; s += (v[j].x * v[j].x + v[j].y * v[j].y) + (v[j].z * v[j].z + v[j].w * v[j].w); }
    const float rs = 1.0f / sqrtf(wave_sum(s) * (1.f / D) + RMS_EPS);
    unsigned long long* o8 = (unsigned long long*)orow + lane;
#pragma unroll
    for (int j = 0; j < 4; ++j) { v[j] = v[j] * rs * gr[64 * j]; o8[64 * j] = (unsigned long long)pk2(v[j].x, v[j].y) | ((unsigned long long)pk2(v[j].z, v[j].w) << 32); }
}

__device__ __forceinline__ void s5_simple(const bf16* U, bf16* Y5, const float* par, const float* c_re, const float* c_im, const float* dvec, LAS unsigned char* lds, int G, int tid) {
    const int lane = tid & 63, w = tid >> 6;
    LAS float* E = (LAS float*)lds;
    LAS float* CM = E + 1024;
    LAS float* SB = CM + 2048 + w * (16 * 130);
    for (int item = blockIdx.x; item < NB * NG; item += G) {
        const int b = item / NG, g = item % NG;
#pragma unroll
        for (int k = 0; k < 4; ++k) { const int idx = tid + 512 * k, pq = idx >> 4, h = idx & 15;
            CM[idx] = pq < 64 ? c_re[(g * 16 + h) * 64 + pq] : -c_im[(g * 16 + h) * 64 + pq - 64]; }
        const float* pp = par + (size_t)(g * 64 + lane) * 34;
        const float are = pp[0], aim = pp[1];
        float bre[16], bim[16];
#pragma unroll
        for (int h = 0; h < 16; ++h) { bre[h] = pp[2 + h]; bim[h] = pp[18 + h]; }
        const int t0 = 256 * w;
        const bf16* ub = U + (size_t)(b * T + t0) * W + 16 * g;
        const int lt = lane >> 4, lh = lane & 15;
        float sre = 0.f, sim = 0.f;
        for (int blk = 0; blk < 16; ++blk) {
            float uu[4];
#pragma unroll
            for (int q = 0; q < 4; ++q) uu[q] = bf2f(ub[(size_t)(blk * 16 + q * 4 + lt) * W + lh]);
#pragma unroll
            for (int tl = 0; tl < 16; ++tl) {
                float br = 0.f, bi = 0.f;
#pragma unroll
                for (int h = 0; h < 16; ++h) { const float uv = rdlane(uu[tl >> 2], (tl & 3) * 16 + h); br += bre[h] * uv; bi += bim[h] * uv; }
                const float nre = are * sre - aim * sim + br, nim = are * sim + aim * sre + bi; sre = nre; sim = nim;
            }
        }
        E[w * 128 + lane] = sre; E[w * 128 + 64 + lane] = sim;
        __syncthreads();
        float pr = are, pi = aim;
#pragma unroll
        for (int k = 0; k < 8; ++k) { const float nr = pr * pr - pi * pi, ni = 2.f * pr * pi; pr = nr; pi = ni; }
        sre = 0.f; sim = 0.f;
        for (int k = 0; k < w; ++k) { const float er = E[k * 128 + lane], ei = E[k * 128 + 64 + lane]; const float nre = pr * sre - pi * sim + er, nim = pr * sim + pi * sre + ei; sre = nre; sim = nim; }
        const int ctl = lane >> 2, chq = lane & 3;
        const f32x4 dv = *(const f32x4*)(dvec + 16 * g + 4 * chq);
        for (int blk = 0; blk < 16; ++blk) {
            float uu[4];
#pragma unroll
            for (int q = 0; q < 4; ++q) uu[q] = bf2f(ub[(size_t)(blk * 16 + q * 4 + lt) * W + lh]);
            const v2u ur = *(const v2u*)(ub + (size_t)(blk * 16 + ctl) * W + 4 * chq);
#pragma unroll
            for (int tl = 0; tl < 16; ++tl) {
                float br = 0.f, bi = 0.f;
#pragma unroll
                for (int h = 0; h < 16; ++h) { const float uv = rdlane(uu[tl >> 2], (tl & 3) * 16 + h); br += bre[h] * uv; bi += bim[h] * uv; }
                const float nre = are * sre - aim * sim + br, nim = are * sim + aim * sre + bi; sre = nre; sim = nim;
                SB[tl * 130 + lane] = sre; SB[tl * 130 + 64 + lane] = sim;
            }
            LDS_WAIT();
            f32x4 acc = (f32x4){0.f, 0.f, 0.f, 0.f};
            const LAS float* srow = SB + ctl * 130;
            for (int pq = 0; pq < 128; ++pq) { const float sv = srow[pq]; const f32x4 cv = *(const LAS f32x4*)(CM + pq * 16 + 4 * chq); acc += sv * cv; }
            LDS_WAIT();
            const float u0 = __uint_as_float(ur.x << 16), u1 = __uint_as_float(ur.x & 0xffff0000u), u2 = __uint_as_float(ur.y << 16), u3 = __uint_as_float(ur.y & 0xffff0000u);
            const float y0 = gelu_tanh(acc.x + dv.x * u0), y1 = gelu_tanh(acc.y + dv.y * u1), y2 = gelu_tanh(acc.z + dv.z * u2), y3 = gelu_tanh(acc.w + dv.w * u3);
            v2u o; o.x = pk2(y0, y1); o.y = pk2(y2, y3);
            *(v2u*)(Y5 + (size_t)(b * T + t0 + blk * 16 + ctl) * W + 16 * g + 4 * chq) = o;
        }
        __syncthreads();
    }
}

__device__ __forceinline__ void attn_simple(const bf16* Q, const bf16* Kb, const bf16* Vb, bf16* O, int gtid, int nthreads) {
    for (int idx = gtid; idx < NB * 6 * T; idx += nthreads) {
        const int t = idx % T, bh = idx / T, b = bh / 6, h = bh % 6;
        const size_t tok = (size_t)b * T + t;
        float q[64], acc[64];
        { const v4u* qp = (const v4u*)(Q + tok * W + 64 * h);
#pragma unroll
          for (int i = 0; i < 8; ++i) { const v4u r = qp[i];
              q[8 * i + 0] = 0.125f * __uint_as_float(r.x << 16); q[8 * i + 1] = 0.125f * __uint_as_float(r.x & 0xffff0000u); q[8 * i + 2] = 0.125f * __uint_as_float(r.y << 16); q[8 * i + 3] = 0.125f * __uint_as_float(r.y & 0xffff0000u);
              q[8 * i + 4] = 0.125f * __uint_as_float(r.z << 16); q[8 * i + 5] = 0.125f * __uint_as_float(r.z & 0xffff0000u); q[8 * i + 6] = 0.125f * __uint_as_float(r.w << 16); q[8 * i + 7] = 0.125f * __uint_as_float(r.w & 0xffff0000u); } }
#pragma unroll
        for (int i = 0; i < 64; ++i) acc[i] = 0.f;
        float R = 0.f;
        for (int s = t - 1; s >= 0 && R > -100.f; --s) {
            const size_t ks = ((size_t)b * T + s) * W + 64 * h;
            const v4u* kp = (const v4u*)(Kb + ks);
            float z = 0.f;
#pragma unroll
            for (int i = 0; i < 8; ++i) { const v4u r = kp[i];
                z += q[8 * i + 0] * __uint_as_float(r.x << 16) + q[8 * i + 1] * __uint_as_float(r.x & 0xffff0000u) + q[8 * i + 2] * __uint_as_float(r.y << 16) + q[8 * i + 3] * __uint_as_float(r.y & 0xffff0000u)
                   + q[8 * i + 4] * __uint_as_float(r.z << 16) + q[8 * i + 5] * __uint_as_float(r.z & 0xffff0000u) + q[8 * i + 6] * __uint_as_float(r.w << 16) + q[8 * i + 7] * __uint_as_float(r.w & 0xffff0000u); }
            const float sp = softplusf(z);
            const float wgt = __expf(z - sp + R);
            R -= sp;
            const v4u* vp = (const v4u*)(Vb + ks);
#pragma unroll
            for (int i = 0; i < 8; ++i) { const v4u r = vp[i];
                acc[8 * i + 0] += wgt * __uint_as_float(r.x << 16); acc[8 * i + 1] += wgt * __uint_as_float(r.x & 0xffff0000u); acc[8 * i + 2] += wgt * __uint_as_float(r.y << 16); acc[8 * i + 3] += wgt * __uint_as_float(r.y & 0xffff0000u);
                acc[8 * i + 4] += wgt * __uint_as_float(r.z << 16); acc[8 * i + 5] += wgt * __uint_as_float(r.z & 0xffff0000u); acc[8 * i + 6] += wgt * __uint_as_float(r.w << 16); acc[8 * i + 7] += wgt * __uint_as_float(r.w & 0xffff0000u); }
        }
        v4u* op = (v4u*)(O + tok * W + 64 * h);
#pragma unroll
        for (int i = 0; i < 8; ++i) { v4u o; o.x = pk2(acc[8 * i], acc[8 * i + 1]); o.y = pk2(acc[8 * i + 2], acc[8 * i + 3]); o.z = pk2(acc[8 * i + 4], acc[8 * i + 5]); o.w = pk2(acc[8 * i + 6], acc[8 * i + 7]); op[i] = o; }
    }
}

__device__ __forceinline__ void lru_pass(int pass, const bf16* XL, bf16* YL, float* AGG, const float* conv_w, const float* conv_b, const float* w_a, const float* b_a, const float* w_x, const float* b_x,
                                         const float* lam, int gw, int ngw, int lane) {
    for (int item = gw; item < NB * 6 * 16; item += ngw) {
        const int c = item & 15, bh = item >> 4, b = bh / 6, hd = bh % 6, ch = 64 * hd + lane;
        float wa[64], wx[64];
#pragma unroll
        for (int i = 0; i < 64; ++i) { wa[i] = w_a[(hd * 64 + i) * 64 + lane]; wx[i] = w_x[(hd * 64 + i) * 64 + lane]; }
        const float cw0 = conv_w[0 * W + ch], cw1 = conv_w[1 * W + ch], cw2 = conv_w[2 * W + ch], cw3 = conv_w[3 * W + ch], cb = conv_b[ch];
        const float ba = b_a[ch], bx = b_x[ch];
        const float lm = lam[ch];
        const float ls8 = 8.0f * (fminf(lm, 0.f) - log1pf(__expf(-fabsf(lm))));
        const int t0 = 128 * c;
        const bf16* xb = XL + (size_t)(b * T) * W + ch;
        bf16* yb = YL + (size_t)(b * T) * W + ch;
        float xm3 = t0 >= 3 ? bf2f(xb[(size_t)(t0 - 3) * W]) : 0.f, xm2 = t0 >= 2 ? bf2f(xb[(size_t)(t0 - 2) * W]) : 0.f, xm1 = t0 >= 1 ? bf2f(xb[(size_t)(t0 - 1) * W]) : 0.f;
        float hst = 0.f, sumlog = 0.f;
        if (pass == 2) { const float* ag = AGG + (size_t)(bh * 16) * 128 + lane;
            for (int k = 0; k < c; ++k) hst = ag[k * 128] * hst + ag[k * 128 + 64]; }
        for (int tb = 0; tb < 128; tb += 8) {
            float xv[8], yv[8];
#pragma unroll
            for (int k = 0; k < 8; ++k) { xv[k] = bf2f(xb[(size_t)(t0 + tb + k) * W]); yv[k] = (pass == 2) ? bf2f(yb[(size_t)(t0 + tb + k) * W]) : 0.f; }
#pragma unroll
            for (int k = 0; k < 8; ++k) {
                const float xc = cw0 * xm3 + cw1 * xm2 + cw2 * xm1 + cw3 * xv[k] + cb;
                xm3 = xm2; xm2 = xm1; xm1 = xv[k];
                float ra = ba, ri = bx;
#pragma unroll
                for (int i = 0; i < 64; ++i) { const float xi = rdlane(xc, i); ra += xi * wa[i]; ri += xi * wx[i]; }
                const float r = sigmf(ra), ig = sigmf(ri);
                const float log_a = ls8 * r;
                const float a = __expf(log_a);
                const float bb = sqrtf(fmaxf(-expm1f(2.0f * log_a), 0.f)) * (ig * xc);
                hst = a * hst + bb;
                if (pass == 1) sumlog += log_a;
                else yb[(size_t)(t0 + tb + k) * W] = (bf16)f2bf(hst * gelu_tanh(yv[k]));
            }
        }
        if (pass == 1) { float* ag = AGG + (size_t)(bh * 16 + c) * 128 + lane; ag[0] = __expf(sumlog); ag[64] = hst; }
    }
}

__device__ __forceinline__ void moe_tables(const int* HIST, LAS unsigned char* lds, int tid) {
    LAS int* HL = (LAS int*)lds;
    LAS int* MT = (LAS int*)(lds + MT_OFF);
    for (int i = tid; i < 4096; i += NTHR) HL[i] = __hip_atomic_load(HIST + i, __ATOMIC_RELAXED, __HIP_MEMORY_SCOPE_AGENT);
    __syncthreads();
    if (tid < 16) { int tot = 0, base = 0; for (int c = 0; c < 256; ++c) { const int v = HL[c * 16 + tid]; tot += v; if (c < (int)blockIdx.x) base += v; } MT[MT_TOT + tid] = tot; MT[MT_BASE + tid] = base; }
    __syncthreads();
    if (tid < 2) { int off = 0, tiles = 0;
        for (int e = 0; e < 8; ++e) { const int pad = (MT[MT_TOT + tid * 8 + e] + 255) & ~255; MT[MT_OFFS + tid * 8 + e] = off; for (int k = 0; k < (pad >> 8) && tiles < MAXT; ++k) MT[MT_TEXP + tid * MAXT + tiles++] = e; off += pad; }
        MT[MT_NT + tid] = tiles; }
    __syncthreads();
}

struct Args { const float* in[33]; float* out; unsigned char* ws; int ph_lo, ph_hi; };
constexpr int N_PHASES = 23;
#ifndef GP_ALIGN
#define GP_ALIGN true
#endif
#ifndef GP_SP2
#define GP_SP2 true
#endif
#ifndef MK_STOP
#define MK_STOP N_PHASES
#endif

__global__ void __launch_bounds__(NTHR, 2) hybrid_fwd(Args args) {
    extern __shared__ __attribute__((aligned(16))) unsigned char lds_raw[];
    LAS unsigned char* lds = (LAS unsigned char*)lds_raw;
    volatile LAS unsigned* MISC = (volatile LAS unsigned*)(lds + MISC_OFF);
    LAS int* MT = (LAS int*)(lds + MT_OFF);
    const int tid0 = threadIdx.x;
    const int G = gridDim.x, bx0 = blockIdx.x;
    const int NGW = G * NWAVES, NTH = G * NTHR;
    unsigned char* ws0 = args.ws;
    unsigned* ctl = (unsigned*)(ws0 + WS_CTL);
    const int lo = args.ph_lo, hi = args.ph_hi;
    for (int u = tid0; u < (LDS_BYTES - RING_BYTES) / 4; u += NTHR) ((LAS unsigned*)(lds + RING_BYTES))[u] = 0u;
    __syncthreads();
    XcdBarrier bar; bar.bar = ctl + CW_BAR; bar.x = 0; bar.st = nullptr;
    if (hi - lo > 1) { bar = xcd_barrier_post(ctl + CW_BAR, MISC + 8); xcd_barrier_census(bar); }
#define PHASE_VARS int tid = tid0; asm volatile("" : "+v"(tid)); int bx = bx0; asm volatile("" : "+s"(bx)); unsigned char* ws = ws0; asm volatile("" : "+s"(ws)); \
    const int lane = tid & 63, wave = __builtin_amdgcn_readfirstlane(tid >> 6), gw = wave * G + bx, gtid = bx * NTHR + tid; (void)lane; (void)wave; (void)gw; (void)gtid; (void)ws;
#define IN(k) (lo <= (k) && (k) < hi)
#define SEAM(k) do { if (IN((k) + 1)) xcd_barrier(bar); } while (0)

#define x_in (args.in[0])
#define xres (args.out)
#define S5PAR ((float*)(ws + WS_MISC + MS_S5PAR))
#define AGG ((float*)(ws + WS_MISC + MS_AGG))
#define ROUTE ((float*)(ws + WS_MISC + MS_ROUTE))
#define HIST ((int*)(ws + WS_MISC + MS_HIST))
#define TOK ((int*)(ws + WS_MISC + MS_TOK))
#define WTS ((float*)(ws + WS_MISC + MS_WTS))
#define WIN ((bf16*)(ws + WS_W + W_IN))
#define WGLU ((bf16*)(ws + WS_W + W_GLU))
#define WBR ((bf16*)(ws + WS_W + W_BR))
#define WOUT ((bf16*)(ws + WS_W + W_OUT))
#define WFGU ((bf16*)(ws + WS_W + W_FGU))
#define WFD ((bf16*)(ws + WS_W + W_FD))
#define HB ((bf16*)(ws + WS_H))
#define Y5 ((bf16*)(ws + WS_Y5))
#define P6 ((bf16*)(ws + WS_P6))
#define GT ((bf16*)(ws + WS_G))
#define DACT ((bf16*)(ws + WS_DACT))
#define MWGU ((bf16*)(ws + WS_MWGU))
#define MWD ((bf16*)(ws + WS_MWD))
#define H2 ((bf16*)(ws + WS_H2))
#define HP ((bf16*)(ws + WS_HP))
#define ACT ((bf16*)(ws + WS_ACT))
#define PU P6
#define PQ (P6 + (size_t)NT * W)
#define PYL (P6 + (size_t)2 * NT * W)
#define PK (P6 + (size_t)3 * NT * W)
#define PV (P6 + (size_t)4 * NT * W)
#define PXL (P6 + (size_t)5 * NT * W)
#define scr ((LAS float*)(lds + wave * 16384))

    if (IN(0)) { PHASE_VARS
        constexpr int I_IN = 16 * (INW / 32), I_GLU = 6 * 12, I_BR = 6 * 32, I_OUT = 16 * 32, I_FG = 16 * (DFF / 32), I_FD = (DFF / 64) * 32;
        constexpr int NITEMS = 2 * I_IN + 2 * I_GLU + 6 * I_BR + 2 * I_OUT + 2 * I_FG + I_FD;
        for (int it = gw; it < NITEMS; it += NGW) {
            int r = it;
            if (r < 2 * I_IN) { const int l = r / I_IN; tr_item(args.in[2] + (size_t)l * D * INW, D, INW, WIN + (size_t)l * INW * D, 0, 0, scr, r % I_IN, lane); continue; } r -= 2 * I_IN;
            if (r < 2 * I_GLU) { const int l = r / I_GLU; tr_item(args.in[12] + (size_t)l * W * W, W, W, WGLU + (size_t)l * 512 * W, 0, 0, scr, r % I_GLU, lane); continue; } r -= 2 * I_GLU;
            if (r < 6 * I_BR) { const int ln = r / I_BR; tr_item(args.in[21] + (size_t)ln * W * D, W, D, WBR + (size_t)ln * D * W, 0, 0, scr, r % I_BR, lane); continue; } r -= 6 * I_BR;
            if (r < 2 * I_OUT) { const int l = r / I_OUT; tr_item(args.in[22] + (size_t)l * D * D, D, D, WOUT + (size_t)l * D * D, 0, 0, scr, r % I_OUT, lane); continue; } r -= 2 * I_OUT;
            if (r < I_FG) { tr_item(args.in[24], D, DFF, WFGU, 1, 0, scr, r, lane); continue; } r -= I_FG;
            if (r < I_FG) { tr_item(args.in[25], D, DFF, WFGU, 1, 128, scr, r, lane); continue; } r -= I_FG;
            tr_item(args.in[26], DFF, D, WFD, 0, 0, scr, r, lane);
        }
        for (int i = gtid; i < 2 * 128 * W / 8; i += NTH) { const int l = i / (128 * W / 8), r = i % (128 * W / 8); *(v4u*)(WGLU + (size_t)l * 512 * W + (size_t)384 * W + (size_t)r * 8) = (v4u){0u, 0u, 0u, 0u}; }
        for (int i = gtid; i < 2 * NG * NP; i += NTH) {
            const int l = i / (NG * NP), gp = i % (NG * NP), g = gp / NP;
            const float lre = args.in[4][i], lim = args.in[5][i], dt = expf(args.in[6][l * NG + g]);
            const float ea = expf(lre * dt), are = ea * cosf(lim * dt), aim = ea * sinf(lim * dt), den = lre * lre + lim * lim, nr = are - 1.0f;
            const float cre = (nr * lre + aim * lim) / den, cim = (aim * lre - nr * lim) / den;
            float* o = S5PAR + (size_t)i * 34; o[0] = are; o[1] = aim;
            for (int h = 0; h < 16; ++h) { const float br = args.in[7][(size_t)i * 16 + h], bi = args.in[8][(size_t)i * 16 + h]; o[2 + h] = cre * br - cim * bi; o[18 + h] = cre * bi + cim * br; }
        }
        for (int m = gw; m < NT; m += NGW) { f32x4 v[4]; rms_row(x_in + (size_t)m * D, args.in[1], HB + (size_t)m * D, lane, v); }
        SEAM(0);
    }

#pragma unroll
    for (int L = 0; L < 2; ++L) {
        const int pb = 1 + 9 * L;
        if (IN(pb)) { PHASE_VARS
            pg8::Gemm g{HB, WIN + (size_t)L * INW * D, NT, INW, D}; pg8::StaticOrder S; S.init(NT, INW, G, bx);
#ifdef MK_EXEPI
            pg8::EpiBf16<0> E{P6, INW, nullptr, 0, 0, 1.f};
            pg8::gemm_phase<pg8::EpiBf16<0>, pg8::StaticOrder, GP_ALIGN, GP_SP2>(lds, g, S, E);
#else
            pg8::EpiInProj E{P6, GT, args.in[3] + L * 3 * D};
            pg8::gemm_phase<pg8::EpiInProj, pg8::StaticOrder, GP_ALIGN, GP_SP2>(lds, g, S, E);
#endif
            SEAM(pb);
        }
#ifndef MK_STRIP
        if (IN(pb + 1)) { PHASE_VARS
#ifndef NO_S5
            s5_simple(PU, Y5, S5PAR + (size_t)L * NG * NP * 34, args.in[9] + (size_t)L * NG * NH * NP, args.in[10] + (size_t)L * NG * NH * NP, args.in[11] + L * W, lds, G, tid);
#endif
#ifndef NO_ATTN
            attn_simple(PQ, PK, PV, PQ, gtid, NTH);
#endif
#ifndef NO_LRU
            lru_pass(1, PXL, PYL, AGG, args.in[14] + L * 4 * W, args.in[15] + L * W, args.in[16] + L * 6 * 64 * 64, args.in[17] + L * W, args.in[18] + L * 6 * 64 * 64, args.in[19] + L * W, args.in[20] + L * W, gw, NGW, lane);
#endif
            SEAM(pb + 1);
        }
        if (IN(pb + 2)) { PHASE_VARS
#ifndef NO_LRU
            lru_pass(2, PXL, PYL, AGG, args.in[14] + L * 4 * W, args.in[15] + L * W, args.in[16] + L * 6 * 64 * 64, args.in[17] + L * W, args.in[18] + L * 6 * 64 * 64, args.in[19] + L * W, args.in[20] + L * W, gw, NGW, lane);
#endif
            __syncthreads();
            pg8::Gemm g{Y5, WGLU + (size_t)L * 512 * W, NT, 512, W}; pg8::StaticOrder S; S.init(NT, 512, G, bx);
            pg8::EpiGlu E{Y5, PU, args.in[13] + L * W};
            pg8::gemm_phase<pg8::EpiGlu, pg8::StaticOrder, GP_ALIGN, GP_SP2>(lds, g, S, E);
            SEAM(pb + 2);
        }
        if (IN(pb + 3)) { PHASE_VARS
            pg8::Gemm g{P6, WBR + (size_t)L * 3 * D * W, 3 * NT, 3 * D, W}; pg8::MergedOrder S; S.so.init(NT, D, G, bx);
            pg8::EpiMerged E{GT, HB};
            pg8::gemm_phase<pg8::EpiMerged, pg8::MergedOrder, GP_ALIGN, GP_SP2>(lds, g, S, E);
            SEAM(pb + 3);
        }
        if (IN(pb + 4)) { PHASE_VARS
            pg8::Gemm g{HB, WOUT + (size_t)L * D * D, NT, D, D}; pg8::StaticOrder S; S.init(NT, D, G, bx);
            pg8::EpiResid E{L == 0 ? x_in : (const float*)xres, xres};
            pg8::gemm_phase<pg8::EpiResid, pg8::StaticOrder, GP_ALIGN, GP_SP2>(lds, g, S, E);
            SEAM(pb + 4);
        }
        if (L == 0) {
            if (IN(6)) { PHASE_VARS for (int m = gw; m < NT; m += NGW) { f32x4 v[4]; rms_row(xres + (size_t)m * D, args.in[23], HB + (size_t)m * D, lane, v); } SEAM(6); }
            if (IN(7)) { PHASE_VARS
                pg8::Gemm g{HB, WFGU, NT, 2 * DFF, D}; pg8::StaticOrder S; S.init(NT, 2 * DFF, G, bx);
                pg8::EpiSwiglu E{DACT, DFF, 2 * DFF / 256};
                pg8::gemm_phase<pg8::EpiSwiglu, pg8::StaticOrder, GP_ALIGN, GP_SP2>(lds, g, S, E);
                SEAM(7);
            }
            if (IN(8)) { PHASE_VARS
                pg8::Gemm g{DACT, WFD, NT, D, DFF}; pg8::StaticOrder S; S.init(NT, D, G, bx);
                pg8::EpiResid E{xres, xres};
                pg8::gemm_phase<pg8::EpiResid, pg8::StaticOrder, GP_ALIGN, GP_SP2>(lds, g, S, E);
                SEAM(8);
            }
            if (IN(9)) { PHASE_VARS for (int m = gw; m < NT; m += NGW) { f32x4 v[4]; rms_row(xres + (size_t)m * D, args.in[1] + D, HB + (size_t)m * D, lane, v); } SEAM(9); }
        }
#endif
    }
#ifndef MK_STRIP

    if (IN(15)) { PHASE_VARS
        constexpr int I_G = 16 * (DFE / 32), I_D = (DFE / 64) * 32, I_E = 2 * I_G + I_D;
        for (int it = gw; it < NE * I_E; it += NGW) {
            const int e = it / I_E; int r = it % I_E;
            if (r < I_G) { tr_item(args.in[29] + (size_t)e * D * DFE, D, DFE, MWGU + (size_t)e * 2 * DFE * D, 1, 0, scr, r, lane); continue; } r -= I_G;
            if (r < I_G) { tr_item(args.in[30] + (size_t)e * D * DFE, D, DFE, MWGU + (size_t)e * 2 * DFE * D, 1, 128, scr, r, lane); continue; } r -= I_G;
            tr_item(args.in[31] + (size_t)e * DFE * D, DFE, D, MWD + (size_t)e * D * DFE, 0, 0, scr, r, lane);
        }
        __syncthreads();
        LAS int* LE = MT + MT_LE;
        for (int tok0 = bx * 128; tok0 < NT; tok0 += G * 128) {
            for (int k = 0; k < 16; ++k) {
                const int il = wave * 16 + k, m = tok0 + il;
                f32x4 v[4]; rms_row(xres + (size_t)m * D, args.in[23] + D, H2 + (size_t)m * D, lane, v);
                float lg[8];
#pragma unroll
                for (int e = 0; e < 8; ++e) lg[e] = 0.f;
#pragma unroll
                for (int j = 0; j < 4; ++j)
#pragma unroll
                    for (int q = 0; q < 4; ++q) { const float* rw = args.in[27] + (size_t)(4 * lane + 256 * j + q) * 8; const f32x4 r0 = *(const f32x4*)rw, r1 = *(const f32x4*)(rw + 4); const float hv = v[j][q];
                        lg[0] += hv * r0.x; lg[1] += hv * r0.y; lg[2] += hv * r0.z; lg[3] += hv * r0.w; lg[4] += hv * r1.x; lg[5] += hv * r1.y; lg[6] += hv * r1.z; lg[7] += hv * r1.w; }
#pragma unroll
                for (int e = 0; e < 8; ++e) lg[e] = wave_sum(lg[e]) + args.in[28][e];
                int e0 = 0; float v0 = lg[0];
#pragma unroll
                for (int e = 1; e < 8; ++e) if (lg[e] > v0) { v0 = lg[e]; e0 = e; }
                int e1 = -1; float v1 = -3.0e38f;
#pragma unroll
                for (int e = 0; e < 8; ++e) if (e != e0 && lg[e] > v1) { v1 = lg[e]; e1 = e; }
                const float w1 = 1.0f / (1.0f + expf(v0 - v1)), w0 = 1.0f - w1;
                if (lane == 0) { float* ro = ROUTE + (size_t)m * 4; ro[0] = __int_as_float(e0); ro[1] = __int_as_float(e1); ro[2] = w0; ro[3] = w1; LE[il] = e0; LE[128 + il] = e1; }
            }
            __syncthreads();
            if (tid < 16) { const int p = tid >> 3, e = tid & 7; int cnt = 0; for (int i = 0; i < 128; ++i) cnt += (LE[p * 128 + i] == e) ? 1 : 0; HIST[(tok0 / 128) * 16 + tid] = cnt; }
            __syncthreads();
        }
        SEAM(15);
    }
    if (IN(16)) { PHASE_VARS
        moe_tables(HIST, lds, tid);
        LAS int* LE = MT + MT_LE;
        const int p = (tid >> 7) & 1, i = tid & 127; const int m = bx * 128 + i;
        int e = 0; float wv = 0.f;
        if (tid < 256) { const float* ro = ROUTE + (size_t)m * 4; e = __float_as_int(ro[p]); wv = ro[2 + p]; LE[p * 128 + i] = e; }
        __syncthreads();
        if (tid < 256) { int rank = 0; for (int k = 0; k < i; ++k) rank += (LE[p * 128 + k] == e) ? 1 : 0;
            const int slot = MT[MT_OFFS + p * 8 + e] + MT[MT_BASE + p * 8 + e] + rank;
            TOK[p * (MAXT * 256) + slot] = m; WTS[p * (MAXT * 256) + slot] = wv; }
        if (bx == 0) { for (int j = 0; j < 16; ++j) { const int tot = MT[MT_TOT + j], pad = (tot + 255) & ~255, off = MT[MT_OFFS + j]; for (int s = tot + tid; s < pad; s += NTHR) { TOK[(j >> 3) * (MAXT * 256) + off + s] = -1; WTS[(j >> 3) * (MAXT * 256) + off + s] = 0.f; } } }
        SEAM(16);
    }
    if (IN(17)) { PHASE_VARS
        if (lo == 17) moe_tables(HIST, lds, tid);
        const int nrows = MT[MT_NT + 0] * 256;
        for (int s = gw; s < nrows; s += NGW) { const int t = __hip_atomic_load(TOK + s, __ATOMIC_RELAXED, __HIP_MEMORY_SCOPE_AGENT);
            v4u a = (v4u){0u, 0u, 0u, 0u}, b2 = a; if (t >= 0) { const v4u* src = (const v4u*)(H2 + (size_t)t * D) + lane; a = src[0]; b2 = src[64]; }
            v4u* dst = (v4u*)(HP + (size_t)s * D) + lane; dst[0] = a; dst[64] = b2; }
        SEAM(17);
    }
#pragma unroll
    for (int p = 0; p < 2; ++p) {
        if (IN(18 + 2 * p)) { PHASE_VARS
            if (lo == 18 + 2 * p) moe_tables(HIST, lds, tid);
            const int nT = MT[MT_NT + p];
            pg8::Gemm g{HP, MWGU, nT * 256, 2 * DFE, D}; pg8::MoeOrder S; S.so.init(nT * 256, 2 * DFE, G, bx); S.tileExp = (const LAS int*)(MT + MT_TEXP + p * MAXT);
            pg8::EpiSwiglu E{ACT, DFE, 2 * DFE / 256};
            pg8::gemm_phase<pg8::EpiSwiglu, pg8::MoeOrder, GP_ALIGN, GP_SP2>(lds, g, S, E);
            SEAM(18 + 2 * p);
        }
        if (IN(19 + 2 * p)) { PHASE_VARS
            if (lo == 19 + 2 * p) moe_tables(HIST, lds, tid);
            const int nT = MT[MT_NT + p];
            pg8::Gemm g{ACT, MWD, nT * 256, D, DFE}; pg8::MoeOrder S; S.so.init(nT * 256, D, G, bx); S.tileExp = (const LAS int*)(MT + MT_TEXP + p * MAXT);
            pg8::EpiMoeDown E{xres, TOK + p * (MAXT * 256), WTS + p * (MAXT * 256)};
            pg8::gemm_phase<pg8::EpiMoeDown, pg8::MoeOrder, GP_ALIGN, GP_SP2>(lds, g, S, E);
            if (p == 0) {
                const int nrows = MT[MT_NT + 1] * 256;
                for (int s = gw; s < nrows; s += NGW) { const int t = __hip_atomic_load(TOK + MAXT * 256 + s, __ATOMIC_RELAXED, __HIP_MEMORY_SCOPE_AGENT);
                    v4u a = (v4u){0u, 0u, 0u, 0u}, b2 = a; if (t >= 0) { const v4u* src = (const v4u*)(H2 + (size_t)t * D) + lane; a = src[0]; b2 = src[64]; }
                    v4u* dst = (v4u*)(HP + (size_t)s * D) + lane; dst[0] = a; dst[64] = b2; }
            }
            SEAM(19 + 2 * p);
        }
    }
    if (IN(22)) { PHASE_VARS
        for (int m = gw; m < NT; m += NGW) {
            f32x4* xr = (f32x4*)(xres + (size_t)m * D) + lane; const f32x4* gr = (const f32x4*)args.in[32] + lane;
            f32x4 v[4]; float s = 0.f;
#pragma unroll
            for (int j = 0; j < 4; ++j) { v[j] = xr[64 * j]; s += (v[j].x * v[j].x + v[j].y * v[j].y) + (v[j].z * v[j].z + v[j].w * v[j].w); }
            const float rs = 1.0f / sqrtf(wave_sum(s) * (1.f / D) + RMS_EPS);
#pragma unroll
            for (int j = 0; j < 4; ++j) xr[64 * j] = v[j] * rs * gr[64 * j];
        }
    }
#endif
#undef IN
#undef SEAM
}

__global__ void nan_fill(float* o, int n) { for (int i = blockIdx.x * blockDim.x + threadIdx.x; i < n; i += gridDim.x * blockDim.x) o[i] = __builtin_nanf(""); }


#ifdef MK_DUMP
__global__ void dump_k(int what, const unsigned char* ws, float* out) {
    for (size_t i = (size_t)blockIdx.x * blockDim.x + threadIdx.x; i < (size_t)NT * D; i += (size_t)gridDim.x * blockDim.x) {
        const size_t t = i / D; const int c = (int)(i % D); float v = 0.f;
        if (what == 1) v = bf2f(((const bf16*)(ws + WS_H))[i]);
        else if (what == 2) { const bf16* g = (const bf16*)(ws + WS_G) + t * 3072; v = bf2f(g[c]) + bf2f(g[c + 1024]) + bf2f(g[c + 2048]); }
        else if (what == 3) { if (c < W) for (int k = 0; k < 6; ++k) v += bf2f(((const bf16*)(ws + WS_P6))[(size_t)k * NT * W + t * W + c]); }
        else if (what == 4) { if (c < W) v = bf2f(((const bf16*)(ws + WS_Y5))[t * W + c]); }
        else if (what == 5) { if (c < W) v = bf2f(((const bf16*)(ws + WS_P6))[(size_t)1 * NT * W + t * W + c]); }
        else if (what == 6) { if (c < W) v = bf2f(((const bf16*)(ws + WS_P6))[(size_t)2 * NT * W + t * W + c]); }
        else if (what == 7) { if (c < W) v = bf2f(((const bf16*)(ws + WS_P6))[(size_t)0 * NT * W + t * W + c]); }
        else if (what == 9) { const bf16* o = (const bf16*)(ws + WS_P6) + t * INW; for (int k = 0; k < 5; ++k) v += bf2f(o[c + 1024 * k]); }
        else if (what == 8) v = bf2f(((const bf16*)(ws + WS_W + W_IN))[i % ((size_t)2 * INW * D)]);
        out[i] = v;
    }
}
#endif
#ifndef MK_PER_PHASE
#define MK_PER_PHASE 1
#endif
extern "C" void kernel_launch(void* const* d_in, const int* in_sizes, int n_in, void* d_out, int out_size, void* d_ws, size_t ws_size, hipStream_t stream) {
    static int grid = 0;
    if (grid == 0) {
        int dev = 0, cus = 0;
        if (n_in != 33 || out_size != NT * D || ws_size < WS_NEED || hipGetDevice(&dev) != hipSuccess || hipDeviceGetAttribute(&cus, hipDeviceAttributeMultiprocessorCount, dev) != hipSuccess ||
            hipFuncSetAttribute((const void*)hybrid_fwd, hipFuncAttributeMaxDynamicSharedMemorySize, LDS_BYTES) != hipSuccess) { fprintf(stderr, "kernel_launch: bad configuration (n_in %d out %d ws %zu)\n", n_in, out_size, ws_size); grid = -1; }
        else grid = cus;
    }
    if (grid < 0) { nan_fill<<<256, 256, 0, stream>>>((float*)d_out, out_size); return; }
    (void)hipMemsetAsync((char*)d_ws + WS_CTL, 0, CTL_ZERO_BYTES, stream);
#ifdef MK_ZERO_G
    (void)hipMemsetAsync((char*)d_ws + WS_G, 0, (size_t)NT * 3072 * 2, stream);
#endif
    Args a{};
    for (int i = 0; i < 33; ++i) a.in[i] = (const float*)d_in[i];
    a.out = (float*)d_out; a.ws = (unsigned char*)d_ws;
#if MK_PER_PHASE
#ifdef MK_FUSE01
    a.ph_lo = 0; a.ph_hi = MK_STOP; hipLaunchKernelGGL(hybrid_fwd, dim3(grid), dim3(NTHR), LDS_BYTES, stream, a);
#else
    for (int ph = 0; ph < MK_STOP; ++ph) { a.ph_lo = ph; a.ph_hi = ph + 1; hipLaunchKernelGGL(hybrid_fwd, dim3(grid), dim3(NTHR), LDS_BYTES, stream, a); }
#endif
#ifdef MK_DUMP
    dump_k<<<2048, 256, 0, stream>>>(MK_DUMP, (const unsigned char*)d_ws, (float*)d_out);
#endif
#else
    a.ph_lo = 0; a.ph_hi = N_PHASES; hipLaunchKernelGGL(hybrid_fwd, dim3(grid), dim3(NTHR), LDS_BYTES, stream, a);
#endif
}
```

```cpp
#include <hip/hip_runtime.h>
#include <cstdio>
#include <cstdint>
#define MK_PER_PHASE 0
namespace pg8 {
#define PG8_LAS __attribute__((address_space(3)))
typedef unsigned short bf16_t;
typedef short bf16x8 __attribute__((ext_vector_type(8)));
typedef float f32x4 __attribute__((ext_vector_type(4)));
typedef unsigned u32x4 __attribute__((ext_vector_type(4)));
constexpr int BM = 256, BK = 64, HALF = 128, HTB = HALF * BK * 2  , STAGE_BYTES = 8 * HTB, NXCD = 8, WGM = 8;

__host__ __device__ __forceinline__ int lds_byte(int r, int c) { const int st = (r >> 4) * 2 + (c >> 5), rr = r & 15, cc = c & 31, ob = rr * 64 + cc * 2; return st * 1024 + (ob ^ (((ob >> 9) & 1) << 5)); }
__host__ __device__ __forceinline__ void stage_rc(int b, int& R, int& C) { const int st = b / 1024, sb = b % 1024, swz = sb ^ (((sb >> 9) & 1) << 5); R = (st >> 1) * 16 + swz / 64; C = (st & 1) * 32 + (swz % 64) / 2; }
__host__ __device__ __forceinline__ int perm32(int rho) { const int n = rho >> 4, i = rho & 15; return 8 * (i >> 2) + 4 * n + (i & 3); }

struct Unit { int pm, pn; };
struct Gemm { const bf16_t* A; const bf16_t* Bt; int M, N, K; };

struct StaticOrder {
    int nM, nN, nwg, G, c;
    __host__ __device__ void init(int M, int N, int G_, int c_) { nM = M / BM; nN = N / BM; nwg = nM * nN; G = G_; c = c_; }
    __host__ __device__ bool next(int i, Unit& u) const {
        const long L = (long)i * G + c; if (L >= nwg) return false;
        int wgid = (int)L; { const int q = nwg / NXCD, r = nwg % NXCD, xcd = wgid % NXCD, off = wgid / NXCD; wgid = (xcd < r ? xcd * (q + 1) : r * (q + 1) + (xcd - r) * q) + off; }
        const int nig = WGM * nN, gid = wgid / nig, fm = gid * WGM, gsz = (nM - fm) < WGM ? (nM - fm) : WGM;
        u.pm = fm + ((wgid % nig) % gsz); u.pn = (wgid % nig) / gsz; return true;
    }
    __device__ __forceinline__ void a_ready(const Unit&) const {}
    __device__ __forceinline__ void done(const Unit&) const {}
};

__device__ __forceinline__ unsigned cvt_pk_bf16(float lo, float hi) { unsigned r; asm volatile("v_cvt_pk_bf16_f32 %0, %1, %2" : "=v"(r) : "v"(lo), "v"(hi)); return r; }
typedef float f32x2 __attribute__((ext_vector_type(2)));
__device__ __forceinline__ f32x2 gelu_pk(f32x2 v) {
    const f32x2 av = __builtin_elementwise_abs(v), d = av * 0.2316418882f + 1.0f;
    f32x2 t; t.x = __builtin_amdgcn_rcpf(d.x); t.y = __builtin_amdgcn_rcpf(d.y);
    f32x2 q = t * 0.5307027145f + (-0.7265760135f); q = q * t + 0.7107068705f; q = q * t + (-0.142248368f); q = q * t + 0.127414796f; q = q * t;
    const f32x2 s = (v * v) * (-0.72134752044f);
    f32x2 e; e.x = __builtin_amdgcn_exp2f(s.x); e.y = __builtin_amdgcn_exp2f(s.y);
    const f32x2 m = v * (q * e), r = v - m;
    f32x2 o; o.x = v.x < 0.f ? m.x : r.x; o.y = v.y < 0.f ? m.y : r.y; return o;
}

template <int ACT  > struct EpiBf16 {
    static constexpr bool PERM = true, AFTER_DRAIN = false; static_assert(ACT == 0 || ACT == 1, "EpiBf16: ACT is 0 (none) or 1 (gelu_pk)");
    bf16_t* O; int ldc; const float* bias; int split_cols; size_t split_stride; float scale0;
    __device__ __forceinline__ void operator()(const f32x4 (&acc)[2][2][4][2], const Unit& u, int wr, int wc, int fr, int fq) const {
        const int row0 = u.pm * BM + wr * 64 + fr; int colt = u.pn * BM; bf16_t* base = O;
        float sc = 1.f; if (split_cols) { const int t = colt / split_cols; base += (size_t)t * split_stride; colt -= t * split_cols; if (t == 0) sc = scale0; }
        const int col0 = colt + wc * 32 + 8 * fq, bcol0 = u.pn * BM + wc * 32 + 8 * fq;
        f32x4 bv[2][2];
#pragma unroll
        for (int bj = 0; bj < 2; ++bj)
#pragma unroll
            for (int n = 0; n < 2; ++n) bv[bj][n] = bias ? *(const f32x4*)(bias + bcol0 + bj * HALF + 4 * n) : (f32x4){0.f, 0.f, 0.f, 0.f};
#pragma unroll
        for (int ai = 0; ai < 2; ++ai)
#pragma unroll
            for (int m = 0; m < 4; ++m) { bf16_t* rowp = base + (size_t)(row0 + ai * HALF + m * 16) * ldc + col0;
#pragma unroll
                for (int bj = 0; bj < 2; ++bj) { f32x4 v0 = acc[ai][bj][m][0] + bv[bj][0], v1 = acc[ai][bj][m][1] + bv[bj][1];
                    if (ACT == 1) { f32x2 a = gelu_pk((f32x2){v0[0], v0[1]}), b = gelu_pk((f32x2){v0[2], v0[3]}), c = gelu_pk((f32x2){v1[0], v1[1]}), d = gelu_pk((f32x2){v1[2], v1[3]});
                        v0 = (f32x4){a.x, a.y, b.x, b.y}; v1 = (f32x4){c.x, c.y, d.x, d.y}; }
                    v0 = v0 * sc; v1 = v1 * sc; u32x4 w; w.x = cvt_pk_bf16(v0[0], v0[1]); w.y = cvt_pk_bf16(v0[2], v0[3]); w.z = cvt_pk_bf16(v1[0], v1[1]); w.w = cvt_pk_bf16(v1[2], v1[3]);
                    *(u32x4*)(rowp + bj * HALF) = w; } }
    }
};
constexpr int NTOK = 32768;
__device__ __forceinline__ float sigm(float x) { return __builtin_amdgcn_rcpf(1.0f + __expf(-x)); }
__device__ __forceinline__ float bf_lo(unsigned u) { return __uint_as_float(u << 16); }
__device__ __forceinline__ float bf_hi(unsigned u) { return __uint_as_float(u & 0xffff0000u); }
typedef __bf16 bf16x2c __attribute__((ext_vector_type(2)));
__device__ __forceinline__ unsigned cvt2(float lo, float hi) { const f32x2 v = {lo, hi}; return __builtin_bit_cast(unsigned, __builtin_convertvector(v, bf16x2c)); }
__device__ __forceinline__ u32x4 pack8(const f32x4& v0, const f32x4& v1) { u32x4 w; w.x = cvt2(v0[0], v0[1]); w.y = cvt2(v0[2], v0[3]); w.z = cvt2(v1[0], v1[1]); w.w = cvt2(v1[2], v1[3]); return w; }
__device__ __forceinline__ void unpack8(const u32x4& w, f32x4& v0, f32x4& v1) { v0 = (f32x4){bf_lo(w.x), bf_hi(w.x), bf_lo(w.y), bf_hi(w.y)}; v1 = (f32x4){bf_lo(w.z), bf_hi(w.z), bf_lo(w.w), bf_hi(w.w)}; }

#ifndef MK_SIG
#define MK_SIG sigm
#endif
struct EpiInProj {
    static constexpr bool PERM = true, AFTER_DRAIN = false;
    bf16_t* P6; bf16_t* G; const float* gate_b;
    __device__ __forceinline__ void operator()(const f32x4 (&acc)[2][2][4][2], const Unit& u, int wr, int wc, int fr, int fq) const {
        const int row0 = u.pm * BM + wr * 64 + fr;
        if (u.pn < 9) {
#pragma unroll
            for (int bj = 0; bj < 2; ++bj) {
                const int c = u.pn * BM + bj * HALF + wc * 32 + 8 * fq;
                const int blk = c / 384, off = c - blk * 384, dblk = (0x254310 >> (4 * blk)) & 0xf;
                bf16_t* base = P6 + (size_t)dblk * ((size_t)NTOK * 384) + off;
                if (blk == 3) {
#pragma unroll
                    for (int ai = 0; ai < 2; ++ai)
#pragma unroll
                        for (int m = 0; m < 4; ++m) { const int row = row0 + ai * HALF + m * 16, bb = row >> 11, t = row & 2047;
                            bf16_t* dst = P6 + (size_t)4 * ((size_t)NTOK * 384) + ((size_t)((bb * 6 + (off >> 6)) * 64 + (off & 63))) * 2048 + t;
                            const u32x4 w = pack8(acc[ai][bj][m][0], acc[ai][bj][m][1]);
                            dst[0] = (bf16_t)(w.x & 0xffffu); dst[2048] = (bf16_t)(w.x >> 16); dst[2 * 2048] = (bf16_t)(w.y & 0xffffu); dst[3 * 2048] = (bf16_t)(w.y >> 16);
                            dst[4 * 2048] = (bf16_t)(w.z & 0xffffu); dst[5 * 2048] = (bf16_t)(w.z >> 16); dst[6 * 2048] = (bf16_t)(w.w & 0xffffu); dst[7 * 2048] = (bf16_t)(w.w >> 16); }
                } else {
#pragma unroll
                for (int ai = 0; ai < 2; ++ai)
#pragma unroll
                    for (int m = 0; m < 4; ++m) { const int row = row0 + ai * HALF + m * 16; *(u32x4*)(base + (size_t)row * 384) = pack8(acc[ai][bj][m][0], acc[ai][bj][m][1]); }
                }
            }
        } else {
#pragma unroll
            for (int bj = 0; bj < 2; ++bj) {
                const int cg = u.pn * BM + bj * HALF + wc * 32 + 8 * fq - 2304;
                const f32x4 b0 = *(const f32x4*)(gate_b + cg), b1 = *(const f32x4*)(gate_b + cg + 4);
#pragma unroll
                for (int ai = 0; ai < 2; ++ai)
#pragma unroll
                    for (int m = 0; m < 4; ++m) { const int row = row0 + ai * HALF + m * 16; f32x4 v0 = acc[ai][bj][m][0] + b0, v1 = acc[ai][bj][m][1] + b1;
#pragma unroll
                        for (int j = 0; j < 4; ++j) { v0[j] = MK_SIG(v0[j]); v1[j] = MK_SIG(v1[j]); }
                        *(u32x4*)(G + (size_t)row * 3072 + cg) = pack8(v0, v1); }
            }
        }
    }
};
struct EpiGlu {
    static constexpr bool PERM = true, AFTER_DRAIN = false;
    const bf16_t* Y5; bf16_t* OUT; const float* b_glu;
    __device__ __forceinline__ void operator()(const f32x4 (&acc)[2][2][4][2], const Unit& u, int wr, int wc, int fr, int fq) const {
        const int row0 = u.pm * BM + wr * 64 + fr;
#pragma unroll
        for (int bj = 0; bj < 2; ++bj) {
            const int c = u.pn * BM + bj * HALF + wc * 32 + 8 * fq;
            if (c < 384) {
                const f32x4 b0 = *(const f32x4*)(b_glu + c), b1 = *(const f32x4*)(b_glu + c + 4);
#pragma unroll
                for (int ai = 0; ai < 2; ++ai)
#pragma unroll
                    for (int m = 0; m < 4; ++m) { const int row = row0 + ai * HALF + m * 16; f32x4 v0 = acc[ai][bj][m][0] + b0, v1 = acc[ai][bj][m][1] + b1, y0, y1;
                        unpack8(*(const u32x4*)(Y5 + (size_t)row * 384 + c), y0, y1);
#pragma unroll
                        for (int j = 0; j < 4; ++j) { v0[j] = y0[j] * sigm(v0[j]); v1[j] = y1[j] * sigm(v1[j]); }
                        *(u32x4*)(OUT + (size_t)row * 384 + c) = pack8(v0, v1); asm volatile("" ::: "memory"); }
            }
        }
    }
};
struct EpiMerged {
    static constexpr bool PERM = true, AFTER_DRAIN = false;
    const bf16_t* G; bf16_t* MG;
    __device__ __forceinline__ void operator()(const f32x4 (&acc)[2][2][4][2], const Unit& u, int wr, int wc, int fr, int fq) const {
        const int n = u.pm >> 7, pm = u.pm & 127, pn = u.pn & 3;
        const int row0 = pm * BM + wr * 64 + fr;
#pragma unroll
        for (int bj = 0; bj < 2; ++bj) {
            const int c = pn * BM + bj * HALF + wc * 32 + 8 * fq;
#pragma unroll
            for (int ai = 0; ai < 2; ++ai)
#pragma unroll
                for (int m = 0; m < 4; ++m) { const int row = row0 + ai * HALF + m * 16; f32x4 g0, g1;
                    unpack8(*(const u32x4*)(G + (size_t)row * 3072 + n * 1024 + c), g0, g1);
                    f32x4 v0 = g0 * acc[ai][bj][m][0], v1 = g1 * acc[ai][bj][m][1];
                    if (n > 0) { f32x4 p0, p1; unpack8(*(const u32x4*)(MG + (size_t)row * 1024 + c), p0, p1); v0 += p0; v1 += p1; }
                    *(u32x4*)(MG + (size_t)row * 1024 + c) = pack8(v0, v1); asm volatile("" ::: "memory"); }
        }
    }
};
struct EpiResid {
    static constexpr bool PERM = false, AFTER_DRAIN = false;
    const float* base; float* out;
    __device__ __forceinline__ void operator()(const f32x4 (&acc)[2][2][4][2], const Unit& u, int wr, int wc, int fr, int fq) const {
        const int row0 = u.pm * BM + wr * 64 + fr, col0 = u.pn * BM + wc * 32 + 4 * fq;
#pragma unroll
        for (int ai = 0; ai < 2; ++ai)
#pragma unroll
            for (int m = 0; m < 4; ++m) { const size_t off = (size_t)(row0 + ai * HALF + m * 16) * 1024 + col0;
#pragma unroll
                for (int bj = 0; bj < 2; ++bj)
#pragma unroll
                    for (int n = 0; n < 2; ++n) { const f32x4 bs = *(const f32x4*)(base + off + bj * HALF + n * 16); *(f32x4*)(out + off + bj * HALF + n * 16) = bs + acc[ai][bj][m][n]; } asm volatile("" ::: "memory"); }
    }
};
struct EpiSwiglu {
    static constexpr bool PERM = true, AFTER_DRAIN = false;
    bf16_t* ACT; int ld; int nct;
    __device__ __forceinline__ void operator()(const f32x4 (&acc)[2][2][4][2], const Unit& u, int wr, int wc, int fr, int fq) const {
        const int row0 = u.pm * BM + wr * 64 + fr, c = (u.pn % nct) * HALF + wc * 32 + 8 * fq;
#pragma unroll
        for (int ai = 0; ai < 2; ++ai)
#pragma unroll
            for (int m = 0; m < 4; ++m) { const int row = row0 + ai * HALF + m * 16; f32x4 v0, v1;
#pragma unroll
                for (int j = 0; j < 4; ++j) { const float g0 = acc[ai][0][m][0][j], g1 = acc[ai][0][m][1][j]; v0[j] = g0 * sigm(g0) * acc[ai][1][m][0][j]; v1[j] = g1 * sigm(g1) * acc[ai][1][m][1][j]; }
                *(u32x4*)(ACT + (size_t)row * ld + c) = pack8(v0, v1); }
    }
};
struct EpiMoeDown {
    static constexpr bool PERM = false, AFTER_DRAIN = false;
    float* X; const int* tok; const float* wt;
    __device__ __forceinline__ void operator()(const f32x4 (&acc)[2][2][4][2], const Unit& u, int wr, int wc, int fr, int fq) const {
        const int slot0 = u.pm * BM + wr * 64 + fr, col0 = (u.pn & 3) * BM + wc * 32 + 4 * fq;
#pragma unroll
        for (int ai = 0; ai < 2; ++ai)
#pragma unroll
            for (int m = 0; m < 4; ++m) { const int slot = slot0 + ai * HALF + m * 16; const int t = tok[slot];
                if (t >= 0) { const float w = wt[slot]; float* rowp = X + (size_t)t * 1024 + col0;
#pragma unroll
                    for (int bj = 0; bj < 2; ++bj)
#pragma unroll
                        for (int n = 0; n < 2; ++n) { const f32x4 bs = *(const f32x4*)(rowp + bj * HALF + n * 16); *(f32x4*)(rowp + bj * HALF + n * 16) = bs + w * acc[ai][bj][m][n]; } } asm volatile("" ::: "memory"); }
    }
};
struct MergedOrder {
    StaticOrder so;
    __device__ bool next(int i, Unit& u) const { Unit t; if (!so.next(i / 3, t)) return false; const int n = i % 3; u.pm = n * 128 + t.pm; u.pn = n * 4 + t.pn; return true; }
    __device__ __forceinline__ void a_ready(const Unit&) const {}
    __device__ __forceinline__ void done(const Unit&) const {}
};
struct MoeOrder {
    StaticOrder so; const PG8_LAS int* tileExp;
    __device__ bool next(int i, Unit& u) const { Unit t; if (!so.next(i, t)) return false; u.pm = t.pm; u.pn = tileExp[t.pm] * so.nN + t.pn; return true; }
    __device__ __forceinline__ void a_ready(const Unit&) const {}
    __device__ __forceinline__ void done(const Unit&) const {}
};
template <class Epi, class Sched, bool ALIGN_EPI = false, bool SP2 = false>
__device__ __forceinline__ void gemm_phase(PG8_LAS unsigned char* lds, const Gemm g, const Sched& S, const Epi& E) {
    int tid_l = threadIdx.x; asm volatile("" : "+v"(tid_l));
    const int tid = tid_l, wid = __builtin_amdgcn_readfirstlane(tid >> 6), lane = tid & 63, wr = wid >> 2, wc = wid & 3, fr = lane & 15, fq = lane >> 4;
    int K_l = g.K; asm volatile("" : "+s"(K_l));
    const int K = K_l, nt = K / BK;
    unsigned voffA[2], voffB[2];
#pragma unroll
    for (int i = 0; i < 2; ++i) { int R, C; stage_rc(tid * 16 + i * 8192, R, C); const int Rb = Epi::PERM ? ((R & ~31) + perm32(R & 31)) : R;
        voffA[i] = (unsigned)(R * K + C) * 2u; voffB[i] = (unsigned)(Rb * K + C) * 2u; }
    const size_t kstep = (size_t)(BK * 2);
    const size_t hstep = (size_t)HALF * K * 2;
    const size_t tstep = 2 * hstep;
    const unsigned ldsw = (unsigned)wid * 1024u;
    const int aoff = lds_byte(wr * 64 + fr, fq * 8), boff = lds_byte(wc * 32 + fr, fq * 8);
#define PG8_SA(b, h) (((b) * 2 + (h)) * HTB)
#define PG8_SB(b, h) ((4 + (b) * 2 + (h)) * HTB)
#define PG8_STAGE(bufoff, gbase, voff) do { _Pragma("unroll") for (int _i = 0; _i < 2; ++_i) \
        __builtin_amdgcn_global_load_lds((const unsigned*)((const char*)(gbase) + (voff)[_i]), (PG8_LAS unsigned*)(lds + (bufoff) + ldsw + _i * 8192), 16, 0, 0); } while (0)
#define PG8_LDA(dst, b, h) do { _Pragma("unroll") for (int m = 0; m < 4; ++m) _Pragma("unroll") for (int k = 0; k < 2; ++k) dst[m][k] = *(const PG8_LAS bf16x8*)(lds + PG8_SA(b, h) + aoff + m * 2048 + k * 1024); } while (0)
#define PG8_LDB(dst, b, h) do { _Pragma("unroll") for (int n = 0; n < 2; ++n) _Pragma("unroll") for (int k = 0; k < 2; ++k) dst[n][k] = *(const PG8_LAS bf16x8*)(lds + PG8_SB(b, h) + boff + n * 2048 + k * 1024); } while (0)
#define PG8_MMA(ai, bj, At, Bt) do { __builtin_amdgcn_s_setprio(1); _Pragma("unroll") for (int m = 0; m < 4; ++m) _Pragma("unroll") for (int n = 0; n < 2; ++n) _Pragma("unroll") for (int k = 0; k < 2; ++k) \
        acc[ai][bj][m][n] = __builtin_amdgcn_mfma_f32_16x16x32_bf16(Bt[n][k], At[m][k], acc[ai][bj][m][n], 0, 0, 0); __builtin_amdgcn_s_setprio(0); } while (0)
#define PG8_WAIT_V(n) asm volatile("s_waitcnt vmcnt(" #n ")" ::: "memory")
#define PG8_WAIT_L(n) asm volatile("s_waitcnt lgkmcnt(" #n ")" ::: "memory")
#define PG8_BAR __builtin_amdgcn_s_barrier()
#define PG8_SCHED __builtin_amdgcn_sched_barrier(0)
    Unit cur, nxt; int ui = 0;
    if (!S.next(0, cur)) return;
    f32x4 acc[2][2][4][2];
#pragma unroll
    for (int a = 0; a < 2; ++a)
#pragma unroll
        for (int b = 0; b < 2; ++b)
#pragma unroll
            for (int m = 0; m < 4; ++m)
#pragma unroll
                for (int n = 0; n < 2; ++n) acc[a][b][m][n] = (f32x4){0.f, 0.f, 0.f, 0.f};
    bf16x8 At[4][2], B0[2][2], B1[2][2];
    const char* cA = (const char*)g.A + (size_t)cur.pm * tstep; const char* cB = (const char*)g.Bt + (size_t)cur.pn * tstep;
    S.a_ready(cur);
    if constexpr (SP2) {
        PG8_STAGE(PG8_SB(0, 0), cB, voffB); PG8_STAGE(PG8_SB(0, 1), cB + hstep, voffB); PG8_STAGE(PG8_SA(0, 0), cA, voffA); PG8_STAGE(PG8_SA(0, 1), cA + hstep, voffA);
        if (wr == 1) PG8_BAR;
        PG8_WAIT_V(2); PG8_BAR;
        PG8_STAGE(PG8_SB(1, 0), cB + kstep, voffB); PG8_STAGE(PG8_SA(1, 0), cA + kstep, voffA); PG8_STAGE(PG8_SB(1, 1), cB + hstep + kstep, voffB);
        PG8_WAIT_V(6); PG8_BAR;
    } else {
        PG8_STAGE(PG8_SB(0, 0), cB, voffB); PG8_STAGE(PG8_SA(0, 0), cA, voffA); PG8_STAGE(PG8_SB(0, 1), cB + hstep, voffB); PG8_STAGE(PG8_SA(0, 1), cA + hstep, voffA);
        if (wr == 1) PG8_BAR;
        PG8_WAIT_V(4); PG8_BAR;
        PG8_STAGE(PG8_SB(1, 0), cB + kstep, voffB); PG8_STAGE(PG8_SA(1, 0), cA + kstep, voffA); PG8_STAGE(PG8_SB(1, 1), cB + hstep + kstep, voffB);
        PG8_WAIT_V(6); PG8_BAR;
    }
    for (;;) {
        const bool has_next = S.next(ui + 1, nxt);
        const char* nA = has_next ? (const char*)g.A + (size_t)nxt.pm * tstep : cA; const char* nB = has_next ? (const char*)g.Bt + (size_t)nxt.pn * tstep : cB;
        for (int t = 0; t < nt; t += 2) {
            const bool last = (t == nt - 2);
            const char* a1 = cA + (size_t)(t + 1) * kstep;
            const char* a2 = last ? nA : cA + (size_t)(t + 2) * kstep; const char* b2 = last ? nB : cB + (size_t)(t + 2) * kstep;
            const char* a3 = a2 + kstep; const char* b3 = b2 + kstep;
            if (last && has_next) S.a_ready(nxt);
            if constexpr (SP2) {
            PG8_LDB(B0, 0, 0); PG8_LDB(B1, 0, 1); PG8_SCHED; PG8_LDA(At, 0, 0); PG8_STAGE(PG8_SA(1, 1), a1 + hstep, voffA);
            PG8_WAIT_V(8); PG8_WAIT_L(0); PG8_BAR; PG8_MMA(0, 0, At, B0); PG8_MMA(0, 1, At, B1); PG8_BAR; PG8_SCHED;
            PG8_LDA(At, 0, 1); PG8_STAGE(PG8_SB(0, 0), b2, voffB); PG8_STAGE(PG8_SB(0, 1), b2 + hstep, voffB); PG8_STAGE(PG8_SA(0, 0), a2, voffA);
            PG8_WAIT_V(8); PG8_WAIT_L(0); PG8_BAR; PG8_MMA(1, 0, At, B0); PG8_MMA(1, 1, At, B1); PG8_BAR; PG8_SCHED;
            PG8_LDB(B0, 1, 0); PG8_LDB(B1, 1, 1); PG8_SCHED; PG8_LDA(At, 1, 0); PG8_STAGE(PG8_SA(0, 1), a2 + hstep, voffA);
            PG8_WAIT_V(8); PG8_WAIT_L(0); PG8_BAR; PG8_MMA(0, 0, At, B0); PG8_MMA(0, 1, At, B1); PG8_BAR; PG8_SCHED;
            PG8_LDA(At, 1, 1); PG8_STAGE(PG8_SB(1, 0), b3, voffB); PG8_STAGE(PG8_SB(1, 1), b3 + hstep, voffB); PG8_STAGE(PG8_SA(1, 0), a3, voffA);
            PG8_WAIT_V(8); PG8_WAIT_L(0); PG8_BAR; PG8_MMA(1, 0, At, B0); PG8_MMA(1, 1, At, B1); PG8_BAR; PG8_SCHED;
            } else {
            PG8_LDB(B0, 0, 0); PG8_SCHED; PG8_LDA(At, 0, 0); PG8_STAGE(PG8_SA(1, 1), a1 + hstep, voffA);
            PG8_WAIT_L(8); PG8_BAR; PG8_WAIT_L(0); PG8_MMA(0, 0, At, B0); PG8_BAR; PG8_SCHED;
            PG8_LDB(B1, 0, 1); PG8_STAGE(PG8_SB(0, 0), b2, voffB);
            PG8_BAR; PG8_WAIT_L(0); PG8_MMA(0, 1, At, B1); PG8_BAR;
            PG8_LDA(At, 0, 1); PG8_STAGE(PG8_SA(0, 0), a2, voffA);
            PG8_BAR; PG8_WAIT_L(0); PG8_MMA(1, 0, At, B0); PG8_BAR; PG8_SCHED;
            PG8_STAGE(PG8_SB(0, 1), b2 + hstep, voffB);
            PG8_WAIT_V(6); PG8_BAR; PG8_MMA(1, 1, At, B1); PG8_BAR;
            PG8_LDB(B0, 1, 0); PG8_SCHED; PG8_LDA(At, 1, 0); PG8_STAGE(PG8_SA(0, 1), a2 + hstep, voffA);
            PG8_WAIT_L(8); PG8_BAR; PG8_WAIT_L(0); PG8_MMA(0, 0, At, B0); PG8_BAR; PG8_SCHED;
            PG8_LDB(B1, 1, 1); PG8_STAGE(PG8_SB(1, 0), b3, voffB);
            PG8_BAR; PG8_WAIT_L(0); PG8_MMA(0, 1, At, B1); PG8_BAR;
            PG8_LDA(At, 1, 1); PG8_STAGE(PG8_SA(1, 0), a3, voffA);
            PG8_BAR; PG8_WAIT_L(0); PG8_MMA(1, 0, At, B0); PG8_BAR; PG8_SCHED;
            PG8_STAGE(PG8_SB(1, 1), b3 + hstep, voffB);
            PG8_WAIT_V(6); PG8_BAR; PG8_MMA(1, 1, At, B1); PG8_BAR;
            }
        }
        if constexpr (ALIGN_EPI) { if (wr == 0) PG8_BAR; }
        if constexpr (!Epi::AFTER_DRAIN) { E(acc, cur, wr, wc, fr, fq); S.done(cur); }
        if (!has_next) break;
#pragma unroll
        for (int a = 0; a < 2; ++a)
#pragma unroll
            for (int b = 0; b < 2; ++b)
#pragma unroll
                for (int m = 0; m < 4; ++m)
#pragma unroll
                    for (int n = 0; n < 2; ++n) acc[a][b][m][n] = (f32x4){0.f, 0.f, 0.f, 0.f};
        cur = nxt; cA = nA; cB = nB; ++ui;
        if constexpr (ALIGN_EPI) { if (wr == 1) PG8_BAR; }
    }
    PG8_WAIT_V(0);
    if constexpr (!ALIGN_EPI) { if (wr == 0) PG8_BAR; }
    PG8_BAR;
    if constexpr (Epi::AFTER_DRAIN) { E.fused(acc, cur, wr, wc, fr, fq, lds, wid, lane); S.done(cur); }
#undef PG8_SA
#undef PG8_SB
#undef PG8_STAGE
#undef PG8_LDA
#undef PG8_LDB
#undef PG8_MMA
#undef PG8_WAIT_V
#undef PG8_WAIT_L
#undef PG8_BAR
#undef PG8_SCHED
}
}

#define GAS __attribute__((address_space(1)))
#define LAS __attribute__((address_space(3)))
typedef unsigned short bf16;
typedef unsigned v4u __attribute__((ext_vector_type(4)));
typedef unsigned v2u __attribute__((ext_vector_type(2)));
typedef float f32x4 __attribute__((ext_vector_type(4)));
#define LDS_WAIT() asm volatile("s_waitcnt lgkmcnt(0)" ::: "memory")
#define VM_WAIT() asm volatile("s_waitcnt vmcnt(0)" ::: "memory")

constexpr int NWAVES = 8, NTHR = 512;
constexpr int D = 1024, NB = 16, T = 2048, NT = NB * T, W = 384, INW = 5376, DFF = 2816, NE = 8, DFE = 3584, NG = 24, NP = 64, NH = 16;
constexpr float RMS_EPS = 1e-6f;
constexpr int MAXT = 136;
static_assert(NT == pg8::NTOK, "token count");

constexpr size_t MiB = 1u << 20;
constexpr size_t WS_CTL = 0, CTL_ZERO_BYTES = 65536;
constexpr size_t WS_MISC = 1 * MiB;
constexpr size_t MS_S5PAR = 0, MS_AGG = 524288, MS_ROUTE = 1572864, MS_HIST = 2097152, MS_TOK = 2162688, MS_WTS = 2621440;
constexpr size_t WS_W = 5 * MiB;
constexpr size_t W_IN = 0, W_GLU = W_IN + (size_t)2 * INW * D * 2, W_BR = W_GLU + (size_t)2 * 512 * W * 2, W_OUT = W_BR + (size_t)2 * 3 * D * W * 2,
                 W_FGU = W_OUT + (size_t)2 * D * D * 2, W_FD = W_FGU + (size_t)2 * DFF * D * 2, W_END = W_FD + (size_t)D * DFF * 2;
static_assert(W_END <= 47 * MiB, "weights region");
constexpr size_t WS_H = 52 * MiB, WS_Y5 = 116 * MiB, WS_P6 = 140 * MiB, WS_G = 284 * MiB;
constexpr size_t P6_BLK = (size_t)NT * W * 2;
constexpr size_t WS_DACT = WS_P6;
constexpr size_t WS_MWGU = 5 * MiB, WS_MWD = 117 * MiB, WS_H2 = 173 * MiB, WS_HP = 237 * MiB, WS_ACT = 305 * MiB, WS_NEED = 543 * MiB;
static_assert(WS_MWGU + (size_t)NE * 2 * DFE * D * 2 <= WS_MWD && WS_MWD + (size_t)NE * D * DFE * 2 <= WS_H2 && WS_HP + (size_t)MAXT * 256 * D * 2 <= WS_ACT && WS_ACT + (size_t)MAXT * 256 * DFE * 2 <= WS_NEED, "moe map");
constexpr int CW_BAR = 4096;
constexpr int RING_BYTES = 131072, MISC_OFF = RING_BYTES + 320, LDS_BYTES = 147456;
constexpr int MT_OFF = MISC_OFF + 128;
constexpr int MT_TEXP = 0, MT_NT = 2 * MAXT, MT_OFFS = MT_NT + 2, MT_BASE = MT_OFFS + 16, MT_TOT = MT_BASE + 16, MT_LE = MT_TOT + 16, MT_WORDS = MT_LE + 256;
static_assert(MT_OFF + MT_WORDS * 4 <= LDS_BYTES, "LDS map");

#define XB_TMO      128
#define XB_XCNT(j)  (256  + 64 * (j))
#define XB_XSUB(j)  (1280 + 64 * (j))
#define XB_XGEN(j)  (2304 + 64 * (j))
#define XB_TOP      3328
#define XB_TOPGEN   3392
#define XCD_BAR_WORDS 3456
#define XB_SPIN_CAP (1u << 18)
__device__ __forceinline__ unsigned xb_ld(unsigned* p)              { return __hip_atomic_load(p, __ATOMIC_RELAXED, __HIP_MEMORY_SCOPE_AGENT); }
__device__ __forceinline__ unsigned xb_add(unsigned* p, unsigned v) { return __hip_atomic_fetch_add(p, v, __ATOMIC_RELAXED, __HIP_MEMORY_SCOPE_AGENT); }
__device__ __forceinline__ unsigned xb_xcc_id() { return (unsigned)__builtin_amdgcn_s_getreg((3 << 11) | 20) & 0xFu; }
#define XB_SPIN(cond, bar) do { unsigned _sp = 0; while (cond) { __builtin_amdgcn_s_sleep(1); \
    if ((++_sp & 255u) == 0u) { if (xb_ld(&(bar)[XB_TMO])) break; if (_sp > XB_SPIN_CAP) { atomicAdd(&(bar)[XB_TMO], 1u); break; } } } } while (0)
struct XcdBarrier { unsigned* bar; unsigned x; volatile LAS unsigned* st; };
__device__ __forceinline__ XcdBarrier xcd_barrier_post(unsigned* bar, volatile LAS unsigned* st) {
    XcdBarrier b; b.bar = bar; b.x = xb_xcc_id(); b.st = st;
    if (threadIdx.x == 0) (void)xb_add(&bar[XB_XCNT(b.x)], 1u);
    return b;
}
__device__ __forceinline__ void xcd_barrier_complete(unsigned* bar, unsigned x, unsigned& nloc, unsigned& nx) {
    const unsigned G = gridDim.x * gridDim.y * gridDim.z;
    unsigned sum, cnt, mine, sp = 0u;
    for (;;) {
        sum = 0u; cnt = 0u; mine = 0u;
#pragma unroll
        for (unsigned j = 0; j < 16; ++j) { const unsigned c = xb_ld(&bar[XB_XCNT(j)]); sum += c; cnt += (c > 0u) ? 1u : 0u; mine = (j == x) ? c : mine; }
        if (sum == G) break;
        __builtin_amdgcn_s_sleep(1);
        if ((++sp & 255u) == 0u) { if (xb_ld(&bar[XB_TMO])) break; if (sp > XB_SPIN_CAP) { atomicAdd(&bar[XB_TMO], 1u); break; } }
    }
    nloc = mine > 0u ? mine : 1u; nx = cnt > 0u ? cnt : 1u;
}
__device__ __forceinline__ void xcd_barrier(const XcdBarrier& b) {
    asm volatile("s_waitcnt vmcnt(0)" ::: "memory");
    __syncthreads();
    if (threadIdx.x == 0) {
        unsigned* bar = b.bar;
        __builtin_amdgcn_s_waitcnt(0);
        const unsigned nloc = b.st[0], nx = b.st[1];
        const unsigned old = xb_add(&bar[XB_XSUB(b.x)], 1u);
        const unsigned gen = old / nloc;
        if (old + 1u == (gen + 1u) * nloc) {
            __builtin_amdgcn_fence(__ATOMIC_RELEASE, "agent");
            asm volatile("s_waitcnt vmcnt(0)" ::: "memory");
            const unsigned og = xb_add(&bar[XB_TOP], 1u);
            const unsigned tg = og / nx;
            if (og + 1u == (tg + 1u) * nx) xb_add(&bar[XB_TOPGEN], 1u);
            else XB_SPIN(xb_ld(&bar[XB_TOPGEN]) == tg, bar);
            __builtin_amdgcn_fence(__ATOMIC_ACQUIRE, "agent");
            xb_add(&bar[XB_XGEN(b.x)], 1u);
            asm volatile("s_waitcnt vmcnt(0)" ::: "memory");
        } else {
            XB_SPIN(xb_ld(&bar[XB_XGEN(b.x)]) == gen, bar);
            __builtin_amdgcn_fence(__ATOMIC_ACQUIRE, "agent");
            asm volatile("s_waitcnt vmcnt(0)" ::: "memory");
        }
    }
    __syncthreads();
}

__device__ __forceinline__ void xcd_barrier_census(const XcdBarrier& b) {
    if (threadIdx.x == 0) { unsigned nloc, nx; xcd_barrier_complete(b.bar, b.x, nloc, nx); b.st[0] = nloc; b.st[1] = nx; }
    __syncthreads();
}

__device__ __forceinline__ unsigned f2bf(float f) { unsigned u = __builtin_bit_cast(unsigned, f); return (u + 0x7fffu + ((u >> 16) & 1u)) >> 16; }
__device__ __forceinline__ unsigned pk2(float lo, float hi) { return f2bf(lo) | (f2bf(hi) << 16); }
__device__ __forceinline__ float bf2f(unsigned short b) { return __uint_as_float(((unsigned)b) << 16); }
__device__ __forceinline__ float wave_sum(float v) {
#pragma unroll
    for (int o = 1; o < 64; o <<= 1) v += __shfl_xor(v, o);
    return v;
}
__device__ __forceinline__ float rdlane(float v, int l) { return __int_as_float(__builtin_amdgcn_readlane(__float_as_int(v), l)); }
__device__ __forceinline__ float sigmf(float x) { return 1.0f / (1.0f + __expf(-x)); }
__device__ __forceinline__ float gelu_tanh(float x) { const float z = 0.7978845608028654f * (x + 0.044715f * x * x * x); return x * sigmf(2.0f * z); }
__device__ __forceinline__ float softplusf(float z) { return fmaxf(z, 0.f) + log1pf(__expf(-fabsf(z))); }

__device__ __forceinline__ void tr_item(const float* W, int K, int N, bf16* WT, int kind, int aux, LAS float* scr, int item, int lane) {
    const int nblk = N / 32, kb = item / nblk, nb = item - kb * nblk, k0 = 64 * kb, n0 = 32 * nb;
    const int drow0 = (kind == 0) ? (aux + n0) : (256 * (n0 >> 7) + aux + (n0 & 127));
#pragma unroll 8
    for (int i = 0; i < 32; ++i) { const int kk = 2 * i + (lane >> 5); scr[kk * 33 + (lane & 31)] = W[(size_t)(k0 + kk) * N + n0 + (lane & 31)]; }
    LDS_WAIT();
    const int c = lane & 7;
#pragma unroll
    for (int j = 0; j < 4; ++j) { const int n = (lane >> 3) + 8 * j; const LAS float* s = scr + (8 * c) * 33 + n;
        v4u o; o.x = pk2(s[0 * 33], s[1 * 33]); o.y = pk2(s[2 * 33], s[3 * 33]); o.z = pk2(s[4 * 33], s[5 * 33]); o.w = pk2(s[6 * 33], s[7 * 33]);
        *(GAS v4u*)(WT + (size_t)(drow0 + n) * K + k0 + 8 * c) = o; }
    LDS_WAIT();
}
__device__ __forceinline__ void rms_row(const float* xrow, const float* gain, bf16* orow, int lane, f32x4 (&v)[4]) {
    const f32x4* xr = (const f32x4*)xrow + lane; const f32x4* gr = (const f32x4*)gain + lane;
    float s = 0.f;
#pragma unroll
    for (int j = 0; j < 4; ++j) { v[j] = xr[64 * j]; s += (v[j].x * v[j].x + v[j].y * v[j].y) + (v[j].z * v[j].z + v[j].w * v[j].w); }
    const float rs = 1.0f / sqrtf(wave_sum(s) * (1.f / D) + RMS_EPS);
    unsigned long long* o8 = (unsigned long long*)orow + lane;
#pragma unroll
    for (int j = 0; j < 4; ++j) { v[j] = v[j] * rs * gr[64 * j]; o8[64 * j] = (unsigned long long)pk2(v[j].x, v[j].y) | ((unsigned long long)pk2(v[j].z, v[j].w) << 32); }
}

__device__ __forceinline__ void s5_simple(const bf16* U, bf16* Y5, const float* par, const float* c_re, const float* c_im, const float* dvec, LAS unsigned char* lds, int G, int tid) {
    const int lane = tid & 63, w = tid >> 6;
    LAS float* E = (LAS float*)lds;
    LAS float* CM = E + 1024;
    LAS float* SB = CM + 2048 + w * (16 * 130);
    for (int item = blockIdx.x; item < NB * NG; item += G) {
        const int b = item / NG, g = item % NG;
#pragma unroll
        for (int k = 0; k < 4; ++k) { const int idx = tid + 512 * k, pq = idx >> 4, h = idx & 15;
            CM[idx] = pq < 64 ? c_re[(g * 16 + h) * 64 + pq] : -c_im[(g * 16 + h) * 64 + pq - 64]; }
        const float* pp = par + (size_t)(g * 64 + lane) * 34;
        const float are = pp[0], aim = pp[1];
        float bre[16], bim[16];
#pragma unroll
        for (int h = 0; h < 16; ++h) { bre[h] = pp[2 + h]; bim[h] = pp[18 + h]; }
        const int t0 = 256 * w;
        const bf16* ub = U + (size_t)(b * T + t0) * W + 16 * g;
        const int lt = lane >> 4, lh = lane & 15;
        float sre = 0.f, sim = 0.f;
        for (int blk = 0; blk < 16; ++blk) {
            float uu[4];
#pragma unroll
            for (int q = 0; q < 4; ++q) uu[q] = bf2f(ub[(size_t)(blk * 16 + q * 4 + lt) * W + lh]);
#pragma unroll
            for (int tl = 0; tl < 16; ++tl) {
                float br = 0.f, bi = 0.f;
#pragma unroll
                for (int h = 0; h < 16; ++h) { const float uv = rdlane(uu[tl >> 2], (tl & 3) * 16 + h); br += bre[h] * uv; bi += bim[h] * uv; }
                const float nre = are * sre - aim * sim + br, nim = are * sim + aim * sre + bi; sre = nre; sim = nim;
            }
        }
        E[w * 128 + lane] = sre; E[w * 128 + 64 + lane] = sim;
        __syncthreads();
        float pr = are, pi = aim;
#pragma unroll
        for (int k = 0; k < 8; ++k) { const float nr = pr * pr - pi * pi, ni = 2.f * pr * pi; pr = nr; pi = ni; }
        sre = 0.f; sim = 0.f;
        for (int k = 0; k < w; ++k) { const float er = E[k * 128 + lane], ei = E[k * 128 + 64 + lane]; const float nre = pr * sre - pi * sim + er, nim = pr * sim + pi * sre + ei; sre = nre; sim = nim; }
        const int ctl = lane >> 2, chq = lane & 3;
        const f32x4 dv = *(const f32x4*)(dvec + 16 * g + 4 * chq);
        for (int blk = 0; blk < 16; ++blk) {
            float uu[4];
#pragma unroll
            for (int q = 0; q < 4; ++q) uu[q] = bf2f(ub[(size_t)(blk * 16 + q * 4 + lt) * W + lh]);
            const v2u ur = *(const v2u*)(ub + (size_t)(blk * 16 + ctl) * W + 4 * chq);
#pragma unroll
            for (int tl = 0; tl < 16; ++tl) {
                float br = 0.f, bi = 0.f;
#pragma unroll
                for (int h = 0; h < 16; ++h) { const float uv = rdlane(uu[tl >> 2], (tl & 3) * 16 + h); br += bre[h] * uv; bi += bim[h] * uv; }
                const float nre = are * sre - aim * sim + br, nim = are * sim + aim * sre + bi; sre = nre; sim = nim;
                SB[tl * 130 + lane] = sre; SB[tl * 130 + 64 + lane] = sim;
            }
            LDS_WAIT();
            f32x4 acc = (f32x4){0.f, 0.f, 0.f, 0.f};
            const LAS float* srow = SB + ctl * 130;
            for (int pq = 0; pq < 128; ++pq) { const float sv = srow[pq]; const f32x4 cv = *(const LAS f32x4*)(CM + pq * 16 + 4 * chq); acc += sv * cv; }
            LDS_WAIT();
            const float u0 = __uint_as_float(ur.x << 16), u1 = __uint_as_float(ur.x & 0xffff0000u), u2 = __uint_as_float(ur.y << 16), u3 = __uint_as_float(ur.y & 0xffff0000u);
            const float y0 = gelu_tanh(acc.x + dv.x * u0), y1 = gelu_tanh(acc.y + dv.y * u1), y2 = gelu_tanh(acc.z + dv.z * u2), y3 = gelu_tanh(acc.w + dv.w * u3);
            v2u o; o.x = pk2(y0, y1); o.y = pk2(y2, y3);
            *(v2u*)(Y5 + (size_t)(b * T + t0 + blk * 16 + ctl) * W + 16 * g + 4 * chq) = o;
        }
        __syncthreads();
    }
}

__device__ __forceinline__ void attn_simple(const bf16* Q, const bf16* Kb, const bf16* Vb, bf16* O, int gtid, int nthreads) {
    for (int idx = gtid; idx < NB * 6 * T; idx += nthreads) {
        const int t = idx % T, bh = idx / T, b = bh / 6, h = bh % 6;
        const size_t tok = (size_t)b * T + t;
        float q[64], acc[64];
        { const v4u* qp = (const v4u*)(Q + tok * W + 64 * h);
#pragma unroll
          for (int i = 0; i < 8; ++i) { const v4u r = qp[i];
              q[8 * i + 0] = 0.125f * __uint_as_float(r.x << 16); q[8 * i + 1] = 0.125f * __uint_as_float(r.x & 0xffff0000u); q[8 * i + 2] = 0.125f * __uint_as_float(r.y << 16); q[8 * i + 3] = 0.125f * __uint_as_float(r.y & 0xffff0000u);
              q[8 * i + 4] = 0.125f * __uint_as_float(r.z << 16); q[8 * i + 5] = 0.125f * __uint_as_float(r.z & 0xffff0000u); q[8 * i + 6] = 0.125f * __uint_as_float(r.w << 16); q[8 * i + 7] = 0.125f * __uint_as_float(r.w & 0xffff0000u); } }
#pragma unroll
        for (int i = 0; i < 64; ++i) acc[i] = 0.f;
        float R = 0.f;
        for (int s = t - 1; s >= 0 && R > -100.f; --s) {
            const size_t ks = ((size_t)b * T + s) * W + 64 * h;
            const v4u* kp = (const v4u*)(Kb + ks);
            float z = 0.f;
#pragma unroll
            for (int i = 0; i < 8; ++i) { const v4u r = kp[i];
                z += q[8 * i + 0] * __uint_as_float(r.x << 16) + q[8 * i + 1] * __uint_as_float(r.x & 0xffff0000u) + q[8 * i + 2] * __uint_as_float(r.y << 16) + q[8 * i + 3] * __uint_as_float(r.y & 0xffff0000u)
                   + q[8 * i + 4] * __uint_as_float(r.z << 16) + q[8 * i + 5] * __uint_as_float(r.z & 0xffff0000u) + q[8 * i + 6] * __uint_as_float(r.w << 16) + q[8 * i + 7] * __uint_as_float(r.w & 0xffff0000u); }
            const float sp = softplusf(z);
            const float wgt = __expf(z - sp + R);
            R -= sp;
            const v4u* vp = (const v4u*)(Vb + ks);
#pragma unroll
            for (int i = 0; i < 8; ++i) { const v4u r = vp[i];
                acc[8 * i + 0] += wgt * __uint_as_float(r.x << 16); acc[8 * i + 1] += wgt * __uint_as_float(r.x & 0xffff0000u); acc[8 * i + 2] += wgt * __uint_as_float(r.y << 16); acc[8 * i + 3] += wgt * __uint_as_float(r.y & 0xffff0000u);
                acc[8 * i + 4] += wgt * __uint_as_float(r.z << 16); acc[8 * i + 5] += wgt * __uint_as_float(r.z & 0xffff0000u); acc[8 * i + 6] += wgt * __uint_as_float(r.w << 16); acc[8 * i + 7] += wgt * __uint_as_float(r.w & 0xffff0000u); }
        }
        v4u* op = (v4u*)(O + tok * W + 64 * h);
#pragma unroll
        for (int i = 0; i < 8; ++i) { v4u o; o.x = pk2(acc[8 * i], acc[8 * i + 1]); o.y = pk2(acc[8 * i + 2], acc[8 * i + 3]); o.z = pk2(acc[8 * i + 4], acc[8 * i + 5]); o.w = pk2(acc[8 * i + 6], acc[8 * i + 7]); op[i] = o; }
    }
}


typedef short bf16x8v __attribute__((ext_vector_type(8)));
typedef float f32x16 __attribute__((ext_vector_type(16)));
typedef float f32x2v __attribute__((ext_vector_type(2)));
typedef __bf16 bf16x2cv __attribute__((ext_vector_type(2)));
__device__ __forceinline__ unsigned cvt2f(float lo, float hi) { const f32x2v v = {lo, hi}; return __builtin_bit_cast(unsigned, __builtin_convertvector(v, bf16x2cv)); }
__device__ __forceinline__ void attn_mfma(const bf16* Q, const bf16* Kb, const bf16* VT, bf16* O, int gw, int ngw, int lane) {
    const int r = lane & 31, hf = lane >> 5;
    for (int item = gw; item < NB * 6 * 64; item += ngw) {
        const int qb = 63 - (item & 63), bh = item >> 6, b = bh / 6, h = bh % 6, q0 = qb * 32;
        const bf16* qrow = Q + (size_t)(b * T + q0 + r) * W + 64 * h + 8 * hf;
        bf16x8v qf[4];
#pragma unroll
        for (int ks = 0; ks < 4; ++ks) qf[ks] = *(const bf16x8v*)(qrow + 16 * ks);
        f32x16 o0, o1;
#pragma unroll
        for (int i = 0; i < 16; ++i) { o0[i] = 0.f; o1[i] = 0.f; }
        float R = 0.f;
        const bf16* kbase = Kb + (size_t)(b * T) * W + 64 * h + 8 * hf;
        const bf16* vbase = VT + (size_t)(bh * 64 + r) * T + 4 * hf;
        for (int kt = qb; kt >= 0; --kt) {
            const int k0 = kt * 32;
            bf16x8v kf[4], vf[2][2];
#pragma unroll
            for (int ks = 0; ks < 4; ++ks) kf[ks] = *(const bf16x8v*)(kbase + (size_t)(k0 + r) * W + 16 * ks);
#pragma unroll
            for (int mb = 0; mb < 2; ++mb)
#pragma unroll
                for (int s = 0; s < 2; ++s) { const bf16* vp = vbase + (size_t)(32 * mb) * T + k0 + 16 * s; const v2u lo = *(const v2u*)vp, hi = *(const v2u*)(vp + 8);
                    const v4u pk = (v4u){lo.x, lo.y, hi.x, hi.y}; vf[mb][s] = __builtin_bit_cast(bf16x8v, pk); }
            f32x16 sa;
#pragma unroll
            for (int i = 0; i < 16; ++i) sa[i] = 0.f;
#pragma unroll
            for (int ks = 0; ks < 4; ++ks) sa = __builtin_amdgcn_mfma_f32_32x32x16_bf16(kf[ks], qf[ks], sa, 0, 0, 0);
            const bool diag = (kt == qb);
            float l[16], lb[16];
#pragma unroll
            for (int i = 0; i < 16; ++i) { const float z = 0.125f * sa[i]; const float sp = fmaxf(z, 0.f) + __logf(1.0f + __expf(-fabsf(z)));
                const bool valid = !diag || (((i & 3) + 8 * (i >> 2) + 4 * hf) < r);
                l[i] = valid ? -sp : 0.f; lb[i] = valid ? (z - sp) : -1.0e30f; }
            float gs[4], pg[4];
#pragma unroll
            for (int g = 0; g < 4; ++g) { gs[g] = (l[4 * g] + l[4 * g + 1]) + (l[4 * g + 2] + l[4 * g + 3]); pg[g] = __shfl_xor(gs[g], 32); }
            float sg[4], tail = 0.f;
#pragma unroll
            for (int g = 3; g >= 0; --g) { sg[g] = tail + (hf == 0 ? pg[g] : 0.f); tail += gs[g] + pg[g]; }
            float w[16];
#pragma unroll
            for (int g = 0; g < 4; ++g) { const float base = R + sg[g];
                const float e2 = l[4 * g + 3], e1 = e2 + l[4 * g + 2], e0 = e1 + l[4 * g + 1];
                w[4 * g + 3] = __expf(lb[4 * g + 3] + base); w[4 * g + 2] = __expf(lb[4 * g + 2] + base + e2); w[4 * g + 1] = __expf(lb[4 * g + 1] + base + e1); w[4 * g] = __expf(lb[4 * g] + base + e0); }
            R += tail;
            bf16x8v wf[2];
#pragma unroll
            for (int s = 0; s < 2; ++s) { const v4u pk = (v4u){cvt2f(w[8 * s], w[8 * s + 1]), cvt2f(w[8 * s + 2], w[8 * s + 3]), cvt2f(w[8 * s + 4], w[8 * s + 5]), cvt2f(w[8 * s + 6], w[8 * s + 7])}; wf[s] = __builtin_bit_cast(bf16x8v, pk); }
#pragma unroll
            for (int s = 0; s < 2; ++s) { o0 = __builtin_amdgcn_mfma_f32_32x32x16_bf16(vf[0][s], wf[s], o0, 0, 0, 0); o1 = __builtin_amdgcn_mfma_f32_32x32x16_bf16(vf[1][s], wf[s], o1, 0, 0, 0); }
            if (__all(R < -100.f)) break;
        }
        bf16* orow = O + (size_t)(b * T + q0 + r) * W + 64 * h + 4 * hf;
#pragma unroll
        for (int g = 0; g < 4; ++g) { v2u a, c2; a.x = cvt2f(o0[4 * g], o0[4 * g + 1]); a.y = cvt2f(o0[4 * g + 2], o0[4 * g + 3]); c2.x = cvt2f(o1[4 * g], o1[4 * g + 1]); c2.y = cvt2f(o1[4 * g + 2], o1[4 * g + 3]);
            *(v2u*)(orow + 8 * g) = a; *(v2u*)(orow + 32 + 8 * g) = c2; }
    }
}

__device__ __forceinline__ void lru_pass(int pass, const bf16* XL, bf16* YL, float* AGG, const float* conv_w, const float* conv_b, const float* w_a, const float* b_a, const float* w_x, const float* b_x,
                                         const float* lam, int gw, int ngw, int lane) {
    for (int item = gw; item < NB * 6 * 16; item += ngw) {
        const int c = item & 15, bh = item >> 4, b = bh / 6, hd = bh % 6, ch = 64 * hd + lane;
        float wa[64], wx[64];
#pragma unroll
        for (int i = 0; i < 64; ++i) { wa[i] = w_a[(hd * 64 + i) * 64 + lane]; wx[i] = w_x[(hd * 64 + i) * 64 + lane]; }
        const float cw0 = conv_w[0 * W + ch], cw1 = conv_w[1 * W + ch], cw2 = conv_w[2 * W + ch], cw3 = conv_w[3 * W + ch], cb = conv_b[ch];
        const float ba = b_a[ch], bx = b_x[ch];
        const float lm = lam[ch];
        const float ls8 = 8.0f * (fminf(lm, 0.f) - log1pf(__expf(-fabsf(lm))));
        const int t0 = 128 * c;
        const bf16* xb = XL + (size_t)(b * T) * W + ch;
        bf16* yb = YL + (size_t)(b * T) * W + ch;
        float xm3 = t0 >= 3 ? bf2f(xb[(size_t)(t0 - 3) * W]) : 0.f, xm2 = t0 >= 2 ? bf2f(xb[(size_t)(t0 - 2) * W]) : 0.f, xm1 = t0 >= 1 ? bf2f(xb[(size_t)(t0 - 1) * W]) : 0.f;
        float hst = 0.f, sumlog = 0.f;
        if (pass == 2) { const float* ag = AGG + (size_t)(bh * 16) * 128 + lane;
            for (int k = 0; k < c; ++k) hst = ag[k * 128] * hst + ag[k * 128 + 64]; }
        for (int tb = 0; tb < 128; tb += 8) {
            float xv[8], yv[8];
#pragma unroll
            for (int k = 0; k < 8; ++k) { xv[k] = bf2f(xb[(size_t)(t0 + tb + k) * W]); yv[k] = (pass == 2) ? bf2f(yb[(size_t)(t0 + tb + k) * W]) : 0.f; }
#pragma unroll
            for (int k = 0; k < 8; ++k) {
                const float xc = cw0 * xm3 + cw1 * xm2 + cw2 * xm1 + cw3 * xv[k] + cb;
                xm3 = xm2; xm2 = xm1; xm1 = xv[k];
                float ra = ba, ri = bx;
#pragma unroll
                for (int i = 0; i < 64; ++i) { const float xi = rdlane(xc, i); ra += xi * wa[i]; ri += xi * wx[i]; }
                const float r = sigmf(ra), ig = sigmf(ri);
                const float log_a = ls8 * r;
                const float a = __expf(log_a);
                const float bb = sqrtf(fmaxf(-expm1f(2.0f * log_a), 0.f)) * (ig * xc);
                hst = a * hst + bb;
                if (pass == 1) sumlog += log_a;
                else yb[(size_t)(t0 + tb + k) * W] = (bf16)f2bf(hst * gelu_tanh(yv[k]));
            }
        }
        if (pass == 1) { float* ag = AGG + (size_t)(bh * 16 + c) * 128 + lane; ag[0] = __expf(sumlog); ag[64] = hst; }
    }
}

__device__ __forceinline__ void moe_tables(const int* HIST, LAS unsigned char* lds, int tid) {
    LAS int* HL = (LAS int*)lds;
    LAS int* MT = (LAS int*)(lds + MT_OFF);
    for (int i = tid; i < 4096; i += NTHR) HL[i] = __hip_atomic_load(HIST + i, __ATOMIC_RELAXED, __HIP_MEMORY_SCOPE_AGENT);
    __syncthreads();
    if (tid < 16) { int tot = 0, base = 0; for (int c = 0; c < 256; ++c) { const int v = HL[c * 16 + tid]; tot += v; if (c < (int)blockIdx.x) base += v; } MT[MT_TOT + tid] = tot; MT[MT_BASE + tid] = base; }
    __syncthreads();
    if (tid < 2) { int off = 0, tiles = 0;
        for (int e = 0; e < 8; ++e) { const int pad = (MT[MT_TOT + tid * 8 + e] + 255) & ~255; MT[MT_OFFS + tid * 8 + e] = off; for (int k = 0; k < (pad >> 8) && tiles < MAXT; ++k) MT[MT_TEXP + tid * MAXT + tiles++] = e; off += pad; }
        MT[MT_NT + tid] = tiles; }
    __syncthreads();
}

struct Args { const float* in[33]; float* out; unsigned char* ws; int ph_lo, ph_hi; };
constexpr int N_PHASES = 23;
#ifndef R_PREP
#define R_PREP 1
#endif
#ifndef R_INPROJ
#define R_INPROJ 1
#endif
#ifndef R_S5
#define R_S5 1
#endif
#ifndef R_ATTN
#define R_ATTN 1
#endif
#ifndef R_LRU1
#define R_LRU1 1
#endif
#ifndef R_LRU2
#define R_LRU2 1
#endif
#ifndef R_GLU
#define R_GLU 1
#endif
#ifndef R_MERGED
#define R_MERGED 1
#endif
#ifndef R_OUT0
#define R_OUT0 1
#endif
#ifndef R_NORM
#define R_NORM 1
#endif
#ifndef R_FGU
#define R_FGU 1
#endif
#ifndef R_P15
#define R_P15 1
#endif
#ifndef R_MGU
#define R_MGU 1
#endif

#ifndef GP_ALIGN
#define GP_ALIGN true
#endif
#ifndef GP_SP2
#define GP_SP2 true
#endif
#ifndef MK_STOP
#define MK_STOP N_PHASES
#endif

__global__ void __launch_bounds__(NTHR, 2) hybrid_fwd(Args args) {
    extern __shared__ __attribute__((aligned(16))) unsigned char lds_raw[];
    LAS unsigned char* lds = (LAS unsigned char*)lds_raw;
    volatile LAS unsigned* MISC = (volatile LAS unsigned*)(lds + MISC_OFF);
    LAS int* MT = (LAS int*)(lds + MT_OFF);
    const int tid0 = threadIdx.x;
    const int G = gridDim.x, bx0 = blockIdx.x;
    const int NGW = G * NWAVES, NTH = G * NTHR;
    unsigned char* ws0 = args.ws;
    unsigned* ctl = (unsigned*)(ws0 + WS_CTL);
    const int lo = args.ph_lo, hi = args.ph_hi;
    for (int u = tid0; u < (LDS_BYTES - RING_BYTES) / 4; u += NTHR) ((LAS unsigned*)(lds + RING_BYTES))[u] = 0u;
    __syncthreads();
    XcdBarrier bar; bar.bar = ctl + CW_BAR; bar.x = 0; bar.st = nullptr;
    if (hi - lo > 1) { bar = xcd_barrier_post(ctl + CW_BAR, MISC + 8); xcd_barrier_census(bar); }
#define PHASE_VARS int tid = tid0; asm volatile("" : "+v"(tid)); int bx = bx0; asm volatile("" : "+s"(bx)); unsigned char* ws = ws0; asm volatile("" : "+s"(ws)); \
    const int lane = tid & 63, wave = __builtin_amdgcn_readfirstlane(tid >> 6), gw = wave * G + bx, gtid = bx * NTHR + tid; (void)lane; (void)wave; (void)gw; (void)gtid; (void)ws;
#define IN(k) (lo <= (k) && (k) < hi)
#define SEAM(k) do { if (IN((k) + 1)) xcd_barrier(bar); } while (0)

#define x_in (args.in[0])
#define xres (args.out)
#define S5PAR ((float*)(ws + WS_MISC + MS_S5PAR))
#define AGG ((float*)(ws + WS_MISC + MS_AGG))
#define ROUTE ((float*)(ws + WS_MISC + MS_ROUTE))
#define HIST ((int*)(ws + WS_MISC + MS_HIST))
#define TOK ((int*)(ws + WS_MISC + MS_TOK))
#define WTS ((float*)(ws + WS_MISC + MS_WTS))
#define WIN ((bf16*)(ws + WS_W + W_IN))
#define WGLU ((bf16*)(ws + WS_W + W_GLU))
#define WBR ((bf16*)(ws + WS_W + W_BR))
#define WOUT ((bf16*)(ws + WS_W + W_OUT))
#define WFGU ((bf16*)(ws + WS_W + W_FGU))
#define WFD ((bf16*)(ws + WS_W + W_FD))
#define HB ((bf16*)(ws + WS_H))
#define Y5 ((bf16*)(ws + WS_Y5))
#define P6 ((bf16*)(ws + WS_P6))
#define GT ((bf16*)(ws + WS_G))
#define DACT ((bf16*)(ws + WS_DACT))
#define MWGU ((bf16*)(ws + WS_MWGU))
#define MWD ((bf16*)(ws + WS_MWD))
#define H2 ((bf16*)(ws + WS_H2))
#define HP ((bf16*)(ws + WS_HP))
#define ACT ((bf16*)(ws + WS_ACT))
#define PU P6
#define PQ (P6 + (size_t)NT * W)
#define PYL (P6 + (size_t)2 * NT * W)
#define PK (P6 + (size_t)3 * NT * W)
#define PV (P6 + (size_t)4 * NT * W)
#define PXL (P6 + (size_t)5 * NT * W)
#define scr ((LAS float*)(lds + wave * 16384))
#define SCRB ((bf16*)(ws + 476 * MiB))

    if (IN(0)) { PHASE_VARS
      for (int rep_ = 0; rep_ < R_PREP; ++rep_) {
        constexpr int I_IN = 16 * (INW / 32), I_GLU = 6 * 12, I_BR = 6 * 32, I_OUT = 16 * 32, I_FG = 16 * (DFF / 32), I_FD = (DFF / 64) * 32;
        constexpr int NITEMS = 2 * I_IN + 2 * I_GLU + 6 * I_BR + 2 * I_OUT + 2 * I_FG + I_FD;
        for (int it = gw; it < NITEMS; it += NGW) {
            int r = it;
            if (r < 2 * I_IN) { const int l = r / I_IN; tr_item(args.in[2] + (size_t)l * D * INW, D, INW, WIN + (size_t)l * INW * D, 0, 0, scr, r % I_IN, lane); continue; } r -= 2 * I_IN;
            if (r < 2 * I_GLU) { const int l = r / I_GLU; tr_item(args.in[12] + (size_t)l * W * W, W, W, WGLU + (size_t)l * 512 * W, 0, 0, scr, r % I_GLU, lane); continue; } r -= 2 * I_GLU;
            if (r < 6 * I_BR) { const int ln = r / I_BR; tr_item(args.in[21] + (size_t)ln * W * D, W, D, WBR + (size_t)ln * D * W, 0, 0, scr, r % I_BR, lane); continue; } r -= 6 * I_BR;
            if (r < 2 * I_OUT) { const int l = r / I_OUT; tr_item(args.in[22] + (size_t)l * D * D, D, D, WOUT + (size_t)l * D * D, 0, 0, scr, r % I_OUT, lane); continue; } r -= 2 * I_OUT;
            if (r < I_FG) { tr_item(args.in[24], D, DFF, WFGU, 1, 0, scr, r, lane); continue; } r -= I_FG;
            if (r < I_FG) { tr_item(args.in[25], D, DFF, WFGU, 1, 128, scr, r, lane); continue; } r -= I_FG;
            tr_item(args.in[26], DFF, D, WFD, 0, 0, scr, r, lane);
        }
        for (int i = gtid; i < 2 * 128 * W / 8; i += NTH) { const int l = i / (128 * W / 8), r = i % (128 * W / 8); *(v4u*)(WGLU + (size_t)l * 512 * W + (size_t)384 * W + (size_t)r * 8) = (v4u){0u, 0u, 0u, 0u}; }
        for (int i = gtid; i < 2 * NG * NP; i += NTH) {
            const int l = i / (NG * NP), gp = i % (NG * NP), g = gp / NP;
            const float lre = args.in[4][i], lim = args.in[5][i], dt = expf(args.in[6][l * NG + g]);
            const float ea = expf(lre * dt), are = ea * cosf(lim * dt), aim = ea * sinf(lim * dt), den = lre * lre + lim * lim, nr = are - 1.0f;
            const float cre = (nr * lre + aim * lim) / den, cim = (aim * lre - nr * lim) / den;
            float* o = S5PAR + (size_t)i * 34; o[0] = are; o[1] = aim;
            for (int h = 0; h < 16; ++h) { const float br = args.in[7][(size_t)i * 16 + h], bi = args.in[8][(size_t)i * 16 + h]; o[2 + h] = cre * br - cim * bi; o[18 + h] = cre * bi + cim * br; }
        }
        for (int m = gw; m < NT; m += NGW) { f32x4 v[4]; rms_row(x_in + (size_t)m * D, args.in[1], HB + (size_t)m * D, lane, v); }
      }
        SEAM(0);
    }

#pragma unroll
    for (int L = 0; L < 2; ++L) {
        const int pb = 1 + 9 * L;
        if (IN(pb)) { PHASE_VARS
            pg8::Gemm g{HB, WIN + (size_t)L * INW * D, NT, INW, D}; pg8::StaticOrder S; S.init(NT, INW, G, bx);
#ifdef MK_EXEPI
            pg8::EpiBf16<0> E{P6, INW, nullptr, 0, 0, 1.f};
            pg8::gemm_phase<pg8::EpiBf16<0>, pg8::StaticOrder, GP_ALIGN, GP_SP2>(lds, g, S, E);
#else
            pg8::EpiInProj E{P6, GT, args.in[3] + L * 3 * D};
            for (int rep_ = 0; rep_ < R_INPROJ; ++rep_) pg8::gemm_phase<pg8::EpiInProj, pg8::StaticOrder, GP_ALIGN, GP_SP2>(lds, g, S, E);
#endif
            SEAM(pb);
        }
#ifndef MK_STRIP
        if (IN(pb + 1)) { PHASE_VARS
#ifndef NO_S5
            for (int rep_ = 0; rep_ < R_S5; ++rep_) s5_simple(PU, Y5, S5PAR + (size_t)L * NG * NP * 34, args.in[9] + (size_t)L * NG * NH * NP, args.in[10] + (size_t)L * NG * NH * NP, args.in[11] + L * W, lds, G, tid);
#endif
#ifndef NO_ATTN
#ifdef ATTN_SIMPLE
            attn_simple(PQ, PK, PV, PQ, gtid, NTH);
#else
            for (int rep_ = 1; rep_ < R_ATTN; ++rep_) attn_mfma(PQ, PK, PV, SCRB, gw, NGW, lane);
            attn_mfma(PQ, PK, PV, PQ, gw, NGW, lane);
#endif
#endif
#ifndef NO_LRU
            for (int rep_ = 0; rep_ < R_LRU1; ++rep_) lru_pass(1, PXL, PYL, AGG, args.in[14] + L * 4 * W, args.in[15] + L * W, args.in[16] + L * 6 * 64 * 64, args.in[17] + L * W, args.in[18] + L * 6 * 64 * 64, args.in[19] + L * W, args.in[20] + L * W, gw, NGW, lane);
#endif
            SEAM(pb + 1);
        }
        if (IN(pb + 2)) { PHASE_VARS
#ifndef NO_LRU
            lru_pass(2, PXL, PYL, AGG, args.in[14] + L * 4 * W, args.in[15] + L * W, args.in[16] + L * 6 * 64 * 64, args.in[17] + L * W, args.in[18] + L * 6 * 64 * 64, args.in[19] + L * W, args.in[20] + L * W, gw, NGW, lane);
#endif
            __syncthreads();
            pg8::Gemm g{Y5, WGLU + (size_t)L * 512 * W, NT, 512, W}; pg8::StaticOrder S; S.init(NT, 512, G, bx);
            pg8::EpiGlu E{Y5, PU, args.in[13] + L * W};
            for (int rep_ = 0; rep_ < R_GLU; ++rep_) pg8::gemm_phase<pg8::EpiGlu, pg8::StaticOrder, GP_ALIGN, GP_SP2>(lds, g, S, E);
            SEAM(pb + 2);
        }
        if (IN(pb + 3)) { PHASE_VARS
            pg8::Gemm g{P6, WBR + (size_t)L * 3 * D * W, 3 * NT, 3 * D, W}; pg8::MergedOrder S; S.so.init(NT, D, G, bx);
            pg8::EpiMerged E{GT, HB};
            for (int rep_ = 0; rep_ < R_MERGED; ++rep_) pg8::gemm_phase<pg8::EpiMerged, pg8::MergedOrder, GP_ALIGN, GP_SP2>(lds, g, S, E);
            SEAM(pb + 3);
        }
        if (IN(pb + 4)) { PHASE_VARS
            pg8::Gemm g{HB, WOUT + (size_t)L * D * D, NT, D, D}; pg8::StaticOrder S; S.init(NT, D, G, bx);
            pg8::EpiResid E{L == 0 ? x_in : (const float*)xres, xres};
            for (int rep_ = 0; rep_ < (L == 0 ? R_OUT0 : 1); ++rep_) pg8::gemm_phase<pg8::EpiResid, pg8::StaticOrder, GP_ALIGN, GP_SP2>(lds, g, S, E);
            SEAM(pb + 4);
        }
        if (L == 0) {
            if (IN(6)) { PHASE_VARS for (int rep_ = 0; rep_ < R_NORM; ++rep_) for (int m = gw; m < NT; m += NGW) { f32x4 v[4]; rms_row(xres + (size_t)m * D, args.in[23], HB + (size_t)m * D, lane, v); } SEAM(6); }
            if (IN(7)) { PHASE_VARS
                pg8::Gemm g{HB, WFGU, NT, 2 * DFF, D}; pg8::StaticOrder S; S.init(NT, 2 * DFF, G, bx);
                pg8::EpiSwiglu E{DACT, DFF, 2 * DFF / 256};
                for (int rep_ = 0; rep_ < R_FGU; ++rep_) pg8::gemm_phase<pg8::EpiSwiglu, pg8::StaticOrder, GP_ALIGN, GP_SP2>(lds, g, S, E);
                SEAM(7);
            }
            if (IN(8)) { PHASE_VARS
                pg8::Gemm g{DACT, WFD, NT, D, DFF}; pg8::StaticOrder S; S.init(NT, D, G, bx);
                pg8::EpiResid E{xres, xres};
                pg8::gemm_phase<pg8::EpiResid, pg8::StaticOrder, GP_ALIGN, GP_SP2>(lds, g, S, E);
                SEAM(8);
            }
            if (IN(9)) { PHASE_VARS for (int m = gw; m < NT; m += NGW) { f32x4 v[4]; rms_row(xres + (size_t)m * D, args.in[1] + D, HB + (size_t)m * D, lane, v); } SEAM(9); }
        }
#endif
    }
#ifndef MK_STRIP

    if (IN(15)) { PHASE_VARS
        constexpr int I_G = 16 * (DFE / 32), I_D = (DFE / 64) * 32, I_E = 2 * I_G + I_D;
        for (int rep_ = 0; rep_ < R_P15; ++rep_) for (int it = gw; it < NE * I_E; it += NGW) {
            const int e = it / I_E; int r = it % I_E;
            if (r < I_G) { tr_item(args.in[29] + (size_t)e * D * DFE, D, DFE, MWGU + (size_t)e * 2 * DFE * D, 1, 0, scr, r, lane); continue; } r -= I_G;
            if (r < I_G) { tr_item(args.in[30] + (size_t)e * D * DFE, D, DFE, MWGU + (size_t)e * 2 * DFE * D, 1, 128, scr, r, lane); continue; } r -= I_G;
            tr_item(args.in[31] + (size_t)e * DFE * D, DFE, D, MWD + (size_t)e * D * DFE, 0, 0, scr, r, lane);
        }
        __syncthreads();
        LAS int* LE = MT + MT_LE;
        for (int tok0 = bx * 128; tok0 < NT; tok0 += G * 128) {
            for (int k = 0; k < 16; ++k) {
                const int il = wave * 16 + k, m = tok0 + il;
                f32x4 v[4]; rms_row(xres + (size_t)m * D, args.in[23] + D, H2 + (size_t)m * D, lane, v);
                float lg[8];
#pragma unroll
                for (int e = 0; e < 8; ++e) lg[e] = 0.f;
#pragma unroll
                for (int j = 0; j < 4; ++j)
#pragma unroll
                    for (int q = 0; q < 4; ++q) { const float* rw = args.in[27] + (size_t)(4 * lane + 256 * j + q) * 8; const f32x4 r0 = *(const f32x4*)rw, r1 = *(const f32x4*)(rw + 4); const float hv = v[j][q];
                        lg[0] += hv * r0.x; lg[1] += hv * r0.y; lg[2] += hv * r0.z; lg[3] += hv * r0.w; lg[4] += hv * r1.x; lg[5] += hv * r1.y; lg[6] += hv * r1.z; lg[7] += hv * r1.w; }
#pragma unroll
                for (int e = 0; e < 8; ++e) lg[e] = wave_sum(lg[e]) + args.in[28][e];
                int e0 = 0; float v0 = lg[0];
#pragma unroll
                for (int e = 1; e < 8; ++e) if (lg[e] > v0) { v0 = lg[e]; e0 = e; }
                int e1 = -1; float v1 = -3.0e38f;
#pragma unroll
                for (int e = 0; e < 8; ++e) if (e != e0 && lg[e] > v1) { v1 = lg[e]; e1 = e; }
                const float w1 = 1.0f / (1.0f + expf(v0 - v1)), w0 = 1.0f - w1;
                if (lane == 0) { float* ro = ROUTE + (size_t)m * 4; ro[0] = __int_as_float(e0); ro[1] = __int_as_float(e1); ro[2] = w0; ro[3] = w1; LE[il] = e0; LE[128 + il] = e1; }
            }
            __syncthreads();
            if (tid < 16) { const int p = tid >> 3, e = tid & 7; int cnt = 0; for (int i = 0; i < 128; ++i) cnt += (LE[p * 128 + i] == e) ? 1 : 0; HIST[(tok0 / 128) * 16 + tid] = cnt; }
            __syncthreads();
        }
        SEAM(15);
    }
    if (IN(16)) { PHASE_VARS
        moe_tables(HIST, lds, tid);
        LAS int* LE = MT + MT_LE;
        const int p = (tid >> 7) & 1, i = tid & 127; const int m = bx * 128 + i;
        int e = 0; float wv = 0.f;
        if (tid < 256) { const float* ro = ROUTE + (size_t)m * 4; e = __float_as_int(ro[p]); wv = ro[2 + p]; LE[p * 128 + i] = e; }
        __syncthreads();
        if (tid < 256) { int rank = 0; for (int k = 0; k < i; ++k) rank += (LE[p * 128 + k] == e) ? 1 : 0;
            const int slot = MT[MT_OFFS + p * 8 + e] + MT[MT_BASE + p * 8 + e] + rank;
            TOK[p * (MAXT * 256) + slot] = m; WTS[p * (MAXT * 256) + slot] = wv; }
        if (bx == 0) { for (int j = 0; j < 16; ++j) { const int tot = MT[MT_TOT + j], pad = (tot + 255) & ~255, off = MT[MT_OFFS + j]; for (int s = tot + tid; s < pad; s += NTHR) { TOK[(j >> 3) * (MAXT * 256) + off + s] = -1; WTS[(j >> 3) * (MAXT * 256) + off + s] = 0.f; } } }
        SEAM(16);
    }
    if (IN(17)) { PHASE_VARS
        if (lo == 17) moe_tables(HIST, lds, tid);
        const int nrows = MT[MT_NT + 0] * 256;
        for (int s = gw; s < nrows; s += NGW) { const int t = __hip_atomic_load(TOK + s, __ATOMIC_RELAXED, __HIP_MEMORY_SCOPE_AGENT);
            v4u a = (v4u){0u, 0u, 0u, 0u}, b2 = a; if (t >= 0) { const v4u* src = (const v4u*)(H2 + (size_t)t * D) + lane; a = src[0]; b2 = src[64]; }
            v4u* dst = (v4u*)(HP + (size_t)s * D) + lane; dst[0] = a; dst[64] = b2; }
        SEAM(17);
    }
#pragma unroll
    for (int p = 0; p < 2; ++p) {
        if (IN(18 + 2 * p)) { PHASE_VARS
            if (lo == 18 + 2 * p) moe_tables(HIST, lds, tid);
            const int nT = MT[MT_NT + p];
            pg8::Gemm g{HP, MWGU, nT * 256, 2 * DFE, D}; pg8::MoeOrder S; S.so.init(nT * 256, 2 * DFE, G, bx); S.tileExp = (const LAS int*)(MT + MT_TEXP + p * MAXT);
            pg8::EpiSwiglu E{ACT, DFE, 2 * DFE / 256};
            for (int rep_ = 0; rep_ < R_MGU; ++rep_) pg8::gemm_phase<pg8::EpiSwiglu, pg8::MoeOrder, GP_ALIGN, GP_SP2>(lds, g, S, E);
            SEAM(18 + 2 * p);
        }
        if (IN(19 + 2 * p)) { PHASE_VARS
            if (lo == 19 + 2 * p) moe_tables(HIST, lds, tid);
            const int nT = MT[MT_NT + p];
            pg8::Gemm g{ACT, MWD, nT * 256, D, DFE}; pg8::MoeOrder S; S.so.init(nT * 256, D, G, bx); S.tileExp = (const LAS int*)(MT + MT_TEXP + p * MAXT);
            pg8::EpiMoeDown E{xres, TOK + p * (MAXT * 256), WTS + p * (MAXT * 256)};
            pg8::gemm_phase<pg8::EpiMoeDown, pg8::MoeOrder, GP_ALIGN, GP_SP2>(lds, g, S, E);
            if (p == 0) {
                const int nrows = MT[MT_NT + 1] * 256;
                for (int s = gw; s < nrows; s += NGW) { const int t = __hip_atomic_load(TOK + MAXT * 256 + s, __ATOMIC_RELAXED, __HIP_MEMORY_SCOPE_AGENT);
                    v4u a = (v4u){0u, 0u, 0u, 0u}, b2 = a; if (t >= 0) { const v4u* src = (const v4u*)(H2 + (size_t)t * D) + lane; a = src[0]; b2 = src[64]; }
                    v4u* dst = (v4u*)(HP + (size_t)s * D) + lane; dst[0] = a; dst[64] = b2; }
            }
            SEAM(19 + 2 * p);
        }
    }
    if (IN(22)) { PHASE_VARS
        for (int m = gw; m < NT; m += NGW) {
            f32x4* xr = (f32x4*)(xres + (size_t)m * D) + lane; const f32x4* gr = (const f32x4*)args.in[32] + lane;
            f32x4 v[4]; float s = 0.f;
#pragma unroll
            for (int j = 0; j < 4; ++j) { v[j] = xr[64 * j]; s += (v[j].x * v[j].x + v[j].y * v[j].y) + (v[j].z * v[j].z + v[j].w * v[j].w); }
            const float rs = 1.0f / sqrtf(wave_sum(s) * (1.f / D) + RMS_EPS);
#pragma unroll
            for (int j = 0; j < 4; ++j) xr[64 * j] = v[j] * rs * gr[64 * j];
        }
    }
#endif
#undef IN
#undef SEAM
}

__global__ void nan_fill(float* o, int n) { for (int i = blockIdx.x * blockDim.x + threadIdx.x; i < n; i += gridDim.x * blockDim.x) o[i] = __builtin_nanf(""); }


#ifdef MK_DUMP
__global__ void dump_k(int what, const unsigned char* ws, float* out) {
    for (size_t i = (size_t)blockIdx.x * blockDim.x + threadIdx.x; i < (size_t)NT * D; i += (size_t)gridDim.x * blockDim.x) {
        const size_t t = i / D; const int c = (int)(i % D); float v = 0.f;
        if (what == 1) v = bf2f(((const bf16*)(ws + WS_H))[i]);
        else if (what == 2) { const bf16* g = (const bf16*)(ws + WS_G) + t * 3072; v = bf2f(g[c]) + bf2f(g[c + 1024]) + bf2f(g[c + 2048]); }
        else if (what == 3) { if (c < W) for (int k = 0; k < 6; ++k) v += bf2f(((const bf16*)(ws + WS_P6))[(size_t)k * NT * W + t * W + c]); }
        else if (what == 4) { if (c < W) v = bf2f(((const bf16*)(ws + WS_Y5))[t * W + c]); }
        else if (what == 5) { if (c < W) v = bf2f(((const bf16*)(ws + WS_P6))[(size_t)1 * NT * W + t * W + c]); }
        else if (what == 6) { if (c < W) v = bf2f(((const bf16*)(ws + WS_P6))[(size_t)2 * NT * W + t * W + c]); }
        else if (what == 7) { if (c < W) v = bf2f(((const bf16*)(ws + WS_P6))[(size_t)0 * NT * W + t * W + c]); }
        else if (what == 9) { const bf16* o = (const bf16*)(ws + WS_P6) + t * INW; for (int k = 0; k < 5; ++k) v += bf2f(o[c + 1024 * k]); }
        else if (what == 8) v = bf2f(((const bf16*)(ws + WS_W + W_IN))[i % ((size_t)2 * INW * D)]);
        out[i] = v;
    }
}
#endif
#ifndef MK_PER_PHASE
#define MK_PER_PHASE 1
#endif
extern "C" void kernel_launch(void* const* d_in, const int* in_sizes, int n_in, void* d_out, int out_size, void* d_ws, size_t ws_size, hipStream_t stream) {
    static int grid = 0;
    if (grid == 0) {
        int dev = 0, cus = 0;
        if (n_in != 33 || out_size != NT * D || ws_size < WS_NEED || hipGetDevice(&dev) != hipSuccess || hipDeviceGetAttribute(&cus, hipDeviceAttributeMultiprocessorCount, dev) != hipSuccess ||
            hipFuncSetAttribute((const void*)hybrid_fwd, hipFuncAttributeMaxDynamicSharedMemorySize, LDS_BYTES) != hipSuccess) { fprintf(stderr, "kernel_launch: bad configuration (n_in %d out %d ws %zu)\n", n_in, out_size, ws_size); grid = -1; }
        else grid = cus;
    }
    if (grid < 0) { nan_fill<<<256, 256, 0, stream>>>((float*)d_out, out_size); return; }
    (void)hipMemsetAsync((char*)d_ws + WS_CTL, 0, CTL_ZERO_BYTES, stream);
#ifdef MK_ZERO_G
    (void)hipMemsetAsync((char*)d_ws + WS_G, 0, (size_t)NT * 3072 * 2, stream);
#endif
    Args a{};
    for (int i = 0; i < 33; ++i) a.in[i] = (const float*)d_in[i];
    a.out = (float*)d_out; a.ws = (unsigned char*)d_ws;
#if MK_PER_PHASE
#ifdef MK_FUSE01
    a.ph_lo = 0; a.ph_hi = MK_STOP; hipLaunchKernelGGL(hybrid_fwd, dim3(grid), dim3(NTHR), LDS_BYTES, stream, a);
#else
    for (int ph = 0; ph < MK_STOP; ++ph) { a.ph_lo = ph; a.ph_hi = ph + 1; hipLaunchKernelGGL(hybrid_fwd, dim3(grid), dim3(NTHR), LDS_BYTES, stream, a); }
#endif
#ifdef MK_DUMP
    dump_k<<<2048, 256, 0, stream>>>(MK_DUMP, (const unsigned char*)d_ws, (float*)d_out);
#endif
#else
    a.ph_lo = 0; a.ph_hi = N_PHASES; hipLaunchKernelGGL(hybrid_fwd, dim3(grid), dim3(NTHR), LDS_BYTES, stream, a);
#endif
}
```

```cpp
#include <hip/hip_runtime.h>
#include <cstdio>
#include <cstdint>
#define MK_PER_PHASE 0
namespace pg8 {
#define PG8_LAS __attribute__((address_space(3)))
typedef unsigned short bf16_t;
typedef short bf16x8 __attribute__((ext_vector_type(8)));
typedef float f32x4 __attribute__((ext_vector_type(4)));
typedef unsigned u32x4 __attribute__((ext_vector_type(4)));
constexpr int BM = 256, BK = 64, HALF = 128, HTB = HALF * BK * 2  , STAGE_BYTES = 8 * HTB, NXCD = 8, WGM = 8;

__host__ __device__ __forceinline__ int lds_byte(int r, int c) { const int st = (r >> 4) * 2 + (c >> 5), rr = r & 15, cc = c & 31, ob = rr * 64 + cc * 2; return st * 1024 + (ob ^ (((ob >> 9) & 1) << 5)); }
__host__ __device__ __forceinline__ void stage_rc(int b, int& R, int& C) { const int st = b / 1024, sb = b % 1024, swz = sb ^ (((sb >> 9) & 1) << 5); R = (st >> 1) * 16 + swz / 64; C = (st & 1) * 32 + (swz % 64) / 2; }
__host__ __device__ __forceinline__ int perm32(int rho) { const int n = rho >> 4, i = rho & 15; return 8 * (i >> 2) + 4 * n + (i & 3); }

struct Unit { int pm, pn; };
struct Gemm { const bf16_t* A; const bf16_t* Bt; int M, N, K; };

struct StaticOrder {
    int nM, nN, nwg, G, c;
    __host__ __device__ void init(int M, int N, int G_, int c_) { nM = M / BM; nN = N / BM; nwg = nM * nN; G = G_; c = c_; }
    __host__ __device__ bool next(int i, Unit& u) const {
        const long L = (long)i * G + c; if (L >= nwg) return false;
        int wgid = (int)L; { const int q = nwg / NXCD, r = nwg % NXCD, xcd = wgid % NXCD, off = wgid / NXCD; wgid = (xcd < r ? xcd * (q + 1) : r * (q + 1) + (xcd - r) * q) + off; }
        const int nig = WGM * nN, gid = wgid / nig, fm = gid * WGM, gsz = (nM - fm) < WGM ? (nM - fm) : WGM;
        u.pm = fm + ((wgid % nig) % gsz); u.pn = (wgid % nig) / gsz; return true;
    }
    __device__ __forceinline__ void a_ready(const Unit&) const {}
    __device__ __forceinline__ void done(const Unit&) const {}
};

__device__ __forceinline__ unsigned cvt_pk_bf16(float lo, float hi) { unsigned r; asm volatile("v_cvt_pk_bf16_f32 %0, %1, %2" : "=v"(r) : "v"(lo), "v"(hi)); return r; }
typedef float f32x2 __attribute__((ext_vector_type(2)));
__device__ __forceinline__ f32x2 gelu_pk(f32x2 v) {
    const f32x2 av = __builtin_elementwise_abs(v), d = av * 0.2316418882f + 1.0f;
    f32x2 t; t.x = __builtin_amdgcn_rcpf(d.x); t.y = __builtin_amdgcn_rcpf(d.y);
    f32x2 q = t * 0.5307027145f + (-0.7265760135f); q = q * t + 0.7107068705f; q = q * t + (-0.142248368f); q = q * t + 0.127414796f; q = q * t;
    const f32x2 s = (v * v) * (-0.72134752044f);
    f32x2 e; e.x = __builtin_amdgcn_exp2f(s.x); e.y = __builtin_amdgcn_exp2f(s.y);
    const f32x2 m = v * (q * e), r = v - m;
    f32x2 o; o.x = v.x < 0.f ? m.x : r.x; o.y = v.y < 0.f ? m.y : r.y; return o;
}

template <int ACT  > struct EpiBf16 {
    static constexpr bool PERM = true, AFTER_DRAIN = false; static_assert(ACT == 0 || ACT == 1, "EpiBf16: ACT is 0 (none) or 1 (gelu_pk)");
    bf16_t* O; int ldc; const float* bias; int split_cols; size_t split_stride; float scale0;
    __device__ __forceinline__ void operator()(const f32x4 (&acc)[2][2][4][2], const Unit& u, int wr, int wc, int fr, int fq) const {
        const int row0 = u.pm * BM + wr * 64 + fr; int colt = u.pn * BM; bf16_t* base = O;
        float sc = 1.f; if (split_cols) { const int t = colt / split_cols; base += (size_t)t * split_stride; colt -= t * split_cols; if (t == 0) sc = scale0; }
        const int col0 = colt + wc * 32 + 8 * fq, bcol0 = u.pn * BM + wc * 32 + 8 * fq;
        f32x4 bv[2][2];
#pragma unroll
        for (int bj = 0; bj < 2; ++bj)
#pragma unroll
            for (int n = 0; n < 2; ++n) bv[bj][n] = bias ? *(const f32x4*)(bias + bcol0 + bj * HALF + 4 * n) : (f32x4){0.f, 0.f, 0.f, 0.f};
#pragma unroll
        for (int ai = 0; ai < 2; ++ai)
#pragma unroll
            for (int m = 0; m < 4; ++m) { bf16_t* rowp = base + (size_t)(row0 + ai * HALF + m * 16) * ldc + col0;
#pragma unroll
                for (int bj = 0; bj < 2; ++bj) { f32x4 v0 = acc[ai][bj][m][0] + bv[bj][0], v1 = acc[ai][bj][m][1] + bv[bj][1];
                    if (ACT == 1) { f32x2 a = gelu_pk((f32x2){v0[0], v0[1]}), b = gelu_pk((f32x2){v0[2], v0[3]}), c = gelu_pk((f32x2){v1[0], v1[1]}), d = gelu_pk((f32x2){v1[2], v1[3]});
                        v0 = (f32x4){a.x, a.y, b.x, b.y}; v1 = (f32x4){c.x, c.y, d.x, d.y}; }
                    v0 = v0 * sc; v1 = v1 * sc; u32x4 w; w.x = cvt_pk_bf16(v0[0], v0[1]); w.y = cvt_pk_bf16(v0[2], v0[3]); w.z = cvt_pk_bf16(v1[0], v1[1]); w.w = cvt_pk_bf16(v1[2], v1[3]);
                    *(u32x4*)(rowp + bj * HALF) = w; } }
    }
};
constexpr int NTOK = 32768;
__device__ __forceinline__ float sigm(float x) { return __builtin_amdgcn_rcpf(1.0f + __expf(-x)); }
__device__ __forceinline__ float bf_lo(unsigned u) { return __uint_as_float(u << 16); }
__device__ __forceinline__ float bf_hi(unsigned u) { return __uint_as_float(u & 0xffff0000u); }
typedef __bf16 bf16x2c __attribute__((ext_vector_type(2)));
__device__ __forceinline__ unsigned cvt2(float lo, float hi) { const f32x2 v = {lo, hi}; return __builtin_bit_cast(unsigned, __builtin_convertvector(v, bf16x2c)); }
__device__ __forceinline__ u32x4 pack8(const f32x4& v0, const f32x4& v1) { u32x4 w; w.x = cvt2(v0[0], v0[1]); w.y = cvt2(v0[2], v0[3]); w.z = cvt2(v1[0], v1[1]); w.w = cvt2(v1[2], v1[3]); return w; }
__device__ __forceinline__ void unpack8(const u32x4& w, f32x4& v0, f32x4& v1) { v0 = (f32x4){bf_lo(w.x), bf_hi(w.x), bf_lo(w.y), bf_hi(w.y)}; v1 = (f32x4){bf_lo(w.z), bf_hi(w.z), bf_lo(w.w), bf_hi(w.w)}; }

#ifndef MK_SIG
#define MK_SIG sigm
#endif
typedef unsigned u32x2g __attribute__((ext_vector_type(2)));
struct EpiInProj {
    static constexpr bool PERM = true, AFTER_DRAIN = false, HOOK = false; static constexpr int HOOK_T0 = -1, HOOK_T1 = -1;
    bf16_t* P6; unsigned char* G8; const float* gate_b; float rin; int gbase;
    __device__ __forceinline__ void operator()(const f32x4 (&acc)[2][2][4][2], const Unit& u, int wr, int wc, int fr, int fq) const {
        const int row0 = u.pm * BM + wr * 64 + fr;
        if (u.pn < gbase) {
#pragma unroll
            for (int bj = 0; bj < 2; ++bj) {
                const int c = u.pn * BM + bj * HALF + wc * 32 + 8 * fq;
                const int blk = c / 384, off = c - blk * 384, dblk = (0x254310 >> (4 * blk)) & 0xf;
                bf16_t* base = P6 + (size_t)dblk * ((size_t)NTOK * 384) + off;
                if (blk == 3) {
#pragma unroll
                    for (int ai = 0; ai < 2; ++ai)
#pragma unroll
                        for (int m = 0; m < 4; ++m) { const int row = row0 + ai * HALF + m * 16, bb = row >> 11, t = row & 2047;
                            bf16_t* dst = P6 + (size_t)4 * ((size_t)NTOK * 384) + ((size_t)((bb * 6 + (off >> 6)) * 64 + (off & 63))) * 2048 + t;
                            const u32x4 w = pack8(acc[ai][bj][m][0], acc[ai][bj][m][1]);
                            dst[0] = (bf16_t)(w.x & 0xffffu); dst[2048] = (bf16_t)(w.x >> 16); dst[2 * 2048] = (bf16_t)(w.y & 0xffffu); dst[3 * 2048] = (bf16_t)(w.y >> 16);
                            dst[4 * 2048] = (bf16_t)(w.z & 0xffffu); dst[5 * 2048] = (bf16_t)(w.z >> 16); dst[6 * 2048] = (bf16_t)(w.w & 0xffffu); dst[7 * 2048] = (bf16_t)(w.w >> 16); }
                } else {
#pragma unroll
                for (int ai = 0; ai < 2; ++ai)
#pragma unroll
                    for (int m = 0; m < 4; ++m) { const int row = row0 + ai * HALF + m * 16; *(u32x4*)(base + (size_t)row * 384) = pack8(acc[ai][bj][m][0], acc[ai][bj][m][1]); }
                }
            }
        } else {
#pragma unroll
            for (int bj = 0; bj < 2; ++bj) {
                const int cg = (u.pn - gbase) * BM + bj * HALF + wc * 32 + 8 * fq;
                const f32x4 b0 = *(const f32x4*)(gate_b + cg), b1 = *(const f32x4*)(gate_b + cg + 4);
#pragma unroll
                for (int ai = 0; ai < 2; ++ai)
#pragma unroll
                    for (int m = 0; m < 4; ++m) { const int row = row0 + ai * HALF + m * 16; f32x4 v0 = acc[ai][bj][m][0] * rin + b0, v1 = acc[ai][bj][m][1] * rin + b1;
#pragma unroll
                        for (int j = 0; j < 4; ++j) { v0[j] = fmaxf(MK_SIG(v0[j]) * 255.0f, 1.0f); v1[j] = fmaxf(MK_SIG(v1[j]) * 255.0f, 1.0f); }
                        unsigned lo = 0u, hi = 0u;
                        lo = __builtin_amdgcn_cvt_pk_u8_f32(v0[0], 0, lo); lo = __builtin_amdgcn_cvt_pk_u8_f32(v0[1], 1, lo); lo = __builtin_amdgcn_cvt_pk_u8_f32(v0[2], 2, lo); lo = __builtin_amdgcn_cvt_pk_u8_f32(v0[3], 3, lo);
                        hi = __builtin_amdgcn_cvt_pk_u8_f32(v1[0], 0, hi); hi = __builtin_amdgcn_cvt_pk_u8_f32(v1[1], 1, hi); hi = __builtin_amdgcn_cvt_pk_u8_f32(v1[2], 2, hi); hi = __builtin_amdgcn_cvt_pk_u8_f32(v1[3], 3, hi);
                        *(u32x2g*)(G8 + (size_t)row * 3072 + cg) = (u32x2g){lo, hi}; }
            }
        }
    }
};
struct EpiGlu {
    static constexpr bool PERM = true, AFTER_DRAIN = false, HOOK = false; static constexpr int HOOK_T0 = -1, HOOK_T1 = -1;
    const bf16_t* Y5; bf16_t* OUT; const float* b_glu; int ldo;
    __device__ __forceinline__ void operator()(const f32x4 (&acc)[2][2][4][2], const Unit& u, int wr, int wc, int fr, int fq) const {
        const int row0 = u.pm * BM + wr * 64 + fr;
#pragma unroll
        for (int bj = 0; bj < 2; ++bj) {
            const int c = u.pn * BM + bj * HALF + wc * 32 + 8 * fq;
            if (c < 384) {
                const f32x4 b0 = *(const f32x4*)(b_glu + c), b1 = *(const f32x4*)(b_glu + c + 4);
                u32x4 yv[8];
#pragma unroll
                for (int i = 0; i < 8; ++i) yv[i] = *(const u32x4*)(Y5 + (size_t)(row0 + (i >> 2) * HALF + (i & 3) * 16) * 384 + c);
#pragma unroll
                for (int ai = 0; ai < 2; ++ai)
#pragma unroll
                    for (int m = 0; m < 4; ++m) { const int row = row0 + ai * HALF + m * 16; f32x4 v0 = acc[ai][bj][m][0] + b0, v1 = acc[ai][bj][m][1] + b1, y0, y1;
                        unpack8(yv[ai * 4 + m], y0, y1);
#pragma unroll
                        for (int j = 0; j < 4; ++j) { v0[j] = y0[j] * sigm(v0[j]); v1[j] = y1[j] * sigm(v1[j]); }
                        *(u32x4*)(OUT + (size_t)row * ldo + c) = pack8(v0, v1); }
                asm volatile("" ::: "memory");
            }
        }
    }
};
struct EpiMerged {
    static constexpr bool PERM = true, AFTER_DRAIN = false, HOOK = false; static constexpr int HOOK_T0 = -1, HOOK_T1 = -1;
    const unsigned char* G8; bf16_t* MG;
    __device__ __forceinline__ void operator()(const f32x4 (&acc)[2][2][4][2], const Unit& u, int wr, int wc, int fr, int fq) const {
        const int n = u.pm >> 7, pm = u.pm & 127, pn = u.pn & 3;
        const int row0 = pm * BM + wr * 64 + fr;
#pragma unroll
        for (int bj = 0; bj < 2; ++bj) {
            const int c = pn * BM + bj * HALF + wc * 32 + 8 * fq;
#pragma unroll
            for (int ai = 0; ai < 2; ++ai)
#pragma unroll
                for (int m = 0; m < 4; ++m) { const int row = row0 + ai * HALF + m * 16; f32x4 g0, g1;
                    { const u32x2g gw8 = *(const u32x2g*)(G8 + (size_t)row * 3072 + n * 1024 + c); const float k = 1.0f / 255.0f;
                      g0 = (f32x4){(float)(gw8.x & 0xffu), (float)((gw8.x >> 8) & 0xffu), (float)((gw8.x >> 16) & 0xffu), (float)(gw8.x >> 24)} * k;
                      g1 = (f32x4){(float)(gw8.y & 0xffu), (float)((gw8.y >> 8) & 0xffu), (float)((gw8.y >> 16) & 0xffu), (float)(gw8.y >> 24)} * k; }
                    f32x4 v0 = g0 * acc[ai][bj][m][0], v1 = g1 * acc[ai][bj][m][1];
                    if (n > 0) { f32x4 p0, p1; unpack8(*(const u32x4*)(MG + (size_t)row * 1024 + c), p0, p1); v0 += p0; v1 += p1; }
                    *(u32x4*)(MG + (size_t)row * 1024 + c) = pack8(v0, v1); asm volatile("" ::: "memory"); }
        }
    }
};
__device__ __forceinline__ void gate8(const unsigned char* p, f32x4& g0, f32x4& g1) { const u32x2g w = *(const u32x2g*)p;
    g0 = (f32x4){(float)(w.x & 0xffu), (float)((w.x >> 8) & 0xffu), (float)((w.x >> 16) & 0xffu), (float)(w.x >> 24)};
    g1 = (f32x4){(float)(w.y & 0xffu), (float)((w.y >> 8) & 0xffu), (float)((w.y >> 16) & 0xffu), (float)(w.y >> 24)};
#pragma unroll
    for (int j = 0; j < 4; ++j) { g0[j] = fmaxf(g0[j], 1.0f); g1[j] = fmaxf(g1[j], 1.0f); } }
__device__ __forceinline__ void gate8v(const u32x2g w, f32x4& g0, f32x4& g1) {
    g0 = (f32x4){(float)(w.x & 0xffu), (float)((w.x >> 8) & 0xffu), (float)((w.x >> 16) & 0xffu), (float)(w.x >> 24)};
    g1 = (f32x4){(float)(w.y & 0xffu), (float)((w.y >> 8) & 0xffu), (float)((w.y >> 16) & 0xffu), (float)(w.y >> 24)}; }
struct EpiMergedF {
    static constexpr bool PERM = true, AFTER_DRAIN = false, HOOK = true; static constexpr int HOOK_T0 = 6, HOOK_T1 = 12;
    const unsigned char* G8; bf16_t* MG;
    __device__ __forceinline__ void hook(f32x4 (&acc)[2][2][4][2], const Unit& u, int t, int wr, int wc, int fr, int fq) const {
        const int n = t / 6 - 1, row0 = u.pm * BM + wr * 64 + fr;
        const int c = u.pn * BM + wc * 32 + 8 * fq;
        u32x2g ga[2][8], gb[2][8];
#pragma unroll
        for (int bj = 0; bj < 2; ++bj)
#pragma unroll
            for (int i = 0; i < 8; ++i) { const unsigned char* gp = G8 + (size_t)(row0 + (i >> 2) * HALF + (i & 3) * 16) * 3072 + n * 1024 + c + bj * HALF; ga[bj][i] = *(const u32x2g*)gp; gb[bj][i] = *(const u32x2g*)(gp + 1024); }
#pragma unroll
        for (int bj = 0; bj < 2; ++bj)
#pragma unroll
            for (int ai = 0; ai < 2; ++ai)
#pragma unroll
                for (int m = 0; m < 4; ++m) { f32x4 a0, a1, b0, b1;
                    gate8v(ga[bj][ai * 4 + m], a0, a1); gate8v(gb[bj][ai * 4 + m], b0, b1);
                    const f32x4 r0 = (f32x4){__builtin_amdgcn_rcpf(b0[0]), __builtin_amdgcn_rcpf(b0[1]), __builtin_amdgcn_rcpf(b0[2]), __builtin_amdgcn_rcpf(b0[3])};
                    const f32x4 r1 = (f32x4){__builtin_amdgcn_rcpf(b1[0]), __builtin_amdgcn_rcpf(b1[1]), __builtin_amdgcn_rcpf(b1[2]), __builtin_amdgcn_rcpf(b1[3])};
                    acc[ai][bj][m][0] = acc[ai][bj][m][0] * (a0 * r0); acc[ai][bj][m][1] = acc[ai][bj][m][1] * (a1 * r1); }
        asm volatile("" ::: "memory");
    }
    __device__ __forceinline__ void operator()(const f32x4 (&acc)[2][2][4][2], const Unit& u, int wr, int wc, int fr, int fq) const {
        const int row0 = u.pm * BM + wr * 64 + fr;
#pragma unroll
        for (int bj = 0; bj < 2; ++bj) {
            const int c = u.pn * BM + bj * HALF + wc * 32 + 8 * fq;
            u32x2g gv[8];
#pragma unroll
            for (int i = 0; i < 8; ++i) gv[i] = *(const u32x2g*)(G8 + (size_t)(row0 + (i >> 2) * HALF + (i & 3) * 16) * 3072 + 2048 + c);
#pragma unroll
            for (int ai = 0; ai < 2; ++ai)
#pragma unroll
                for (int m = 0; m < 4; ++m) { const int row = row0 + ai * HALF + m * 16; f32x4 g0, g1; gate8v(gv[ai * 4 + m], g0, g1);
                    const float k = 1.0f / 255.0f;
                    *(u32x4*)(MG + (size_t)row * 1024 + c) = pack8(acc[ai][bj][m][0] * (g0 * k), acc[ai][bj][m][1] * (g1 * k)); }
            asm volatile("" ::: "memory");
        }
    }
};
struct EpiResid {
    static constexpr bool PERM = false, AFTER_DRAIN = false, HOOK = false; static constexpr int HOOK_T0 = -1, HOOK_T1 = -1;
    const float* base; float* out;
    __device__ __forceinline__ void operator()(const f32x4 (&acc)[2][2][4][2], const Unit& u, int wr, int wc, int fr, int fq) const {
        const int row0 = u.pm * BM + wr * 64 + fr, col0 = u.pn * BM + wc * 32 + 4 * fq;
#pragma unroll
        for (int ai = 0; ai < 2; ++ai)
#pragma unroll
            for (int m = 0; m < 4; ++m) { const size_t off = (size_t)(row0 + ai * HALF + m * 16) * 1024 + col0;
#pragma unroll
                for (int bj = 0; bj < 2; ++bj)
#pragma unroll
                    for (int n = 0; n < 2; ++n) { const f32x4 bs = *(const f32x4*)(base + off + bj * HALF + n * 16); *(f32x4*)(out + off + bj * HALF + n * 16) = bs + acc[ai][bj][m][n]; } asm volatile("" ::: "memory"); }
    }
};
constexpr int XP = 2048;
template <bool BASE_F32> struct EpiResidB {
    static constexpr bool PERM = true, AFTER_DRAIN = false, HOOK = false; static constexpr int HOOK_T0 = -1, HOOK_T1 = -1;
    const float* basef; bf16_t* X;
    __device__ __forceinline__ void operator()(const f32x4 (&acc)[2][2][4][2], const Unit& u, int wr, int wc, int fr, int fq) const {
        const int row0 = u.pm * BM + wr * 64 + fr;
#pragma unroll
        for (int bj = 0; bj < 2; ++bj) {
            const int c = u.pn * BM + bj * HALF + wc * 32 + 8 * fq;
            if (BASE_F32) {
#pragma unroll
                for (int ai = 0; ai < 2; ++ai) { f32x4 bv[4][2];
#pragma unroll
                    for (int m = 0; m < 4; ++m) { const float* bp = basef + (size_t)(row0 + ai * HALF + m * 16) * 1024 + c; bv[m][0] = *(const f32x4*)bp; bv[m][1] = *(const f32x4*)(bp + 4); }
#pragma unroll
                    for (int m = 0; m < 4; ++m) { const int row = row0 + ai * HALF + m * 16; *(u32x4*)(X + (size_t)row * XP + c) = pack8(bv[m][0] + acc[ai][bj][m][0], bv[m][1] + acc[ai][bj][m][1]); }
                    asm volatile("" ::: "memory"); }
            } else {
                u32x4 xv[8];
#pragma unroll
                for (int i = 0; i < 8; ++i) xv[i] = *(const u32x4*)(X + (size_t)(row0 + (i >> 2) * HALF + (i & 3) * 16) * XP + c);
#pragma unroll
                for (int ai = 0; ai < 2; ++ai)
#pragma unroll
                    for (int m = 0; m < 4; ++m) { const int row = row0 + ai * HALF + m * 16; f32x4 b0, b1; unpack8(xv[ai * 4 + m], b0, b1);
                        *(u32x4*)(X + (size_t)row * XP + c) = pack8(b0 + acc[ai][bj][m][0], b1 + acc[ai][bj][m][1]); }
                asm volatile("" ::: "memory");
            }
        }
    }
};
struct EpiSwiglu {
    static constexpr bool PERM = true, AFTER_DRAIN = false, HOOK = false; static constexpr int HOOK_T0 = -1, HOOK_T1 = -1;
    bf16_t* ACT; int ld; int nct;
    __device__ __forceinline__ void operator()(const f32x4 (&acc)[2][2][4][2], const Unit& u, int wr, int wc, int fr, int fq) const {
        const int row0 = u.pm * BM + wr * 64 + fr, c = (u.pn % nct) * HALF + wc * 32 + 8 * fq;
#pragma unroll
        for (int ai = 0; ai < 2; ++ai)
#pragma unroll
            for (int m = 0; m < 4; ++m) { const int row = row0 + ai * HALF + m * 16; f32x4 v0, v1;
#pragma unroll
                for (int j = 0; j < 4; ++j) { const float g0 = acc[ai][0][m][0][j], g1 = acc[ai][0][m][1][j]; v0[j] = g0 * sigm(g0) * acc[ai][1][m][0][j]; v1[j] = g1 * sigm(g1) * acc[ai][1][m][1][j]; }
                *(u32x4*)(ACT + (size_t)row * ld + c) = pack8(v0, v1); }
    }
};
__device__ __forceinline__ unsigned pk4_f8(float a, float b, float c, float d) {
    a = __builtin_amdgcn_fmed3f(a, -448.f, 448.f); b = __builtin_amdgcn_fmed3f(b, -448.f, 448.f); c = __builtin_amdgcn_fmed3f(c, -448.f, 448.f); d = __builtin_amdgcn_fmed3f(d, -448.f, 448.f);
    int r = __builtin_amdgcn_cvt_pk_fp8_f32(a, b, 0, false); r = __builtin_amdgcn_cvt_pk_fp8_f32(c, d, r, true); return (unsigned)r; }
struct EpiSwiglu8 {
    static constexpr bool PERM = true, AFTER_DRAIN = false, HOOK = false; static constexpr int HOOK_T0 = -1, HOOK_T1 = -1;
    unsigned char* ACT; int ld; int nct; float rin, sout;
    __device__ __forceinline__ void operator()(const f32x4 (&acc)[2][2][4][2], const Unit& u, int wr, int wc, int fr, int fq) const {
        const int row0 = u.pm * BM + wr * 64 + fr, c = (u.pn % nct) * HALF + wc * 32 + 8 * fq;
#pragma unroll
        for (int ai = 0; ai < 2; ++ai)
#pragma unroll
            for (int m = 0; m < 4; ++m) { const int row = row0 + ai * HALF + m * 16; f32x4 v0, v1;
#pragma unroll
                for (int j = 0; j < 4; ++j) { const float g0 = acc[ai][0][m][0][j] * rin, g1 = acc[ai][0][m][1][j] * rin; v0[j] = g0 * sigm(g0) * (acc[ai][1][m][0][j] * (rin * sout)); v1[j] = g1 * sigm(g1) * (acc[ai][1][m][1][j] * (rin * sout)); }
                typedef unsigned u32x2 __attribute__((ext_vector_type(2)));
                u32x2 o; o.x = pk4_f8(v0[0], v0[1], v0[2], v0[3]); o.y = pk4_f8(v1[0], v1[1], v1[2], v1[3]);
                *(u32x2*)(ACT + (size_t)row * ld + c) = o; }
    }
};
struct EpiMoeDown {
    static constexpr bool PERM = true, AFTER_DRAIN = false, HOOK = false; static constexpr int HOOK_T0 = -1, HOOK_T1 = -1;
    bf16_t* X; const int* tok; const float* wt; float sc;
    bf16_t* X2 = nullptr; int split = 1 << 30;
    __device__ __forceinline__ void operator()(const f32x4 (&acc)[2][2][4][2], const Unit& u, int wr, int wc, int fr, int fq) const {
        const int slot0 = u.pm * BM + wr * 64 + fr, c0 = (u.pn & 3) * BM + wc * 32 + 8 * fq;
        int tk[8]; float wv[8];
#pragma unroll
        for (int i = 0; i < 8; ++i) { const int slot = slot0 + (i >> 2) * HALF + (i & 3) * 16; tk[i] = tok[slot]; wv[i] = wt[slot] * sc; }
        if (u.pm >= split) {
#pragma unroll
            for (int bj = 0; bj < 2; ++bj)
#pragma unroll
                for (int ai = 0; ai < 2; ++ai)
#pragma unroll
                    for (int m = 0; m < 4; ++m) { const int i = ai * 4 + m;
                        if (tk[i] >= 0) *(u32x4*)(X2 + (size_t)tk[i] * 1024 + c0 + bj * HALF) = pack8(wv[i] * acc[ai][bj][m][0], wv[i] * acc[ai][bj][m][1]); }
            asm volatile("" ::: "memory");
            return;
        }
#pragma unroll
        for (int bj = 0; bj < 2; ++bj) {
            u32x4 xv[8];
#pragma unroll
            for (int i = 0; i < 8; ++i) xv[i] = *(const u32x4*)(X + (size_t)(tk[i] < 0 ? 0 : tk[i]) * XP + c0 + bj * HALF);
#pragma unroll
            for (int ai = 0; ai < 2; ++ai)
#pragma unroll
                for (int m = 0; m < 4; ++m) { const int i = ai * 4 + m; f32x4 b0, b1; unpack8(xv[i], b0, b1);
                    if (tk[i] >= 0) *(u32x4*)(X + (size_t)tk[i] * XP + c0 + bj * HALF) = pack8(b0 + wv[i] * acc[ai][bj][m][0], b1 + wv[i] * acc[ai][bj][m][1]); }
            asm volatile("" ::: "memory");
        }
    }
};
struct MergedOrder {
    StaticOrder so;
    __device__ bool next(int i, Unit& u) const { Unit t; if (!so.next(i / 3, t)) return false; const int n = i % 3; u.pm = n * 128 + t.pm; u.pn = n * 4 + t.pn; return true; }
    __device__ __forceinline__ void a_ready(const Unit&) const {}
    __device__ __forceinline__ void done(const Unit&) const {}
};
struct MoeOrder {
    StaticOrder so; const PG8_LAS int* tileExp; int nT0 = 1 << 30, jump = 0;
    __device__ bool next(int i, Unit& u) const { Unit t; if (!so.next(i, t)) return false; u.pm = t.pm + (t.pm >= nT0 ? jump : 0); u.pn = tileExp[u.pm] * so.nN + t.pn; return true; }
    __device__ __forceinline__ void a_ready(const Unit&) const {}
    __device__ __forceinline__ void done(const Unit&) const {}
};
typedef int pg8_i32x4 __attribute__((ext_vector_type(4)));
typedef int pg8_i32x8 __attribute__((ext_vector_type(8)));
__device__ __forceinline__ pg8_i32x8 cat8(bf16x8 a, bf16x8 b) { const pg8_i32x4 x = __builtin_bit_cast(pg8_i32x4, a), y = __builtin_bit_cast(pg8_i32x4, b); return __builtin_shufflevector(x, y, 0, 1, 2, 3, 4, 5, 6, 7); }
template <class Epi, class Sched, bool ALIGN_EPI = false, bool SP2 = false, bool FP8 = false>
__device__ __forceinline__ void gemm_phase(PG8_LAS unsigned char* lds, const Gemm g, const Sched& S, const Epi& E, int tid_in) {
    int tid_l = tid_in; asm volatile("" : "+v"(tid_l));
    const int tid = tid_l, wid = __builtin_amdgcn_readfirstlane(tid >> 6), lane = tid & 63, wr = wid >> 2, wc = wid & 3, fr = lane & 15, fq = lane >> 4;
    int K_l = g.K; asm volatile("" : "+s"(K_l));
    const int K = K_l, nt = K / BK;
    unsigned voffA[2], voffB[2];
#pragma unroll
    for (int i = 0; i < 2; ++i) { int R, C; stage_rc(tid * 16 + i * 8192, R, C); const int Rb = Epi::PERM ? ((R & ~31) + perm32(R & 31)) : R;
        voffA[i] = (unsigned)(R * K + C) * 2u; voffB[i] = (unsigned)(Rb * K + C) * 2u; }
    const size_t kstep = (size_t)(BK * 2);
    const size_t hstep = (size_t)HALF * K * 2;
    const size_t tstep = 2 * hstep;
    const unsigned ldsw = (unsigned)wid * 1024u;
    const int aoff = lds_byte(wr * 64 + fr, fq * 8), boff = lds_byte(wc * 32 + fr, fq * 8);
#define PG8_SA(b, h) (((b) * 2 + (h)) * HTB)
#define PG8_SB(b, h) ((4 + (b) * 2 + (h)) * HTB)
#define PG8_STAGE(bufoff, gbase, voff) do { _Pragma("unroll") for (int _i = 0; _i < 2; ++_i) \
        __builtin_amdgcn_global_load_lds((const unsigned*)((const char*)(gbase) + (voff)[_i]), (PG8_LAS unsigned*)(lds + (bufoff) + ldsw + _i * 8192), 16, 0, 0); } while (0)
#define PG8_LDA(dst, b, h) do { _Pragma("unroll") for (int m = 0; m < 4; ++m) _Pragma("unroll") for (int k = 0; k < 2; ++k) dst[m][k] = *(const PG8_LAS bf16x8*)(lds + PG8_SA(b, h) + aoff + m * 2048 + k * 1024); } while (0)
#define PG8_LDB(dst, b, h) do { _Pragma("unroll") for (int n = 0; n < 2; ++n) _Pragma("unroll") for (int k = 0; k < 2; ++k) dst[n][k] = *(const PG8_LAS bf16x8*)(lds + PG8_SB(b, h) + boff + n * 2048 + k * 1024); } while (0)
#define PG8_MMA(ai, bj, At, Bt) do { __builtin_amdgcn_s_setprio(1); _Pragma("unroll") for (int m = 0; m < 4; ++m) _Pragma("unroll") for (int n = 0; n < 2; ++n) { \
        if constexpr (FP8) { const pg8_i32x8 a8_ = cat8(Bt[n][0], Bt[n][1]), b8_ = cat8(At[m][0], At[m][1]); asm volatile("v_mfma_f32_16x16x128_f8f6f4 %0, %1, %2, %0" : "+v"(acc[ai][bj][m][n]) : "v"(a8_), "v"(b8_)); } \
        else { _Pragma("unroll") for (int k = 0; k < 2; ++k) acc[ai][bj][m][n] = __builtin_amdgcn_mfma_f32_16x16x32_bf16(Bt[n][k], At[m][k], acc[ai][bj][m][n], 0, 0, 0); } } __builtin_amdgcn_s_setprio(0); } while (0)
#define PG8_WAIT_V(n) asm volatile("s_waitcnt vmcnt(" #n ")" ::: "memory")
#define PG8_WAIT_L(n) asm volatile("s_waitcnt lgkmcnt(" #n ")" ::: "memory")
#define PG8_BAR __builtin_amdgcn_s_barrier()
#define PG8_SCHED __builtin_amdgcn_sched_barrier(0)
    Unit cur, nxt; int ui = 0;
    if (!S.next(0, cur)) return;
    f32x4 acc[2][2][4][2];
#pragma unroll
    for (int a = 0; a < 2; ++a)
#pragma unroll
        for (int b = 0; b < 2; ++b)
#pragma unroll
            for (int m = 0; m < 4; ++m)
#pragma unroll
                for (int n = 0; n < 2; ++n) acc[a][b][m][n] = (f32x4){0.f, 0.f, 0.f, 0.f};
    bf16x8 At[4][2], B0[2][2], B1[2][2];
    const char* cA = (const char*)g.A + (size_t)cur.pm * tstep; const char* cB = (const char*)g.Bt + (size_t)cur.pn * tstep;
    S.a_ready(cur);
    if constexpr (SP2) {
        PG8_STAGE(PG8_SB(0, 0), cB, voffB); PG8_STAGE(PG8_SB(0, 1), cB + hstep, voffB); PG8_STAGE(PG8_SA(0, 0), cA, voffA); PG8_STAGE(PG8_SA(0, 1), cA + hstep, voffA);
        if (wr == 1) PG8_BAR;
        PG8_WAIT_V(2); PG8_BAR;
        PG8_STAGE(PG8_SB(1, 0), cB + kstep, voffB); PG8_STAGE(PG8_SA(1, 0), cA + kstep, voffA); PG8_STAGE(PG8_SB(1, 1), cB + hstep + kstep, voffB);
        PG8_WAIT_V(6); PG8_BAR;
    } else {
        PG8_STAGE(PG8_SB(0, 0), cB, voffB); PG8_STAGE(PG8_SA(0, 0), cA, voffA); PG8_STAGE(PG8_SB(0, 1), cB + hstep, voffB); PG8_STAGE(PG8_SA(0, 1), cA + hstep, voffA);
        if (wr == 1) PG8_BAR;
        PG8_WAIT_V(4); PG8_BAR;
        PG8_STAGE(PG8_SB(1, 0), cB + kstep, voffB); PG8_STAGE(PG8_SA(1, 0), cA + kstep, voffA); PG8_STAGE(PG8_SB(1, 1), cB + hstep + kstep, voffB);
        PG8_WAIT_V(6); PG8_BAR;
    }
    for (;;) {
        const bool has_next = S.next(ui + 1, nxt);
        const char* nA = has_next ? (const char*)g.A + (size_t)nxt.pm * tstep : cA; const char* nB = has_next ? (const char*)g.Bt + (size_t)nxt.pn * tstep : cB;
        for (int t = 0; t < nt; t += 2) {
            if constexpr (Epi::HOOK) { if (t == Epi::HOOK_T0 || t == Epi::HOOK_T1) {
                if constexpr (ALIGN_EPI) { if (wr == 0) PG8_BAR; }
                E.hook(acc, cur, t, wr, wc, fr, fq);
                if constexpr (ALIGN_EPI) { if (wr == 1) PG8_BAR; } } }
            const bool last = (t == nt - 2);
            const char* a1 = cA + (size_t)(t + 1) * kstep;
            const char* a2 = last ? nA : cA + (size_t)(t + 2) * kstep; const char* b2 = last ? nB : cB + (size_t)(t + 2) * kstep;
            const char* a3 = a2 + kstep; const char* b3 = b2 + kstep;
            if (last && has_next) S.a_ready(nxt);
            if constexpr (SP2) {
            PG8_LDB(B0, 0, 0); PG8_LDB(B1, 0, 1); PG8_SCHED; PG8_LDA(At, 0, 0); PG8_STAGE(PG8_SA(1, 1), a1 + hstep, voffA);
            PG8_WAIT_V(8); PG8_WAIT_L(0); PG8_BAR; PG8_MMA(0, 0, At, B0); PG8_MMA(0, 1, At, B1); PG8_BAR; PG8_SCHED;
            PG8_LDA(At, 0, 1); PG8_STAGE(PG8_SB(0, 0), b2, voffB); PG8_STAGE(PG8_SB(0, 1), b2 + hstep, voffB); PG8_STAGE(PG8_SA(0, 0), a2, voffA);
            PG8_WAIT_V(8); PG8_WAIT_L(0); PG8_BAR; PG8_MMA(1, 0, At, B0); PG8_MMA(1, 1, At, B1); PG8_BAR; PG8_SCHED;
            PG8_LDB(B0, 1, 0); PG8_LDB(B1, 1, 1); PG8_SCHED; PG8_LDA(At, 1, 0); PG8_STAGE(PG8_SA(0, 1), a2 + hstep, voffA);
            PG8_WAIT_V(8); PG8_WAIT_L(0); PG8_BAR; PG8_MMA(0, 0, At, B0); PG8_MMA(0, 1, At, B1); PG8_BAR; PG8_SCHED;
            PG8_LDA(At, 1, 1); PG8_STAGE(PG8_SB(1, 0), b3, voffB); PG8_STAGE(PG8_SB(1, 1), b3 + hstep, voffB); PG8_STAGE(PG8_SA(1, 0), a3, voffA);
            PG8_WAIT_V(8); PG8_WAIT_L(0); PG8_BAR; PG8_MMA(1, 0, At, B0); PG8_MMA(1, 1, At, B1); PG8_BAR; PG8_SCHED;
            } else {
            PG8_LDB(B0, 0, 0); PG8_SCHED; PG8_LDA(At, 0, 0); PG8_STAGE(PG8_SA(1, 1), a1 + hstep, voffA);
            PG8_WAIT_L(8); PG8_BAR; PG8_WAIT_L(0); PG8_MMA(0, 0, At, B0); PG8_BAR; PG8_SCHED;
            PG8_LDB(B1, 0, 1); PG8_STAGE(PG8_SB(0, 0), b2, voffB);
            PG8_BAR; PG8_WAIT_L(0); PG8_MMA(0, 1, At, B1); PG8_BAR;
            PG8_LDA(At, 0, 1); PG8_STAGE(PG8_SA(0, 0), a2, voffA);
            PG8_BAR; PG8_WAIT_L(0); PG8_MMA(1, 0, At, B0); PG8_BAR; PG8_SCHED;
            PG8_STAGE(PG8_SB(0, 1), b2 + hstep, voffB);
            PG8_WAIT_V(6); PG8_BAR; PG8_MMA(1, 1, At, B1); PG8_BAR;
            PG8_LDB(B0, 1, 0); PG8_SCHED; PG8_LDA(At, 1, 0); PG8_STAGE(PG8_SA(0, 1), a2 + hstep, voffA);
            PG8_WAIT_L(8); PG8_BAR; PG8_WAIT_L(0); PG8_MMA(0, 0, At, B0); PG8_BAR; PG8_SCHED;
            PG8_LDB(B1, 1, 1); PG8_STAGE(PG8_SB(1, 0), b3, voffB);
            PG8_BAR; PG8_WAIT_L(0); PG8_MMA(0, 1, At, B1); PG8_BAR;
            PG8_LDA(At, 1, 1); PG8_STAGE(PG8_SA(1, 0), a3, voffA);
            PG8_BAR; PG8_WAIT_L(0); PG8_MMA(1, 0, At, B0); PG8_BAR; PG8_SCHED;
            PG8_STAGE(PG8_SB(1, 1), b3 + hstep, voffB);
            PG8_WAIT_V(6); PG8_BAR; PG8_MMA(1, 1, At, B1); PG8_BAR;
            }
        }
        if constexpr (FP8) asm volatile("s_nop 15\n\ts_nop 15" ::: "memory");
        if constexpr (ALIGN_EPI) { if (wr == 0) PG8_BAR; }
        if constexpr (!Epi::AFTER_DRAIN) { E(acc, cur, wr, wc, fr, fq); S.done(cur); }
        if (!has_next) break;
#pragma unroll
        for (int a = 0; a < 2; ++a)
#pragma unroll
            for (int b = 0; b < 2; ++b)
#pragma unroll
                for (int m = 0; m < 4; ++m)
#pragma unroll
                    for (int n = 0; n < 2; ++n) acc[a][b][m][n] = (f32x4){0.f, 0.f, 0.f, 0.f};
        cur = nxt; cA = nA; cB = nB; ++ui;
        if constexpr (ALIGN_EPI) { if (wr == 1) PG8_BAR; }
    }
    PG8_WAIT_V(0);
    if constexpr (!ALIGN_EPI) { if (wr == 0) PG8_BAR; }
    PG8_BAR;
    if constexpr (Epi::AFTER_DRAIN) { E.fused(acc, cur, wr, wc, fr, fq, lds, wid, lane); S.done(cur); }
#undef PG8_SA
#undef PG8_SB
#undef PG8_STAGE
#undef PG8_LDA
#undef PG8_LDB
#undef PG8_MMA
#undef PG8_WAIT_V
#undef PG8_WAIT_L
#undef PG8_BAR
#undef PG8_SCHED
}
}

#define GAS __attribute__((address_space(1)))
#define LAS __attribute__((address_space(3)))
typedef unsigned short bf16;
typedef unsigned v4u __attribute__((ext_vector_type(4)));
typedef unsigned v2u __attribute__((ext_vector_type(2)));
typedef float f32x4 __attribute__((ext_vector_type(4)));
#define LDS_WAIT() asm volatile("s_waitcnt lgkmcnt(0)" ::: "memory")
#define VM_WAIT() asm volatile("s_waitcnt vmcnt(0)" ::: "memory")

constexpr int NWAVES = 8, NTHR = 512;
constexpr int D = 1024, NB = 16, T = 2048, NT = NB * T, W = 384, INW = 5376, DFF = 2816, NE = 8, DFE = 3584, NG = 24, NP = 64, NH = 16;
constexpr float RMS_EPS = 1e-6f;
constexpr int MAXT = 136;
static_assert(NT == pg8::NTOK, "token count");

constexpr size_t MiB = 1u << 20;
constexpr size_t WS_CTL = 0, CTL_ZERO_BYTES = 65536;
constexpr size_t WS_MISC = 1 * MiB;
constexpr size_t MS_S5PAR = 0, MS_AGG = 524288, MS_ROUTE = 1572864, MS_HIST = 2097152, MS_TOK = 2162688, MS_WTS = 2621440, MS_LRUW = 3145728;
constexpr size_t WS_W = 5 * MiB;
constexpr size_t W_IN = 0, W_GLU = W_IN + (size_t)2 * INW * D * 2, W_BR = W_GLU + (size_t)2 * 512 * W * 2, W_OUT = W_BR + (size_t)2 * 3 * D * W * 2,
                 W_FGU = W_OUT + (size_t)2 * D * D * 2, W_FD = W_FGU + (size_t)2 * DFF * D * 2, W_END = W_FD + (size_t)D * DFF * 2;
static_assert(W_END <= 47 * MiB, "weights region");
constexpr size_t WS_H = 52 * MiB, WS_Y5 = 116 * MiB, WS_P6 = 144 * MiB, WS_G = 288 * MiB, WS_Y5B = 384 * MiB, WS_HPK = 408 * MiB;
constexpr size_t P6_BLK = (size_t)NT * W * 2;
constexpr size_t WS_DACT = WS_P6;
constexpr size_t WS_MWGU = 5 * MiB, WS_MWD = 116 * MiB, WS_H2 = 173 * MiB, WS_HP = 237 * MiB, WS_ACT = 305 * MiB, WS_NEED = 556 * MiB;
static_assert(WS_MWGU + (size_t)NE * 2 * DFE * D <= WS_MWD && WS_MWD + (size_t)NE * D * DFE <= WS_P6 && WS_HPK + (size_t)NT * W * 4 <= 476 * MiB && WS_P6 + 6 * (size_t)NT * W * 2 <= WS_G && WS_G + (size_t)NT * 3072 <= WS_Y5B && WS_HP + (size_t)2 * MAXT * 256 * D <= WS_ACT && WS_ACT + (size_t)2 * MAXT * 256 * DFE <= WS_NEED && 478 * MiB + (size_t)NT * 3 * W * 2 <= WS_NEED, "moe / branch-buffer map");
constexpr int CW_BAR = 4096;
constexpr int RING_BYTES = 131072, MISC_OFF = RING_BYTES + 320, LDS_BYTES = 147456;
constexpr int MT_OFF = MISC_OFF + 128;
constexpr int MT_TEXP = 0, MT_NT = 2 * MAXT, MT_OFFS = MT_NT + 2, MT_BASE = MT_OFFS + 16, MT_TOT = MT_BASE + 16, MT_LE = MT_TOT + 16, MT_WORDS = MT_LE + 256 + 256;
static_assert(MT_OFF + MT_WORDS * 4 <= LDS_BYTES, "LDS map");

#define XB_TMO      128
#define XB_XCNT(j)  (256  + 64 * (j))
#define XB_XSUB(j)  (1280 + 64 * (j))
#define XB_XGEN(j)  (2304 + 64 * (j))
#define XB_TOP      3328
#define XB_TOPGEN   3392
#define XCD_BAR_WORDS 3456
#define XB_SPIN_CAP (1u << 18)
__device__ __forceinline__ unsigned xb_ld(unsigned* p)              { return __hip_atomic_load(p, __ATOMIC_RELAXED, __HIP_MEMORY_SCOPE_AGENT); }
__device__ __forceinline__ unsigned xb_add(unsigned* p, unsigned v) { return __hip_atomic_fetch_add(p, v, __ATOMIC_RELAXED, __HIP_MEMORY_SCOPE_AGENT); }
__device__ __forceinline__ unsigned xb_xcc_id() { return (unsigned)__builtin_amdgcn_s_getreg((3 << 11) | 20) & 0xFu; }
#define XB_SPIN(cond, bar) do { unsigned _sp = 0; while (cond) { __builtin_amdgcn_s_sleep(1); \
    if ((++_sp & 255u) == 0u) { if (xb_ld(&(bar)[XB_TMO])) break; if (_sp > XB_SPIN_CAP) { atomicAdd(&(bar)[XB_TMO], 1u); break; } } } } while (0)
struct XcdBarrier { unsigned* bar; unsigned x; volatile LAS unsigned* st; };
__device__ __forceinline__ XcdBarrier xcd_barrier_post(unsigned* bar, volatile LAS unsigned* st) {
    XcdBarrier b; b.bar = bar; b.x = xb_xcc_id(); b.st = st;
    if (threadIdx.x == 0) (void)xb_add(&bar[XB_XCNT(b.x)], 1u);
    return b;
}
__device__ __forceinline__ void xcd_barrier_complete(unsigned* bar, unsigned x, unsigned& nloc, unsigned& nx) {
    const unsigned G = gridDim.x * gridDim.y * gridDim.z;
    unsigned sum, cnt, mine, sp = 0u;
    for (;;) {
        sum = 0u; cnt = 0u; mine = 0u;
#pragma unroll
        for (unsigned j = 0; j < 16; ++j) { const unsigned c = xb_ld(&bar[XB_XCNT(j)]); sum += c; cnt += (c > 0u) ? 1u : 0u; mine = (j == x) ? c : mine; }
        if (sum == G) break;
        __builtin_amdgcn_s_sleep(1);
        if ((++sp & 255u) == 0u) { if (xb_ld(&bar[XB_TMO])) break; if (sp > XB_SPIN_CAP) { atomicAdd(&bar[XB_TMO], 1u); break; } }
    }
    nloc = mine > 0u ? mine : 1u; nx = cnt > 0u ? cnt : 1u;
}
__device__ __forceinline__ void xcd_barrier(const XcdBarrier& b) {
    asm volatile("s_waitcnt vmcnt(0)" ::: "memory");
    __syncthreads();
    if (threadIdx.x == 0) {
        unsigned* bar = b.bar;
        __builtin_amdgcn_s_waitcnt(0);
        const unsigned nloc = b.st[0], nx = b.st[1];
        const unsigned old = xb_add(&bar[XB_XSUB(b.x)], 1u);
        const unsigned gen = old / nloc;
        if (old + 1u == (gen + 1u) * nloc) {
            __builtin_amdgcn_fence(__ATOMIC_RELEASE, "agent");
            asm volatile("s_waitcnt vmcnt(0)" ::: "memory");
            const unsigned og = xb_add(&bar[XB_TOP], 1u);
            const unsigned tg = og / nx;
            if (og + 1u == (tg + 1u) * nx) xb_add(&bar[XB_TOPGEN], 1u);
            else XB_SPIN(xb_ld(&bar[XB_TOPGEN]) == tg, bar);
            __builtin_amdgcn_fence(__ATOMIC_ACQUIRE, "agent");
            xb_add(&bar[XB_XGEN(b.x)], 1u);
            asm volatile("s_waitcnt vmcnt(0)" ::: "memory");
        } else {
            XB_SPIN(xb_ld(&bar[XB_XGEN(b.x)]) == gen, bar);
            __builtin_amdgcn_fence(__ATOMIC_ACQUIRE, "agent");
            asm volatile("s_waitcnt vmcnt(0)" ::: "memory");
        }
    }
    __syncthreads();
}

__device__ __forceinline__ void xcd_barrier_census(const XcdBarrier& b) {
    if (threadIdx.x == 0) { unsigned nloc, nx; xcd_barrier_complete(b.bar, b.x, nloc, nx); b.st[0] = nloc; b.st[1] = nx; }
    __syncthreads();
}

__device__ __forceinline__ unsigned f2bf(float f) { unsigned u = __builtin_bit_cast(unsigned, f); return (u + 0x7fffu + ((u >> 16) & 1u)) >> 16; }
__device__ __forceinline__ unsigned pk2(float lo, float hi) { return f2bf(lo) | (f2bf(hi) << 16); }
__device__ __forceinline__ float bf2f(unsigned short b) { return __uint_as_float(((unsigned)b) << 16); }
__device__ __forceinline__ float wave_sum(float v) {
#pragma unroll
    for (int o = 1; o < 64; o <<= 1) v += __shfl_xor(v, o);
    return v;
}
__device__ __forceinline__ float rdlane(float v, int l) { return __int_as_float(__builtin_amdgcn_readlane(__float_as_int(v), l)); }
__device__ __forceinline__ float sigmf(float x) { return __builtin_amdgcn_rcpf(1.0f + __expf(-x)); }
__device__ __forceinline__ float one_m_exp(float x, float ex) { const float p = -x * (1.0f + x * (0.5f + x * (0.16666667f + x * (0.041666668f + x * 0.0083333338f)))); return x > -0.25f ? p : 1.0f - ex; }
__device__ __forceinline__ float gelu_tanh(float x) { const float z = 0.7978845608028654f * (x + 0.044715f * x * x * x); return x * sigmf(2.0f * z); }
__device__ __forceinline__ float softplusf(float z) { return fmaxf(z, 0.f) + log1pf(__expf(-fabsf(z))); }

__device__ __forceinline__ void tr_item(const float* W, int K, int N, bf16* WT, int kind, int aux, LAS float* scr, int item, int lane) {
    const int nblk = N / 32, kb = item / nblk, nb = item - kb * nblk, k0 = 64 * kb, n0 = 32 * nb;
    const int drow0 = (kind == 0) ? (aux + n0) : (256 * (n0 >> 7) + aux + (n0 & 127));
#pragma unroll 8
    for (int i = 0; i < 32; ++i) { const int kk = 2 * i + (lane >> 5); scr[kk * 33 + (lane & 31)] = W[(size_t)(k0 + kk) * N + n0 + (lane & 31)]; }
    LDS_WAIT();
    const int c = lane & 7;
#pragma unroll
    for (int j = 0; j < 4; ++j) { const int n = (lane >> 3) + 8 * j; const LAS float* s = scr + (8 * c) * 33 + n;
        v4u o; o.x = pk2(s[0 * 33], s[1 * 33]); o.y = pk2(s[2 * 33], s[3 * 33]); o.z = pk2(s[4 * 33], s[5 * 33]); o.w = pk2(s[6 * 33], s[7 * 33]);
        *(GAS v4u*)(WT + (size_t)(drow0 + n) * K + k0 + 8 * c) = o; }
    LDS_WAIT();
}
struct TrJob { const float* W; int K, N; bf16* WT; int kind, aux, item; int ldk = 0, koff = 0; float f8sc = 0.f; int f8row = 0; unsigned char* WT8 = nullptr; int emu = 0; };
__device__ __forceinline__ void tr_load(const TrJob& j, int lane, f32x4 (&v)[8], int ex = 0) {
    if (ex == 4) {
#pragma unroll
        for (int i = 0; i < 8; ++i) v[i] = (f32x4){0.f, 0.f, 0.f, 0.f};
        return; }
    const int nblk = j.N / 32, kb = j.item / nblk, nb = j.item - kb * nblk, k0 = 64 * kb, n0 = 32 * nb;
#pragma unroll
    for (int i = 0; i < 8; ++i) v[i] = *(const f32x4*)(j.W + (size_t)(k0 + 8 * i + (lane >> 3)) * j.N + n0 + 4 * (lane & 7));
}
__device__ __forceinline__ void tr_write(const TrJob& j, int lane, const f32x4 (&v)[8], LAS float* scr, int ex = 0) {
    const int nblk = j.N / 32, kb = j.item / nblk, nb = j.item - kb * nblk, k0 = 64 * kb, n0 = 32 * nb;
    const int drow0 = (j.kind == 0) ? (j.aux + n0) : (256 * (n0 >> 7) + j.aux + (n0 & 127));
#pragma unroll
    for (int i = 0; i < 8; ++i) { LAS float* d = scr + (8 * i + (lane >> 3)) * 33 + 4 * (lane & 7); d[0] = v[i].x; d[1] = v[i].y; d[2] = v[i].z; d[3] = v[i].w; }
    LDS_WAIT();
    const int c = lane & 7;
    if (j.f8sc != 0.f && drow0 >= j.f8row) {
        const float sc = j.f8sc; unsigned char* w8 = j.WT8 ? j.WT8 : (unsigned char*)j.WT;
#pragma unroll
        for (int q = 0; q < 4; ++q) { const int n = (lane >> 3) + 8 * q; const LAS float* sp = scr + (8 * c) * 33 + n;
            v2u o; o.x = pg8::pk4_f8(sp[0 * 33] * sc, sp[1 * 33] * sc, sp[2 * 33] * sc, sp[3 * 33] * sc); o.y = pg8::pk4_f8(sp[4 * 33] * sc, sp[5 * 33] * sc, sp[6 * 33] * sc, sp[7 * 33] * sc);
            *(GAS v2u*)(w8 + (size_t)(drow0 + n - j.f8row) * (j.ldk ? j.ldk : j.K) + j.koff + k0 + 8 * c) = o; }
        LDS_WAIT();
        return;
    }
#ifdef MK_F8EMU
    if (j.emu) {
#pragma unroll
        for (int q = 0; q < 4; ++q) { const int n = (lane >> 3) + 8 * q; LAS float* sp = scr + (8 * c) * 33 + n;
#pragma unroll
            for (int k = 0; k < 8; k += 2) { const int pk = __builtin_amdgcn_cvt_pk_fp8_f32(sp[k * 33] * 32.f, sp[(k + 1) * 33] * 32.f, 0, false);
                typedef float f2_ __attribute__((ext_vector_type(2))); const f2_ r = __builtin_amdgcn_cvt_pk_f32_fp8(pk, false); sp[k * 33] = r.x * (1.f / 32.f); sp[(k + 1) * 33] = r.y * (1.f / 32.f); } }
    }
#endif
#pragma unroll
    for (int q = 0; q < 4; ++q) { const int n = (lane >> 3) + 8 * q; const LAS float* sp = scr + (8 * c) * 33 + n;
        v4u o; o.x = pk2(sp[0 * 33], sp[1 * 33]); o.y = pk2(sp[2 * 33], sp[3 * 33]); o.z = pk2(sp[4 * 33], sp[5 * 33]); o.w = pk2(sp[6 * 33], sp[7 * 33]);
        if (ex != 3) *(GAS v4u*)(j.WT + (size_t)(drow0 + n) * (j.ldk ? j.ldk : j.K) + j.koff + k0 + 8 * c) = o; else asm volatile("" :: "v"(o.x), "v"(o.y), "v"(o.z), "v"(o.w)); }
    LDS_WAIT();
}
__device__ __forceinline__ void rms_row(const float* xrow, const float* gain, bf16* orow, int lane, f32x4 (&v)[4]) {
    const f32x4* xr = (const f32x4*)xrow + lane; const f32x4* gr = (const f32x4*)gain + lane;
    float s = 0.f;
#pragma unroll
    for (int j = 0; j < 4; ++j) { v[j] = xr[64 * j]; s += (v[j].x * v[j].x + v[j].y * v[j].y) + (v[j].z * v[j].z + v[j].w * v[j].w); }
    const float rs = 1.0f / sqrtf(wave_sum(s) * (1.f / D) + RMS_EPS);
    unsigned long long* o8 = (unsigned long long*)orow + lane;
#pragma unroll
    for (int j = 0; j < 4; ++j) { v[j] = v[j] * rs * gr[64 * j]; o8[64 * j] = (unsigned long long)pk2(v[j].x, v[j].y) | ((unsigned long long)pk2(v[j].z, v[j].w) << 32); }
}

__device__ __forceinline__ float rms_row_b(const bf16* xrow, const float* gain, bf16* orow, int lane, f32x4 (&v)[4]) {
    const v2u* xr = (const v2u*)xrow + lane; const f32x4* gr = (const f32x4*)gain + lane;
    float s = 0.f;
#pragma unroll
    for (int j = 0; j < 4; ++j) { const v2u r = xr[64 * j]; v[j] = (f32x4){__uint_as_float(r.x << 16), __uint_as_float(r.x & 0xffff0000u), __uint_as_float(r.y << 16), __uint_as_float(r.y & 0xffff0000u)};
        s += (v[j].x * v[j].x + v[j].y * v[j].y) + (v[j].z * v[j].z + v[j].w * v[j].w); }
    const float rs = 1.0f / sqrtf(wave_sum(s) * (1.f / D) + RMS_EPS);
    unsigned long long* o8 = (unsigned long long*)orow + lane;
#pragma unroll
    for (int j = 0; j < 4; ++j) { v[j] = v[j] * rs * gr[64 * j]; o8[64 * j] = (unsigned long long)pk2(v[j].x, v[j].y) | ((unsigned long long)pk2(v[j].z, v[j].w) << 32); }
    return rs;
}

__device__ __forceinline__ void s5_simple(const bf16* U, bf16* Y5, const float* par, const float* c_re, const float* c_im, const float* dvec, LAS unsigned char* lds, int G, int tid) {
    const int lane = tid & 63, w = tid >> 6;
    LAS float* E = (LAS float*)lds;
    LAS float* CM = E + 1024;
    LAS float* SB = CM + 2048 + w * (16 * 130);
    for (int item = blockIdx.x; item < NB * NG; item += G) {
        const int b = item / NG, g = item % NG;
#pragma unroll
        for (int k = 0; k < 4; ++k) { const int idx = tid + 512 * k, pq = idx >> 4, h = idx & 15;
            CM[idx] = pq < 64 ? c_re[(g * 16 + h) * 64 + pq] : -c_im[(g * 16 + h) * 64 + pq - 64]; }
        const float* pp = par + (size_t)(g * 64 + lane) * 34;
        const float are = pp[0], aim = pp[1];
        float bre[16], bim[16];
#pragma unroll
        for (int h = 0; h < 16; ++h) { bre[h] = pp[2 + h]; bim[h] = pp[18 + h]; }
        const int t0 = 256 * w;
        const bf16* ub = U + (size_t)(b * T + t0) * W + 16 * g;
        const int lt = lane >> 4, lh = lane & 15;
        float sre = 0.f, sim = 0.f;
        for (int blk = 0; blk < 16; ++blk) {
            float uu[4];
#pragma unroll
            for (int q = 0; q < 4; ++q) uu[q] = bf2f(ub[(size_t)(blk * 16 + q * 4 + lt) * W + lh]);
#pragma unroll
            for (int tl = 0; tl < 16; ++tl) {
                float br = 0.f, bi = 0.f;
#pragma unroll
                for (int h = 0; h < 16; ++h) { const float uv = rdlane(uu[tl >> 2], (tl & 3) * 16 + h); br += bre[h] * uv; bi += bim[h] * uv; }
                const float nre = are * sre - aim * sim + br, nim = are * sim + aim * sre + bi; sre = nre; sim = nim;
            }
        }
        E[w * 128 + lane] = sre; E[w * 128 + 64 + lane] = sim;
        __syncthreads();
        float pr = are, pi = aim;
#pragma unroll
        for (int k = 0; k < 8; ++k) { const float nr = pr * pr - pi * pi, ni = 2.f * pr * pi; pr = nr; pi = ni; }
        sre = 0.f; sim = 0.f;
        for (int k = 0; k < w; ++k) { const float er = E[k * 128 + lane], ei = E[k * 128 + 64 + lane]; const float nre = pr * sre - pi * sim + er, nim = pr * sim + pi * sre + ei; sre = nre; sim = nim; }
        const int ctl = lane >> 2, chq = lane & 3;
        const f32x4 dv = *(const f32x4*)(dvec + 16 * g + 4 * chq);
        for (int blk = 0; blk < 16; ++blk) {
            float uu[4];
#pragma unroll
            for (int q = 0; q < 4; ++q) uu[q] = bf2f(ub[(size_t)(blk * 16 + q * 4 + lt) * W + lh]);
            const v2u ur = *(const v2u*)(ub + (size_t)(blk * 16 + ctl) * W + 4 * chq);
#pragma unroll
            for (int tl = 0; tl < 16; ++tl) {
                float br = 0.f, bi = 0.f;
#pragma unroll
                for (int h = 0; h < 16; ++h) { const float uv = rdlane(uu[tl >> 2], (tl & 3) * 16 + h); br += bre[h] * uv; bi += bim[h] * uv; }
                const float nre = are * sre - aim * sim + br, nim = are * sim + aim * sre + bi; sre = nre; sim = nim;
                SB[tl * 130 + lane] = sre; SB[tl * 130 + 64 + lane] = sim;
            }
            LDS_WAIT();
            f32x4 acc = (f32x4){0.f, 0.f, 0.f, 0.f};
            const LAS float* srow = SB + ctl * 130;
            for (int pq = 0; pq < 128; ++pq) { const float sv = srow[pq]; const f32x4 cv = *(const LAS f32x4*)(CM + pq * 16 + 4 * chq); acc += sv * cv; }
            LDS_WAIT();
            const float u0 = __uint_as_float(ur.x << 16), u1 = __uint_as_float(ur.x & 0xffff0000u), u2 = __uint_as_float(ur.y << 16), u3 = __uint_as_float(ur.y & 0xffff0000u);
            const float y0 = gelu_tanh(acc.x + dv.x * u0), y1 = gelu_tanh(acc.y + dv.y * u1), y2 = gelu_tanh(acc.z + dv.z * u2), y3 = gelu_tanh(acc.w + dv.w * u3);
            v2u o; o.x = pk2(y0, y1); o.y = pk2(y2, y3);
            *(v2u*)(Y5 + (size_t)(b * T + t0 + blk * 16 + ctl) * W + 16 * g + 4 * chq) = o;
        }
        __syncthreads();
    }
}

__device__ __forceinline__ void attn_simple(const bf16* Q, const bf16* Kb, const bf16* Vb, bf16* O, int gtid, int nthreads) {
    for (int idx = gtid; idx < NB * 6 * T; idx += nthreads) {
        const int t = idx % T, bh = idx / T, b = bh / 6, h = bh % 6;
        const size_t tok = (size_t)b * T + t;
        float q[64], acc[64];
        { const v4u* qp = (const v4u*)(Q + tok * W + 64 * h);
#pragma unroll
          for (int i = 0; i < 8; ++i) { const v4u r = qp[i];
              q[8 * i + 0] = 0.125f * __uint_as_float(r.x << 16); q[8 * i + 1] = 0.125f * __uint_as_float(r.x & 0xffff0000u); q[8 * i + 2] = 0.125f * __uint_as_float(r.y << 16); q[8 * i + 3] = 0.125f * __uint_as_float(r.y & 0xffff0000u);
              q[8 * i + 4] = 0.125f * __uint_as_float(r.z << 16); q[8 * i + 5] = 0.125f * __uint_as_float(r.z & 0xffff0000u); q[8 * i + 6] = 0.125f * __uint_as_float(r.w << 16); q[8 * i + 7] = 0.125f * __uint_as_float(r.w & 0xffff0000u); } }
#pragma unroll
        for (int i = 0; i < 64; ++i) acc[i] = 0.f;
        float R = 0.f;
        for (int s = t - 1; s >= 0 && R > -100.f; --s) {
            const size_t ks = ((size_t)b * T + s) * W + 64 * h;
            const v4u* kp = (const v4u*)(Kb + ks);
            float z = 0.f;
#pragma unroll
            for (int i = 0; i < 8; ++i) { const v4u r = kp[i];
                z += q[8 * i + 0] * __uint_as_float(r.x << 16) + q[8 * i + 1] * __uint_as_float(r.x & 0xffff0000u) + q[8 * i + 2] * __uint_as_float(r.y << 16) + q[8 * i + 3] * __uint_as_float(r.y & 0xffff0000u)
                   + q[8 * i + 4] * __uint_as_float(r.z << 16) + q[8 * i + 5] * __uint_as_float(r.z & 0xffff0000u) + q[8 * i + 6] * __uint_as_float(r.w << 16) + q[8 * i + 7] * __uint_as_float(r.w & 0xffff0000u); }
            const float sp = softplusf(z);
            const float wgt = __expf(z - sp + R);
            R -= sp;
            const v4u* vp = (const v4u*)(Vb + ks);
#pragma unroll
            for (int i = 0; i < 8; ++i) { const v4u r = vp[i];
                acc[8 * i + 0] += wgt * __uint_as_float(r.x << 16); acc[8 * i + 1] += wgt * __uint_as_float(r.x & 0xffff0000u); acc[8 * i + 2] += wgt * __uint_as_float(r.y << 16); acc[8 * i + 3] += wgt * __uint_as_float(r.y & 0xffff0000u);
                acc[8 * i + 4] += wgt * __uint_as_float(r.z << 16); acc[8 * i + 5] += wgt * __uint_as_float(r.z & 0xffff0000u); acc[8 * i + 6] += wgt * __uint_as_float(r.w << 16); acc[8 * i + 7] += wgt * __uint_as_float(r.w & 0xffff0000u); }
        }
        v4u* op = (v4u*)(O + tok * W + 64 * h);
#pragma unroll
        for (int i = 0; i < 8; ++i) { v4u o; o.x = pk2(acc[8 * i], acc[8 * i + 1]); o.y = pk2(acc[8 * i + 2], acc[8 * i + 3]); o.z = pk2(acc[8 * i + 4], acc[8 * i + 5]); o.w = pk2(acc[8 * i + 6], acc[8 * i + 7]); op[i] = o; }
    }
}


__device__ __forceinline__ float rms_row_b8(const bf16* xrow, const float* gain, unsigned char* orow, int lane, float sc) {
    const v2u* xr = (const v2u*)xrow + lane; const f32x4* gr = (const f32x4*)gain + lane;
    f32x4 v[4]; float s = 0.f;
#pragma unroll
    for (int j = 0; j < 4; ++j) { const v2u r = xr[64 * j]; v[j] = (f32x4){__uint_as_float(r.x << 16), __uint_as_float(r.x & 0xffff0000u), __uint_as_float(r.y << 16), __uint_as_float(r.y & 0xffff0000u)};
        s += (v[j].x * v[j].x + v[j].y * v[j].y) + (v[j].z * v[j].z + v[j].w * v[j].w); }
    const float rs = 1.0f / sqrtf(wave_sum(s) * (1.f / D) + RMS_EPS);
    unsigned* o4 = (unsigned*)orow + lane;
#pragma unroll
    for (int j = 0; j < 4; ++j) { v[j] = v[j] * (rs * sc) * gr[64 * j]; o4[64 * j] = pg8::pk4_f8(v[j].x, v[j].y, v[j].z, v[j].w); }
    return rs;
}

typedef short bf16x8v __attribute__((ext_vector_type(8)));
typedef float f32x16 __attribute__((ext_vector_type(16)));
typedef float f32x2v __attribute__((ext_vector_type(2)));
typedef __bf16 bf16x2cv __attribute__((ext_vector_type(2)));
__device__ __forceinline__ unsigned cvt2f(float lo, float hi) { const f32x2v v = {lo, hi}; return __builtin_bit_cast(unsigned, __builtin_convertvector(v, bf16x2cv)); }
__device__ __forceinline__ void attn_item(int item, const bf16* Q, const bf16* Kb, const bf16* VT, bf16* O, int ldo, int lane) {
    const int r = lane & 31, hf = lane >> 5;
    {
        const int qb = 63 - (item & 63), bh = item >> 6, b = bh / 6, h = bh % 6, q0 = qb * 32;
        const bf16* qrow = Q + (size_t)(b * T + q0 + r) * W + 64 * h + 8 * hf;
        bf16x8v qf[4];
#pragma unroll
        for (int ks = 0; ks < 4; ++ks) qf[ks] = *(const bf16x8v*)(qrow + 16 * ks);
        f32x16 o0, o1;
#pragma unroll
        for (int i = 0; i < 16; ++i) { o0[i] = 0.f; o1[i] = 0.f; }
        float R = 1.0f;
        const bf16* kbase = Kb + (size_t)(b * T) * W + 64 * h + 8 * hf;
        const bf16* vbase = VT + (size_t)(bh * 64 + r) * T + 4 * hf;
        bf16x8v kf[4], vf[2][2];
#define ATT_LOAD(KF, VF, K0) do { _Pragma("unroll") for (int ks = 0; ks < 4; ++ks) KF[ks] = *(const bf16x8v*)(kbase + (size_t)((K0) + r) * W + 16 * ks); \
            _Pragma("unroll") for (int mb = 0; mb < 2; ++mb) _Pragma("unroll") for (int s2 = 0; s2 < 2; ++s2) { const bf16* vp = vbase + (size_t)(32 * mb) * T + (K0) + 16 * s2; const v2u lo_ = *(const v2u*)vp, hi_ = *(const v2u*)(vp + 8); \
                const v4u pk_ = (v4u){lo_.x, lo_.y, hi_.x, hi_.y}; VF[mb][s2] = __builtin_bit_cast(bf16x8v, pk_); } } while (0)
        ATT_LOAD(kf, vf, q0);
        bf16x8v kf1[4], vf1[2][2];
        { const int k1 = qb > 0 ? (qb - 1) * 32 : 0; ATT_LOAD(kf1, vf1, k1); }
        for (int kt = qb; kt >= 0; --kt) {
            bf16x8v kfn[4], vfn[2][2];
            { const int kn = kt > 1 ? (kt - 2) * 32 : 0; ATT_LOAD(kfn, vfn, kn); }
            f32x16 sa;
#pragma unroll
            for (int i = 0; i < 16; ++i) sa[i] = 0.f;
#pragma unroll
            for (int ks = 0; ks < 4; ++ks) sa = __builtin_amdgcn_mfma_f32_32x32x16_bf16(kf[ks], qf[ks], sa, 0, 0, 0);
            const bool diag = (kt == qb);
            float om[16], be[16];
#pragma unroll
            for (int i = 0; i < 16; ++i) { const float e = __builtin_amdgcn_exp2f(-fabsf(sa[i]) * (0.125f * 1.44269504f)); const float rr = __builtin_amdgcn_rcpf(1.0f + e); const float er = e * rr;
                const bool pos = sa[i] >= 0.f; be[i] = pos ? rr : er; om[i] = pos ? er : rr; }
            if (diag) {
#pragma unroll
                for (int i = 0; i < 16; ++i) { const bool valid = (((i & 3) + 8 * (i >> 2) + 4 * hf) < r); be[i] = valid ? be[i] : 0.f; om[i] = valid ? om[i] : 1.0f; }
            }
            float gs[4], pg[4];
#pragma unroll
            for (int g = 0; g < 4; ++g) { gs[g] = (om[4 * g] * om[4 * g + 1]) * (om[4 * g + 2] * om[4 * g + 3]); pg[g] = __shfl_xor(gs[g], 32); }
            float sg[4], tail = 1.0f;
#pragma unroll
            for (int g = 3; g >= 0; --g) { sg[g] = hf == 0 ? tail * pg[g] : tail; tail *= gs[g] * pg[g]; }
            float w[16];
#pragma unroll
            for (int g = 0; g < 4; ++g) { const float base = R * sg[g];
                const float e2 = base * om[4 * g + 3], e1 = e2 * om[4 * g + 2], e0 = e1 * om[4 * g + 1];
                w[4 * g + 3] = be[4 * g + 3] * base; w[4 * g + 2] = be[4 * g + 2] * e2; w[4 * g + 1] = be[4 * g + 1] * e1; w[4 * g] = be[4 * g] * e0; }
            R *= tail;
            bf16x8v wf[2];
#pragma unroll
            for (int s = 0; s < 2; ++s) { const v4u pk = (v4u){cvt2f(w[8 * s], w[8 * s + 1]), cvt2f(w[8 * s + 2], w[8 * s + 3]), cvt2f(w[8 * s + 4], w[8 * s + 5]), cvt2f(w[8 * s + 6], w[8 * s + 7])}; wf[s] = __builtin_bit_cast(bf16x8v, pk); }
#pragma unroll
            for (int s = 0; s < 2; ++s) { o0 = __builtin_amdgcn_mfma_f32_32x32x16_bf16(vf[0][s], wf[s], o0, 0, 0, 0); o1 = __builtin_amdgcn_mfma_f32_32x32x16_bf16(vf[1][s], wf[s], o1, 0, 0, 0); }
            if (__all(R < 1.0e-12f)) break;
#pragma unroll
            for (int ks = 0; ks < 4; ++ks) { kf[ks] = kf1[ks]; kf1[ks] = kfn[ks]; }
#pragma unroll
            for (int mb = 0; mb < 2; ++mb) { vf[mb][0] = vf1[mb][0]; vf[mb][1] = vf1[mb][1]; vf1[mb][0] = vfn[mb][0]; vf1[mb][1] = vfn[mb][1]; }
        }
#undef ATT_LOAD
        bf16* orow = O + (size_t)(b * T + q0 + r) * ldo + 64 * h + 4 * hf;
#pragma unroll
        for (int g = 0; g < 4; ++g) { v2u a, c2; a.x = cvt2f(o0[4 * g], o0[4 * g + 1]); a.y = cvt2f(o0[4 * g + 2], o0[4 * g + 3]); c2.x = cvt2f(o1[4 * g], o1[4 * g + 1]); c2.y = cvt2f(o1[4 * g + 2], o1[4 * g + 3]);
            *(v2u*)(orow + 8 * g) = a; *(v2u*)(orow + 32 + 8 * g) = c2; }
    }
}


typedef float f32x4v __attribute__((ext_vector_type(4)));
struct Cplx { float re, im; };
__device__ __forceinline__ Cplx cmul(Cplx a, Cplx b) { return Cplx{a.re * b.re - a.im * b.im, a.re * b.im + a.im * b.re}; }
__device__ __forceinline__ Cplx cfma(Cplx a, Cplx s, Cplx c) { return Cplx{a.re * s.re - a.im * s.im + c.re, a.re * s.im + a.im * s.re + c.im}; }
__device__ __forceinline__ bf16x8v pack8f(const float* v) { const v4u pk = (v4u){cvt2f(v[0], v[1]), cvt2f(v[2], v[3]), cvt2f(v[4], v[5]), cvt2f(v[6], v[7])}; return __builtin_bit_cast(bf16x8v, pk); }
__device__ __forceinline__ void s5_scan_state(float (&re)[16], float (&im)[16], Cplx a1, Cplx a2, Cplx a3, Cplx a4, Cplx& carry, int hf) {
    Cplx e[4], pe[4];
#pragma unroll
    for (int g = 0; g < 4; ++g) {
        Cplx l = Cplx{re[4 * g], im[4 * g]};
#pragma unroll
        for (int k = 1; k < 4; ++k) { l = cfma(a1, l, Cplx{re[4 * g + k], im[4 * g + k]}); re[4 * g + k] = l.re; im[4 * g + k] = l.im; }
        e[g] = l; pe[g].re = __shfl_xor(l.re, 32); pe[g].im = __shfl_xor(l.im, 32);
    }
    Cplx S = carry, sst[4];
#pragma unroll
    for (int g = 0; g < 4; ++g) {
        const Cplx elo = hf == 0 ? e[g] : pe[g], ehi = hf == 0 ? pe[g] : e[g];
        const Cplx S1 = cfma(a4, S, elo);
        sst[g] = hf == 0 ? S : S1;
        S = cfma(a4, S1, ehi);
    }
    carry = S;
#pragma unroll
    for (int g = 0; g < 4; ++g) {
        const Cplx f0 = cmul(a1, sst[g]), f1 = cmul(a2, sst[g]), f2 = cmul(a3, sst[g]), f3 = cmul(a4, sst[g]);
        re[4 * g] += f0.re; im[4 * g] += f0.im; re[4 * g + 1] += f1.re; im[4 * g + 1] += f1.im; re[4 * g + 2] += f2.re; im[4 * g + 2] += f2.im; re[4 * g + 3] += f3.re; im[4 * g + 3] += f3.im;
    }
}
constexpr int S5_LROW = 304;
__device__ __forceinline__ void s5_item(int item, const bf16* U, bf16* Y5, const float* par, const float* c_re, const float* c_im, const float* dvec, LAS unsigned char* ldsw, int lane) {
    const int b = item / NG, g = item % NG, r = lane & 31, hf = lane >> 5, l15 = lane & 15, kq = lane >> 4;
    bf16x8v bB[4], cB[4], dB;
    Cplx aA1, aB1;
    { const float* pa = par + (size_t)(g * 64 + r) * 34; const float* pb = par + (size_t)(g * 64 + 32 + r) * 34;
      aA1 = Cplx{pa[0], pa[1]}; aB1 = Cplx{pb[0], pb[1]};
      float t8[8];
#pragma unroll
      for (int j = 0; j < 8; ++j) t8[j] = pa[2 + 8 * hf + j]; bB[0] = pack8f(t8);
#pragma unroll
      for (int j = 0; j < 8; ++j) t8[j] = pb[2 + 8 * hf + j]; bB[1] = pack8f(t8);
#pragma unroll
      for (int j = 0; j < 8; ++j) t8[j] = pa[18 + 8 * hf + j]; bB[2] = pack8f(t8);
#pragma unroll
      for (int j = 0; j < 8; ++j) t8[j] = pb[18 + 8 * hf + j]; bB[3] = pack8f(t8); }
    {
        const float* cr = c_re + (size_t)(g * 16 + l15) * 64; const float* ci = c_im + (size_t)(g * 16 + l15) * 64;
#pragma unroll
        for (int ks = 0; ks < 4; ++ks) { float t8[8];
#pragma unroll
            for (int j = 0; j < 8; ++j) { const int kk = 32 * ks + 8 * kq + j, rr = kk >> 2, c = kk & 3; t8[j] = c == 0 ? cr[rr] : c == 1 ? cr[32 + rr] : c == 2 ? -ci[rr] : -ci[32 + rr]; }
            cB[ks] = pack8f(t8); }
        const float dh = dvec[16 * g + l15]; float t8[8];
#pragma unroll
        for (int j = 0; j < 8; ++j) t8[j] = (8 * kq + j == l15) ? dh : 0.f;
        dB = pack8f(t8);
    }
    const Cplx aA2 = cmul(aA1, aA1), aA3 = cmul(aA2, aA1), aA4 = cmul(aA2, aA2), aB2 = cmul(aB1, aB1), aB3 = cmul(aB2, aB1), aB4 = cmul(aB2, aB2);
    Cplx cyA = Cplx{0.f, 0.f}, cyB = Cplx{0.f, 0.f};
    const bf16* ua = U + (size_t)(b * T + r) * W + 16 * g + 8 * hf;
    bf16* yo = Y5 + (size_t)(b * T + 4 * kq) * W + 16 * g + l15;
    bf16x8v rA[4];
#pragma unroll
    for (int j = 0; j < 3; ++j) rA[j] = *(const bf16x8v*)(ua + (size_t)(32 * j) * W);
    for (int c4 = 0; c4 < T / 32; c4 += 4) {
#pragma unroll
      for (int jj = 0; jj < 4; ++jj) {
        const int c = c4 + jj, t0 = 32 * c;
        { const int cn = c + 3 < T / 32 ? c + 3 : T / 32 - 1; const int sl = (jj + 3) & 3;
          rA[sl] = *(const bf16x8v*)(ua + (size_t)(32 * cn) * W); }
        const bf16x8v uA = rA[jj];
        *(LAS bf16x8v*)(ldsw + r * S5_LROW + 256 + 16 * hf) = uA;
        f32x16 z16;
#pragma unroll
        for (int i = 0; i < 16; ++i) z16[i] = 0.f;
        f32x16 b0 = __builtin_amdgcn_mfma_f32_32x32x16_bf16(uA, bB[0], z16, 0, 0, 0), b1 = __builtin_amdgcn_mfma_f32_32x32x16_bf16(uA, bB[1], z16, 0, 0, 0);
        f32x16 b2 = __builtin_amdgcn_mfma_f32_32x32x16_bf16(uA, bB[2], z16, 0, 0, 0), b3 = __builtin_amdgcn_mfma_f32_32x32x16_bf16(uA, bB[3], z16, 0, 0, 0);
        float reA[16], imA[16], reB[16], imB[16];
#pragma unroll
        for (int i = 0; i < 16; ++i) { reA[i] = b0[i]; reB[i] = b1[i]; imA[i] = b2[i]; imB[i] = b3[i]; }
        s5_scan_state(reA, imA, aA1, aA2, aA3, aA4, cyA, hf);
        s5_scan_state(reB, imB, aB1, aB2, aB3, aB4, cyB, hf);
#pragma unroll
        for (int i = 0; i < 16; ++i) { const int tl = (i & 3) + 8 * (i >> 2) + 4 * hf; v2u o; o.x = cvt2f(reA[i], reB[i]); o.y = cvt2f(imA[i], imB[i]); *(LAS v2u*)(ldsw + tl * S5_LROW + 8 * r) = o; }
        LDS_WAIT();
#pragma unroll
        for (int tb = 0; tb < 2; ++tb) {
            f32x4v acc = (f32x4v){0.f, 0.f, 0.f, 0.f};
#pragma unroll
            for (int ks = 0; ks < 4; ++ks) { const bf16x8v aS = *(const LAS bf16x8v*)(ldsw + (16 * tb + l15) * S5_LROW + (32 * ks + 8 * kq) * 2); acc = __builtin_amdgcn_mfma_f32_16x16x32_bf16(aS, cB[ks], acc, 0, 0, 0); }
            { bf16x8v uD = *(const LAS bf16x8v*)(ldsw + (16 * tb + l15) * S5_LROW + 256 + 16 * (kq & 1)); if (kq >= 2) uD = (bf16x8v){0, 0, 0, 0, 0, 0, 0, 0}; acc = __builtin_amdgcn_mfma_f32_16x16x32_bf16(uD, dB, acc, 0, 0, 0); }
#pragma unroll
            for (int q = 0; q < 4; ++q) yo[(size_t)(t0 + 16 * tb + q) * W] = (bf16)(cvt2f(gelu_tanh(acc[q]), 0.f) & 0xffffu);
        }
        LDS_WAIT();
      }
    }
}

constexpr int LRU_LROW = 144;
__device__ __forceinline__ void lru_item(int pass, int item, const bf16* XL, const bf16* YL, bf16* OB, float* AGG, const float* conv_w, const float* conv_b, const bf16* wT, const float* b_a, const float* b_x,
                                         const float* lam, LAS unsigned char* ldsw, int lane, unsigned* HPK = nullptr) {
    const int c = item & 15, bh = item >> 4, b = bh / 6, hd = bh % 6, ch = 64 * hd + lane, r = lane & 31, hf = lane >> 5;
    const bf16* wTl = wT + (size_t)(hd * 64 + r) * 64 + 8 * hf;
    const float cw0 = conv_w[0 * W + ch], cw1 = conv_w[1 * W + ch], cw2 = conv_w[2 * W + ch], cw3 = conv_w[3 * W + ch], cb = conv_b[ch];
    const float lm = lam[ch];
    const float ls8 = 8.0f * (fminf(lm, 0.f) - log1pf(__expf(-fabsf(lm))));
    const int t0 = 128 * c;
    const bf16* xb = XL + (size_t)(b * T) * W + ch;
    const bf16* yb = YL + (size_t)(b * T) * W + ch;
    bf16* ob = OB + (size_t)(b * T) * (3 * W) + 2 * W + ch;
    float xm3 = t0 >= 3 ? bf2f(xb[(size_t)(t0 - 3) * W]) : 0.f, xm2 = t0 >= 2 ? bf2f(xb[(size_t)(t0 - 2) * W]) : 0.f, xm1 = t0 >= 1 ? bf2f(xb[(size_t)(t0 - 1) * W]) : 0.f;
    float hst = 0.f, sumlog = 0.f, prod = 1.0f;
    unsigned* hpk = HPK + (size_t)(b * T) * W + ch;
    if (pass == 2) { const float* ag = AGG + (size_t)(bh * 16) * 128 + lane;
        for (int k = 0; k < c; ++k) hst = ag[k * 128] * hst + ag[k * 128 + 64]; }
    typedef unsigned short us2 __attribute__((ext_vector_type(2)));
    us2 xnx[16];
#pragma unroll
    for (int k = 0; k < 16; ++k) { xnx[k].x = xb[(size_t)(t0 + 2 * k) * W]; xnx[k].y = xb[(size_t)(t0 + 2 * k + 1) * W]; }
    for (int blk = 0; blk < 4; ++blk) {
        const int tb0 = t0 + 32 * blk;
        float xc[32];
#pragma unroll
        for (int k = 0; k < 16; ++k) { xc[2 * k] = bf2f(xnx[k].x); xc[2 * k + 1] = bf2f(xnx[k].y); }
        { const int tn = blk < 3 ? tb0 + 32 : tb0;
#pragma unroll
          for (int k = 0; k < 16; ++k) { xnx[k].x = xb[(size_t)(tn + 2 * k) * W]; xnx[k].y = xb[(size_t)(tn + 2 * k + 1) * W]; } }
        us2 yv2[16];
        if (pass == 2) {
#pragma unroll
            for (int k = 0; k < 16; ++k) { yv2[k].x = yb[(size_t)(tb0 + 2 * k) * W]; yv2[k].y = yb[(size_t)(tb0 + 2 * k + 1) * W]; }
        }
#pragma unroll
        for (int k = 0; k < 32; ++k) { const float xv = xc[k]; xc[k] = cw0 * xm3 + cw1 * xm2 + cw2 * xm1 + cw3 * xv + cb; xm3 = xm2; xm2 = xm1; xm1 = xv; }
#pragma unroll
        for (int k = 0; k < 32; k += 2) { const unsigned pk = cvt2f(xc[k], xc[k + 1]); *(LAS unsigned short*)(ldsw + k * LRU_LROW + 2 * lane) = (unsigned short)(pk & 0xffffu); *(LAS unsigned short*)(ldsw + (k + 1) * LRU_LROW + 2 * lane) = (unsigned short)(pk >> 16); }
        LDS_WAIT();
        bf16x8v aX[4];
#pragma unroll
        for (int ks = 0; ks < 4; ++ks) aX[ks] = *(const LAS bf16x8v*)(ldsw + r * LRU_LROW + (16 * ks + 8 * hf) * 2);
        LDS_WAIT();
        float lo[2][16], hi[2][16];
#pragma unroll
        for (int mat = 0; mat < 2; ++mat) {
            f32x16 d0, d1;
#pragma unroll
            for (int i = 0; i < 16; ++i) { d0[i] = 0.f; d1[i] = 0.f; }
#pragma unroll
            for (int ks = 0; ks < 4; ++ks) { const bf16x8v w0 = *(const bf16x8v*)(wTl + (size_t)mat * 6 * 4096 + 16 * ks), w1 = *(const bf16x8v*)(wTl + (size_t)mat * 6 * 4096 + 32 * 64 + 16 * ks);
                d0 = __builtin_amdgcn_mfma_f32_32x32x16_bf16(aX[ks], w0, d0, 0, 0, 0); d1 = __builtin_amdgcn_mfma_f32_32x32x16_bf16(aX[ks], w1, d1, 0, 0, 0); }
            const float bz0 = (mat == 0 ? b_a : b_x)[64 * hd + r], bz1 = (mat == 0 ? b_a : b_x)[64 * hd + 32 + r];
#pragma unroll
            for (int i = 0; i < 16; ++i) { const float x0 = d0[i] + bz0, x1 = d1[i] + bz1;
                const auto rr = __builtin_amdgcn_permlane32_swap(__float_as_uint(x0), __float_as_uint(x1), false, false); lo[mat][i] = __uint_as_float(rr[0]); hi[mat][i] = __uint_as_float(rr[1]); }
            asm volatile("s_nop 7\n\ts_nop 7" : "+v"(lo[mat][0]), "+v"(lo[mat][1]), "+v"(lo[mat][2]), "+v"(lo[mat][3]), "+v"(lo[mat][4]), "+v"(lo[mat][5]), "+v"(lo[mat][6]), "+v"(lo[mat][7]), "+v"(lo[mat][8]), "+v"(lo[mat][9]), "+v"(lo[mat][10]), "+v"(lo[mat][11]), "+v"(lo[mat][12]), "+v"(lo[mat][13]), "+v"(lo[mat][14]), "+v"(lo[mat][15]));
            asm volatile("" : "+v"(hi[mat][0]), "+v"(hi[mat][1]), "+v"(hi[mat][2]), "+v"(hi[mat][3]), "+v"(hi[mat][4]), "+v"(hi[mat][5]), "+v"(hi[mat][6]), "+v"(hi[mat][7]), "+v"(hi[mat][8]), "+v"(hi[mat][9]), "+v"(hi[mat][10]), "+v"(hi[mat][11]), "+v"(hi[mat][12]), "+v"(hi[mat][13]), "+v"(hi[mat][14]), "+v"(hi[mat][15]));
        }
#pragma unroll
        for (int k8 = 0; k8 < 32; k8 += 8) {
#pragma unroll
            for (int kk = 0; kk < 8; ++kk) {
                const int k = k8 + kk;
                const int i = 4 * (k >> 3) + (k & 3); const bool up = ((k >> 2) & 1) != 0;
                const float ra = (up ? hi[0][i] : lo[0][i]), ri = (up ? hi[1][i] : lo[1][i]);
                const float rg = sigmf(ra), ig = sigmf(ri), log_a = ls8 * rg, a = __expf(log_a);
                const float bb = __builtin_amdgcn_sqrtf(fmaxf(one_m_exp(2.0f * log_a, a * a), 0.f)) * (ig * xc[k]);
                hst = a * hst + bb;
                if (pass == 1) { prod *= a; hpk[(size_t)(tb0 + k) * W] = cvt2f(hst, prod); }
                else ob[(size_t)(tb0 + k) * (3 * W)] = (bf16)(cvt2f(hst * gelu_tanh(bf2f((k & 1) ? yv2[k >> 1].y : yv2[k >> 1].x)), 0.f) & 0xffffu);
            }
        }
    }
    if (pass == 1) { float* ag = AGG + (size_t)(bh * 16 + c) * 128 + lane; ag[0] = prod; ag[64] = hst; }
    (void)sumlog;
}
__device__ __forceinline__ void lru2_item(int item, const unsigned* HPK, const bf16* YL, bf16* OB, const float* AGG, int lane) {
    const int c = item & 15, bh = item >> 4, b = bh / 6, hd = bh % 6, cg = lane & 7, ts = lane >> 3, ch0 = 64 * hd + 8 * cg;
    float carry[8];
#pragma unroll
    for (int j = 0; j < 8; ++j) carry[j] = 0.f;
    const float* ag = AGG + (size_t)(bh * 16) * 128 + 8 * cg;
    for (int k0 = 0; k0 < c; k0 += 4) {
        f32x4v av[4][2], hv[4][2];
#pragma unroll
        for (int kk = 0; kk < 4; ++kk) { const float* q = ag + (size_t)(k0 + kk) * 128; av[kk][0] = *(const f32x4v*)q; av[kk][1] = *(const f32x4v*)(q + 4); hv[kk][0] = *(const f32x4v*)(q + 64); hv[kk][1] = *(const f32x4v*)(q + 68); }
#pragma unroll
        for (int kk = 0; kk < 4; ++kk) { const bool on = (k0 + kk) < c;
#pragma unroll
            for (int j = 0; j < 8; ++j) { const float a = on ? av[kk][j >> 2][j & 3] : 1.0f, h = on ? hv[kk][j >> 2][j & 3] : 0.f; carry[j] = a * carry[j] + h; } }
    }
    const size_t row0 = (size_t)(b * T + 128 * c + ts);
#pragma unroll 4
    for (int s = 0; s < 16; ++s) {
        const size_t row = row0 + 8 * s;
        const v4u p0 = *(const v4u*)(HPK + row * W + ch0), p1 = *(const v4u*)(HPK + row * W + ch0 + 4);
        const v4u yv = *(const v4u*)(YL + row * W + ch0);
        const unsigned pp[8] = {p0.x, p0.y, p0.z, p0.w, p1.x, p1.y, p1.z, p1.w};
        const unsigned yy[4] = {yv.x, yv.y, yv.z, yv.w};
        float o[8];
#pragma unroll
        for (int j = 0; j < 8; ++j) { const float hl = __uint_as_float(pp[j] << 16), pr = __uint_as_float(pp[j] & 0xffff0000u);
            const float y = __uint_as_float((j & 1) ? (yy[j >> 1] & 0xffff0000u) : (yy[j >> 1] << 16));
            o[j] = (hl + pr * carry[j]) * gelu_tanh(y); }
        const v4u ov = (v4u){cvt2f(o[0], o[1]), cvt2f(o[2], o[3]), cvt2f(o[4], o[5]), cvt2f(o[6], o[7])};
        *(v4u*)(OB + row * (3 * W) + 2 * W + ch0) = ov;
    }
}

__device__ __forceinline__ void lru_pass(int pass, const bf16* XL, bf16* YL, float* AGG, const float* conv_w, const float* conv_b, const float* w_a, const float* b_a, const float* w_x, const float* b_x,
                                         const float* lam, int gw, int ngw, int lane) {
    for (int item = gw; item < NB * 6 * 16; item += ngw) {
        const int c = item & 15, bh = item >> 4, b = bh / 6, hd = bh % 6, ch = 64 * hd + lane;
        float wa[64], wx[64];
#pragma unroll
        for (int i = 0; i < 64; ++i) { wa[i] = w_a[(hd * 64 + i) * 64 + lane]; wx[i] = w_x[(hd * 64 + i) * 64 + lane]; }
        const float cw0 = conv_w[0 * W + ch], cw1 = conv_w[1 * W + ch], cw2 = conv_w[2 * W + ch], cw3 = conv_w[3 * W + ch], cb = conv_b[ch];
        const float ba = b_a[ch], bx = b_x[ch];
        const float lm = lam[ch];
        const float ls8 = 8.0f * (fminf(lm, 0.f) - log1pf(__expf(-fabsf(lm))));
        const int t0 = 128 * c;
        const bf16* xb = XL + (size_t)(b * T) * W + ch;
        bf16* yb = YL + (size_t)(b * T) * W + ch;
        float xm3 = t0 >= 3 ? bf2f(xb[(size_t)(t0 - 3) * W]) : 0.f, xm2 = t0 >= 2 ? bf2f(xb[(size_t)(t0 - 2) * W]) : 0.f, xm1 = t0 >= 1 ? bf2f(xb[(size_t)(t0 - 1) * W]) : 0.f;
        float hst = 0.f, sumlog = 0.f;
        if (pass == 2) { const float* ag = AGG + (size_t)(bh * 16) * 128 + lane;
            for (int k = 0; k < c; ++k) hst = ag[k * 128] * hst + ag[k * 128 + 64]; }
        for (int tb = 0; tb < 128; tb += 8) {
            float xv[8], yv[8];
#pragma unroll
            for (int k = 0; k < 8; ++k) { xv[k] = bf2f(xb[(size_t)(t0 + tb + k) * W]); yv[k] = (pass == 2) ? bf2f(yb[(size_t)(t0 + tb + k) * W]) : 0.f; }
#pragma unroll
            for (int k = 0; k < 8; ++k) {
                const float xc = cw0 * xm3 + cw1 * xm2 + cw2 * xm1 + cw3 * xv[k] + cb;
                xm3 = xm2; xm2 = xm1; xm1 = xv[k];
                float ra = ba, ri = bx;
#pragma unroll
                for (int i = 0; i < 64; ++i) { const float xi = rdlane(xc, i); ra += xi * wa[i]; ri += xi * wx[i]; }
                const float r = sigmf(ra), ig = sigmf(ri);
                const float log_a = ls8 * r;
                const float a = __expf(log_a);
                const float bb = sqrtf(fmaxf(-expm1f(2.0f * log_a), 0.f)) * (ig * xc);
                hst = a * hst + bb;
                if (pass == 1) sumlog += log_a;
                else yb[(size_t)(t0 + tb + k) * W] = (bf16)f2bf(hst * gelu_tanh(yv[k]));
            }
        }
        if (pass == 1) { float* ag = AGG + (size_t)(bh * 16 + c) * 128 + lane; ag[0] = __expf(sumlog); ag[64] = hst; }
    }
}

__device__ __forceinline__ void moe_tables(const int* HIST, LAS unsigned char* lds, int tid) {
    LAS int* HL = (LAS int*)lds;
    LAS int* MT = (LAS int*)(lds + MT_OFF);
    for (int i = tid; i < 4096; i += NTHR) HL[i] = __hip_atomic_load(HIST + i, __ATOMIC_RELAXED, __HIP_MEMORY_SCOPE_AGENT);
    __syncthreads();
    { const int col = tid & 15, part = tid >> 4; int tot = 0, base = 0;
#pragma unroll
      for (int k = 0; k < 8; ++k) { const int c = part * 8 + k, v = HL[c * 16 + col]; tot += v; base += (c < (int)blockIdx.x) ? v : 0; }
      __syncthreads();
      HL[tid] = tot; HL[512 + tid] = base; }
    __syncthreads();
    if (tid < 16) { int tot = 0, base = 0; for (int q = 0; q < 32; ++q) { tot += HL[q * 16 + tid]; base += HL[512 + q * 16 + tid]; } MT[MT_TOT + tid] = tot; MT[MT_BASE + tid] = base; }
    __syncthreads();
    if (tid < 2) { int off = 0, tiles = 0;
        for (int e = 0; e < 8; ++e) { const int pad = (MT[MT_TOT + tid * 8 + e] + 255) & ~255; MT[MT_OFFS + tid * 8 + e] = off; for (int k = 0; k < (pad >> 8) && tiles < MAXT; ++k) MT[MT_TEXP + tid * MAXT + tiles++] = e; off += pad; }
        MT[MT_NT + tid] = tiles; }
    __syncthreads();
}

struct Args { const float* in[33]; float* out; unsigned char* ws; int ph_lo, ph_hi, li, pad; };
constexpr int N_PHASES = 23;
#ifndef R_PREP
#define R_PREP 1
#endif
#ifndef R_INPROJ
#define R_INPROJ 1
#endif
#ifndef R_S5
#define R_S5 1
#endif
#ifndef R_ATTN
#define R_ATTN 1
#endif
#ifndef R_LRU1
#define R_LRU1 1
#endif
#ifndef R_LRU2
#define R_LRU2 1
#endif
#ifndef R_GLU
#define R_GLU 1
#endif
#ifndef R_MERGED
#define R_MERGED 1
#endif
#ifndef R_OUT0
#define R_OUT0 1
#endif
#ifndef R_NORM
#define R_NORM 1
#endif
#ifndef R_FGU
#define R_FGU 1
#endif
#ifndef R_P15
#define R_P15 1
#endif
#ifndef R_MGU
#define R_MGU 1
#endif

#ifndef GP_ALIGN
#define GP_ALIGN true
#endif
#ifndef GP_SP2
#define GP_SP2 true
#endif
#ifndef MK_STOP
#define MK_STOP N_PHASES
#endif

__global__ void __launch_bounds__(NTHR, 2) hybrid_fwd(Args args) {
    extern __shared__ __attribute__((aligned(16))) unsigned char lds_raw[];
    LAS unsigned char* lds = (LAS unsigned char*)lds_raw;
    volatile LAS unsigned* MISC = (volatile LAS unsigned*)(lds + MISC_OFF);
    LAS int* MT = (LAS int*)(lds + MT_OFF);
    const int tid0 = threadIdx.x;
    int wave0 = __builtin_amdgcn_readfirstlane(tid0 >> 6); asm volatile("" : "+s"(wave0));
    const int G = gridDim.x, bx0 = blockIdx.x;
    const int NGW = G * NWAVES, NTH = G * NTHR;
    unsigned char* ws0 = args.ws;
    unsigned* ctl = (unsigned*)(ws0 + WS_CTL);
    const int lo = args.ph_lo, hi = args.ph_hi;
    for (int u = tid0; u < (LDS_BYTES - RING_BYTES) / 4; u += NTHR) ((LAS unsigned*)(lds + RING_BYTES))[u] = 0u;
    __syncthreads();
    XcdBarrier bar; bar.bar = ctl + CW_BAR + args.li * XCD_BAR_WORDS; bar.x = 0; bar.st = nullptr;
    if (hi - lo > 1) { bar = xcd_barrier_post(ctl + CW_BAR + args.li * XCD_BAR_WORDS, MISC + 8); xcd_barrier_census(bar); }
#define PHASE_VARS int tid = wave0 * 64 + (int)__builtin_amdgcn_mbcnt_hi(~0u, __builtin_amdgcn_mbcnt_lo(~0u, 0u)); asm volatile("" : "+v"(tid)); int bx = bx0; asm volatile("" : "+s"(bx)); unsigned char* ws = ws0; asm volatile("" : "+s"(ws)); \
    const int lane = tid & 63, wave = __builtin_amdgcn_readfirstlane(tid >> 6), gw = wave * G + bx, gtid = bx * NTHR + tid; (void)lane; (void)wave; (void)gw; (void)gtid; (void)ws;
#define IN(k) (lo <= (k) && (k) < hi)
#ifndef R_MERGED
#define R_MERGED 1
#endif
#ifndef PROBE_MASK
#define PROBE_MASK 0u
#endif
    unsigned long long pt0_ = PROBE_MASK ? __builtin_amdgcn_s_memrealtime() : 0ull;
#define PROBE_T1(k) do { if ((PROBE_MASK >> (k)) & 1u) { __syncthreads(); const unsigned long long d_ = __builtin_amdgcn_s_memrealtime() - pt0_; while (__builtin_amdgcn_s_memrealtime() - pt0_ < 2ull * d_) __builtin_amdgcn_s_sleep(8); } } while (0)
#define SEAM(k) do { PROBE_T1(k); if (IN((k) + 1)) xcd_barrier(bar); if (PROBE_MASK) pt0_ = __builtin_amdgcn_s_memrealtime(); } while (0)

#define x_in (args.in[0])
#define xres ((bf16*)args.out)
constexpr int XP = pg8::XP;
#define S5PAR ((float*)(ws + WS_MISC + MS_S5PAR))
#define AGG ((float*)(ws + 476 * MiB + (size_t)L * 1048576))
#define ROUTE ((float*)(ws + WS_MISC + MS_ROUTE))
#define HIST ((int*)(ws + WS_MISC + MS_HIST))
#define TOK ((int*)(ws + WS_MISC + MS_TOK))
#define WTS ((float*)(ws + WS_MISC + MS_WTS))
#define LRUW ((bf16*)(ws + WS_MISC + MS_LRUW))
#define WIN ((bf16*)(ws + WS_W + W_IN))
#define WGLU ((bf16*)(ws + WS_W + W_GLU))
#define WBR ((bf16*)(ws + WS_W + W_BR))
#define WOUT ((bf16*)(ws + WS_W + W_OUT))
#define WFGU ((bf16*)(ws + WS_W + W_FGU))
#define WFD ((bf16*)(ws + WS_W + W_FD))
#define HB ((bf16*)(ws + WS_H))
#define Y5 ((bf16*)(ws + (L == 0 ? WS_Y5 : WS_Y5B)))
#define P6 ((bf16*)(ws + WS_P6))
#define GT ((bf16*)(ws + WS_G))
#define DACT ((bf16*)(ws + WS_DACT))
#define MWGU ((bf16*)(ws + WS_MWGU))
#define MWD ((bf16*)(ws + WS_MWD))
#define H2 ((bf16*)(ws + WS_H2))
#define HP ((bf16*)(ws + WS_HP))
#define ACT ((bf16*)(ws + WS_ACT))
#define MWGU8 ((unsigned char*)(ws + WS_MWGU))
#define MWD8 ((unsigned char*)(ws + WS_MWD))
#define H28 ((unsigned char*)(ws + WS_H2))
#define HP8 ((unsigned char*)(ws + WS_HP))
#define ACT8 ((unsigned char*)(ws + WS_ACT))
#define X2B ((bf16*)(ws + WS_H2))
#define HB8 ((unsigned char*)(ws + 478 * MiB))
#define WG8 ((unsigned char*)(ws + 550 * MiB))
#define F8_SX 4.0f
#define F8_SW1 32.0f
#define F8_SACT 8.0f
#define F8_SW2 64.0f
#define PU P6
#define PQ (P6 + (size_t)NT * W)
#define PYL (P6 + (size_t)2 * NT * W)
#define PK (P6 + (size_t)3 * NT * W)
#define PV (P6 + (size_t)4 * NT * W)
#define PXL (P6 + (size_t)5 * NT * W)
#define scr ((LAS float*)(lds + wave * 16384))
#define PREP_JOBS \
        constexpr int I_IN = 16 * (INW / 32), I_GLU = 6 * 12, I_BR = 6 * 32, I_OUT = 16 * 32, I_FG = 16 * (DFF / 32), I_FD = (DFF / 64) * 32; \
        constexpr int NITEMS = 2 * I_IN + 2 * I_GLU + 6 * I_BR + 2 * I_OUT + 2 * I_FG + I_FD, N_EARLY = I_IN + 2 * I_GLU, N_DEFER = NITEMS - N_EARLY; (void)N_DEFER; \
        auto job0 = [&](int it) -> TrJob { int r = it; \
            if (r < 2 * I_IN) { const int l = r / I_IN; return TrJob{args.in[2] + (size_t)l * D * INW, D, INW, WIN + (size_t)l * INW * D, 0, 0, r % I_IN, 0, 0, F8_SW1, 2304, WG8 + (size_t)l * 3072 * D}; } r -= 2 * I_IN; \
            if (r < 2 * I_GLU) { const int l = r / I_GLU; return TrJob{args.in[12] + (size_t)l * W * W, W, W, WGLU + (size_t)l * 512 * W, 0, 0, r % I_GLU}; } r -= 2 * I_GLU; \
            if (r < 6 * I_BR) { const int ln = r / I_BR; return TrJob{args.in[21] + (size_t)ln * W * D, W, D, WBR + (size_t)(ln / 3) * D * 3 * W, 0, 0, r % I_BR, 3 * W, (ln % 3) * W, 0.f, 0, nullptr, EMU_BIT(0)}; } r -= 6 * I_BR; \
            if (r < 2 * I_OUT) { const int l = r / I_OUT; return TrJob{args.in[22] + (size_t)l * D * D, D, D, WOUT + (size_t)l * D * D, 0, 0, r % I_OUT, 0, 0, 0.f, 0, nullptr, EMU_BIT(1)}; } r -= 2 * I_OUT; \
            if (r < I_FG) return TrJob{args.in[24], D, DFF, WFGU, 1, 0, r, 0, 0, 0.f, 0, nullptr, EMU_BIT(3)}; r -= I_FG; \
            if (r < I_FG) return TrJob{args.in[25], D, DFF, WFGU, 1, 128, r, 0, 0, 0.f, 0, nullptr, EMU_BIT(4)}; r -= I_FG; \
            return TrJob{args.in[26], DFF, D, WFD, 0, 0, r, 0, 0, 0.f, 0, nullptr, EMU_BIT(2)}; };
#ifdef MK_F8EMU
#define EMU_BIT(b) (((MK_F8EMU) >> (b)) & 1)
#else
#define EMU_BIT(b) 0
#endif
#define TR_MAP_ID(v) (v)
#define TR_MAP_EARLY(v) ((v) < I_IN ? (v) : (v) + I_IN)
#define TR_MAP_DEFER(v) ((v) < I_IN ? (v) + I_IN : (v) + I_IN + 2 * I_GLU)
#define TR_RUN(NV, START, STRIDE, MAP) { f32x4 va[8], vb[8]; TrJob ja{}, jb{}; int it = (START); \
          if (it < (NV)) { ja = job0(MAP(it)); tr_load(ja, lane, va); } \
          for (; it < (NV); it += 2 * (STRIDE)) { \
              const bool hb = it + (STRIDE) < (NV); if (hb) { jb = job0(MAP(it + (STRIDE))); tr_load(jb, lane, vb); } \
              tr_write(ja, lane, va, scr); \
              const bool ha = it + 2 * (STRIDE) < (NV); if (ha) { ja = job0(MAP(it + 2 * (STRIDE))); tr_load(ja, lane, va); } \
              if (hb) tr_write(jb, lane, vb, scr); \
          } }
#define HPK ((unsigned*)(ws + WS_HPK))
#define BR3 ((bf16*)(ws + 478 * MiB))

    if (IN(0)) { PHASE_VARS
      for (int rep_ = 0; rep_ < R_PREP; ++rep_) {
        PREP_JOBS
        TR_RUN(N_EARLY, bx * NWAVES + wave, NGW, TR_MAP_EARLY)
        for (int i = gtid; i < 2 * 128 * W / 8; i += NTH) { const int l = i / (128 * W / 8), r = i % (128 * W / 8); *(v4u*)(WGLU + (size_t)l * 512 * W + (size_t)384 * W + (size_t)r * 8) = (v4u){0u, 0u, 0u, 0u}; }
        for (int i = gtid; i < 2 * 2 * 6 * 4096; i += NTH) { const int ii = i & 63, j = (i >> 6) & 63, hd = (i >> 12) % 6, lm = (i >> 12) / 6, mat = lm & 1, l = lm >> 1;
            LRUW[i] = (bf16)f2bf((mat == 0 ? args.in[16] : args.in[18])[(size_t)((l * 6 + hd) * 64 + ii) * 64 + j]); }
        for (int i = gtid; i < 2 * NG * NP; i += NTH) {
            const int l = i / (NG * NP), gp = i % (NG * NP), g = gp / NP;
            const float lre = args.in[4][i], lim = args.in[5][i], dt = expf(args.in[6][l * NG + g]);
            const float ea = expf(lre * dt), are = ea * cosf(lim * dt), aim = ea * sinf(lim * dt), den = lre * lre + lim * lim, nr = are - 1.0f;
            const float cre = (nr * lre + aim * lim) / den, cim = (aim * lre - nr * lim) / den;
            float* o = S5PAR + (size_t)i * 34; o[0] = are; o[1] = aim;
            for (int h = 0; h < 16; ++h) { const float br = args.in[7][(size_t)i * 16 + h], bi = args.in[8][(size_t)i * 16 + h]; o[2 + h] = cre * br - cim * bi; o[18 + h] = cre * bi + cim * br; }
        }
        for (int m = gw; m < NT; m += NGW) { f32x4 v[4]; rms_row(x_in + (size_t)m * D, args.in[1], HB + (size_t)m * D, lane, v);
            unsigned* o4 = (unsigned*)(HB8 + (size_t)m * D) + lane;
#pragma unroll
            for (int j = 0; j < 4; ++j) o4[64 * j] = pg8::pk4_f8(v[j].x * F8_SX, v[j].y * F8_SX, v[j].z * F8_SX, v[j].w * F8_SX); }
      }
        SEAM(0);
    }

    { constexpr int L = 0;
        const int pb = 1 + 9 * L;
        if (IN(pb)) { PHASE_VARS
            { pg8::Gemm g8{(const bf16*)HB8, (const bf16*)(WG8 + (size_t)L * 3072 * D), NT, 3072, D / 2}; pg8::StaticOrder S8; S8.init(NT, 3072, G, bx);
              pg8::EpiInProj E8{P6, (unsigned char*)GT, args.in[3] + L * 3 * D, 1.0f / (F8_SX * F8_SW1), 0};
              pg8::gemm_phase<pg8::EpiInProj, pg8::StaticOrder, GP_ALIGN, GP_SP2, true>(lds, g8, S8, E8, tid); }
            pg8::Gemm g{HB, WIN + (size_t)L * INW * D, NT, 2304, D}; pg8::StaticOrder S; S.init(NT, 2304, G, bx);
            pg8::EpiInProj E{P6, (unsigned char*)GT, args.in[3] + L * 3 * D, 1.0f, 9};
            for (int rep_ = 0; rep_ < R_INPROJ; ++rep_) pg8::gemm_phase<pg8::EpiInProj, pg8::StaticOrder, GP_ALIGN, GP_SP2>(lds, g, S, E, tid);
            if (L == 0 && bx >= G / 2) {
                PREP_JOBS
                TR_RUN(N_DEFER, (bx - G / 2) * NWAVES + wave, (G / 2) * NWAVES, TR_MAP_DEFER)
            }
            if (L == 1 && bx >= G / 2) {
                constexpr int I_D = (DFE / 64) * 32;
                auto job0 = [&](int it) -> TrJob { const int e = it / I_D; return TrJob{args.in[31] + (size_t)e * DFE * D, DFE, D, (bf16*)(MWD8 + (size_t)e * D * DFE), 0, 0, it % I_D, 0, 0, F8_SW2}; };
                TR_RUN(NE * I_D, (bx - G / 2) * NWAVES + wave, (G / 2) * NWAVES, TR_MAP_ID)
            }
            SEAM(pb);
        }
#ifndef MK_STRIP
        if (IN(pb + 1)) { PHASE_VARS
#ifdef MIX_SIMPLE
            s5_simple(PU, Y5, S5PAR + (size_t)L * NG * NP * 34, args.in[9] + (size_t)L * NG * NH * NP, args.in[10] + (size_t)L * NG * NH * NP, args.in[11] + L * W, lds, G, tid);
            for (int it = gw; it < NB * 6 * 64; it += NGW) attn_item(it, PQ, PK, PV, BR3 + W, 3 * W, lane);
            lru_pass(1, PXL, PYL, AGG, args.in[14] + L * 4 * W, args.in[15] + L * W, args.in[16] + L * 6 * 64 * 64, args.in[17] + L * W, args.in[18] + L * 6 * 64 * 64, args.in[19] + L * W, args.in[20] + L * W, gw, NGW, lane);
#else
            LAS int* qc = (LAS int*)(lds + MT_OFF);
            if (tid < 2) qc[tid] = 0;
            __syncthreads();
            const bool s5w = gw < NB * NG;
            if (s5w) {
                __builtin_amdgcn_s_setprio(3);
                for (int rep_ = 0; rep_ < R_S5; ++rep_) s5_item(gw, PU, Y5, S5PAR + (size_t)L * NG * NP * 34, args.in[9] + (size_t)L * NG * NH * NP, args.in[10] + (size_t)L * NG * NH * NP, args.in[11] + L * W, lds + wave * 9728, lane);
                __builtin_amdgcn_s_setprio(0); }
            { const int nA = bx < G / 2 ? 22 : 26, a0 = bx < G / 2 ? 22 * bx : 22 * (G / 2) + 26 * (bx - G / 2);
              const bool attn_first = s5w || wave == 4 || (wave == 5 && bx < G / 2);
              for (;;) {
                int kind = attn_first ? 1 : 0, k = 0;
                if (lane == 0) k = __hip_atomic_fetch_add(qc + kind, 1, __ATOMIC_RELAXED, __HIP_MEMORY_SCOPE_WORKGROUP);
                k = __builtin_amdgcn_readfirstlane(k);
                if (k >= (kind ? nA : 6)) {
                    kind ^= 1; k = 0;
                    if (lane == 0) k = __hip_atomic_fetch_add(qc + kind, 1, __ATOMIC_RELAXED, __HIP_MEMORY_SCOPE_WORKGROUP);
                    k = __builtin_amdgcn_readfirstlane(k);
                    if (k >= (kind ? nA : 6)) break;
                }
                if (kind == 0) lru_item(1, bx * 6 + k, PXL, PYL, BR3, AGG, args.in[14] + L * 4 * W, args.in[15] + L * W, LRUW + (size_t)L * 2 * 6 * 4096, args.in[17] + L * W, args.in[19] + L * W, args.in[20] + L * W, lds + 20480 + wave * 4608, lane, HPK);
                else attn_item(a0 + k, PQ, PK, PV, BR3 + W, 3 * W, lane);
              } }
#endif
            SEAM(pb + 1);
        }
        if (IN(pb + 2)) { PHASE_VARS
#ifdef MIX_SIMPLE
            lru_pass(2, PXL, PYL, AGG, args.in[14] + L * 4 * W, args.in[15] + L * W, args.in[16] + L * 6 * 64 * 64, args.in[17] + L * W, args.in[18] + L * 6 * 64 * 64, args.in[19] + L * W, args.in[20] + L * W, gw, NGW, lane);
#else
            for (int it = gw; it < NB * 6 * 16; it += NGW) lru2_item(it, HPK, PYL, BR3, AGG, lane);
#endif
            __syncthreads();
            pg8::Gemm g{Y5, WGLU + (size_t)L * 512 * W, NT, 512, W}; pg8::StaticOrder S; S.init(NT, 512, G, bx);
            pg8::EpiGlu E{Y5, BR3, args.in[13] + L * W, 3 * W};
            for (int rep_ = 0; rep_ < R_GLU; ++rep_) pg8::gemm_phase<pg8::EpiGlu, pg8::StaticOrder, GP_ALIGN, GP_SP2>(lds, g, S, E, tid);
            SEAM(pb + 2);
        }
        if (IN(pb + 3)) { PHASE_VARS
            pg8::Gemm g{BR3, WBR + (size_t)L * 3 * D * W, NT, D, 3 * W}; pg8::StaticOrder S; S.init(NT, D, G, bx);
            pg8::EpiMergedF E{(const unsigned char*)GT, HB};
            for (int rep_ = 0; rep_ < R_MERGED; ++rep_) pg8::gemm_phase<pg8::EpiMergedF, pg8::StaticOrder, GP_ALIGN, GP_SP2>(lds, g, S, E, tid);
            SEAM(pb + 3);
        }
        if (IN(pb + 4)) { PHASE_VARS
            pg8::Gemm g{HB, WOUT + (size_t)L * D * D, NT, D, D}; pg8::StaticOrder S; S.init(NT, D, G, bx);
            pg8::EpiResidB<L == 0> E{x_in, xres};
            pg8::gemm_phase<pg8::EpiResidB<L == 0>, pg8::StaticOrder, GP_ALIGN, GP_SP2>(lds, g, S, E, tid);
            SEAM(pb + 4);
        }
        if (L == 0) {
            if (IN(6)) { PHASE_VARS for (int rep_ = 0; rep_ < R_NORM; ++rep_) for (int m = gw; m < NT; m += NGW) { f32x4 v[4]; rms_row_b(xres + (size_t)m * XP, args.in[23], HB + (size_t)m * D, lane, v); } SEAM(6); }
            if (IN(7)) { PHASE_VARS
                pg8::Gemm g{HB, WFGU, NT, 2 * DFF, D}; pg8::StaticOrder S; S.init(NT, 2 * DFF, G, bx);
                pg8::EpiSwiglu E{DACT, DFF, 2 * DFF / 256};
                for (int rep_ = 0; rep_ < R_FGU; ++rep_) pg8::gemm_phase<pg8::EpiSwiglu, pg8::StaticOrder, GP_ALIGN, GP_SP2>(lds, g, S, E, tid);
                SEAM(7);
            }
            if (IN(8)) { PHASE_VARS
                pg8::Gemm g{DACT, WFD, NT, D, DFF}; pg8::StaticOrder S; S.init(NT, D, G, bx);
                pg8::EpiResidB<false> E{nullptr, xres};
                pg8::gemm_phase<pg8::EpiResidB<false>, pg8::StaticOrder, GP_ALIGN, GP_SP2>(lds, g, S, E, tid);
                SEAM(8);
            }
            if (IN(9)) { PHASE_VARS for (int m = gw; m < NT; m += NGW) { f32x4 v[4]; rms_row_b(xres + (size_t)m * XP, args.in[1] + D, HB + (size_t)m * D, lane, v);
                unsigned* o4 = (unsigned*)(HB8 + (size_t)m * D) + lane;
#pragma unroll
                for (int j = 0; j < 4; ++j) o4[64 * j] = pg8::pk4_f8(v[j].x * F8_SX, v[j].y * F8_SX, v[j].z * F8_SX, v[j].w * F8_SX); } SEAM(9); }
        }
#endif
    }
    { constexpr int L = 1;
        const int pb = 1 + 9 * L;
        if (IN(pb)) { PHASE_VARS
            { pg8::Gemm g8{(const bf16*)HB8, (const bf16*)(WG8 + (size_t)L * 3072 * D), NT, 3072, D / 2}; pg8::StaticOrder S8; S8.init(NT, 3072, G, bx);
              pg8::EpiInProj E8{P6, (unsigned char*)GT, args.in[3] + L * 3 * D, 1.0f / (F8_SX * F8_SW1), 0};
              pg8::gemm_phase<pg8::EpiInProj, pg8::StaticOrder, GP_ALIGN, GP_SP2, true>(lds, g8, S8, E8, tid); }
            pg8::Gemm g{HB, WIN + (size_t)L * INW * D, NT, 2304, D}; pg8::StaticOrder S; S.init(NT, 2304, G, bx);
            pg8::EpiInProj E{P6, (unsigned char*)GT, args.in[3] + L * 3 * D, 1.0f, 9};
            for (int rep_ = 0; rep_ < R_INPROJ; ++rep_) pg8::gemm_phase<pg8::EpiInProj, pg8::StaticOrder, GP_ALIGN, GP_SP2>(lds, g, S, E, tid);
            if (L == 0 && bx >= G / 2) {
                PREP_JOBS
                TR_RUN(N_DEFER, (bx - G / 2) * NWAVES + wave, (G / 2) * NWAVES, TR_MAP_DEFER)
            }
            if (L == 1 && bx >= G / 2) {
                constexpr int I_D = (DFE / 64) * 32;
                auto job0 = [&](int it) -> TrJob { const int e = it / I_D; return TrJob{args.in[31] + (size_t)e * DFE * D, DFE, D, (bf16*)(MWD8 + (size_t)e * D * DFE), 0, 0, it % I_D, 0, 0, F8_SW2}; };
                TR_RUN(NE * I_D, (bx - G / 2) * NWAVES + wave, (G / 2) * NWAVES, TR_MAP_ID)
            }
            SEAM(pb);
        }
#ifndef MK_STRIP
        if (IN(pb + 1)) { PHASE_VARS
#ifdef MIX_SIMPLE
            s5_simple(PU, Y5, S5PAR + (size_t)L * NG * NP * 34, args.in[9] + (size_t)L * NG * NH * NP, args.in[10] + (size_t)L * NG * NH * NP, args.in[11] + L * W, lds, G, tid);
            for (int it = gw; it < NB * 6 * 64; it += NGW) attn_item(it, PQ, PK, PV, BR3 + W, 3 * W, lane);
            lru_pass(1, PXL, PYL, AGG, args.in[14] + L * 4 * W, args.in[15] + L * W, args.in[16] + L * 6 * 64 * 64, args.in[17] + L * W, args.in[18] + L * 6 * 64 * 64, args.in[19] + L * W, args.in[20] + L * W, gw, NGW, lane);
#else
            LAS int* qc = (LAS int*)(lds + MT_OFF);
            if (tid < 2) qc[tid] = 0;
            __syncthreads();
            const bool s5w = gw < NB * NG;
            if (s5w) {
                __builtin_amdgcn_s_setprio(3);
                for (int rep_ = 0; rep_ < R_S5; ++rep_) s5_item(gw, PU, Y5, S5PAR + (size_t)L * NG * NP * 34, args.in[9] + (size_t)L * NG * NH * NP, args.in[10] + (size_t)L * NG * NH * NP, args.in[11] + L * W, lds + wave * 9728, lane);
                __builtin_amdgcn_s_setprio(0); }
            { const int nA = bx < G / 2 ? 22 : 26, a0 = bx < G / 2 ? 22 * bx : 22 * (G / 2) + 26 * (bx - G / 2);
              const bool attn_first = s5w || wave == 4 || (wave == 5 && bx < G / 2);
              for (;;) {
                int kind = attn_first ? 1 : 0, k = 0;
                if (lane == 0) k = __hip_atomic_fetch_add(qc + kind, 1, __ATOMIC_RELAXED, __HIP_MEMORY_SCOPE_WORKGROUP);
                k = __builtin_amdgcn_readfirstlane(k);
                if (k >= (kind ? nA : 6)) {
                    kind ^= 1; k = 0;
                    if (lane == 0) k = __hip_atomic_fetch_add(qc + kind, 1, __ATOMIC_RELAXED, __HIP_MEMORY_SCOPE_WORKGROUP);
                    k = __builtin_amdgcn_readfirstlane(k);
                    if (k >= (kind ? nA : 6)) break;
                }
                if (kind == 0) lru_item(1, bx * 6 + k, PXL, PYL, BR3, AGG, args.in[14] + L * 4 * W, args.in[15] + L * W, LRUW + (size_t)L * 2 * 6 * 4096, args.in[17] + L * W, args.in[19] + L * W, args.in[20] + L * W, lds + 20480 + wave * 4608, lane, HPK);
                else attn_item(a0 + k, PQ, PK, PV, BR3 + W, 3 * W, lane);
              } }
#endif
            SEAM(pb + 1);
        }
        if (IN(pb + 2)) { PHASE_VARS
#ifdef MIX_SIMPLE
            lru_pass(2, PXL, PYL, AGG, args.in[14] + L * 4 * W, args.in[15] + L * W, args.in[16] + L * 6 * 64 * 64, args.in[17] + L * W, args.in[18] + L * 6 * 64 * 64, args.in[19] + L * W, args.in[20] + L * W, gw, NGW, lane);
#else
            for (int it = gw; it < NB * 6 * 16; it += NGW) lru2_item(it, HPK, PYL, BR3, AGG, lane);
#endif
            __syncthreads();
            pg8::Gemm g{Y5, WGLU + (size_t)L * 512 * W, NT, 512, W}; pg8::StaticOrder S; S.init(NT, 512, G, bx);
            pg8::EpiGlu E{Y5, BR3, args.in[13] + L * W, 3 * W};
            for (int rep_ = 0; rep_ < R_GLU; ++rep_) pg8::gemm_phase<pg8::EpiGlu, pg8::StaticOrder, GP_ALIGN, GP_SP2>(lds, g, S, E, tid);
            SEAM(pb + 2);
        }
        if (IN(pb + 3)) { PHASE_VARS
            pg8::Gemm g{BR3, WBR + (size_t)L * 3 * D * W, NT, D, 3 * W}; pg8::StaticOrder S; S.init(NT, D, G, bx);
            pg8::EpiMergedF E{(const unsigned char*)GT, HB};
            for (int rep_ = 0; rep_ < R_MERGED; ++rep_) pg8::gemm_phase<pg8::EpiMergedF, pg8::StaticOrder, GP_ALIGN, GP_SP2>(lds, g, S, E, tid);
            SEAM(pb + 3);
        }
        if (IN(pb + 4)) { PHASE_VARS
            pg8::Gemm g{HB, WOUT + (size_t)L * D * D, NT, D, D}; pg8::StaticOrder S; S.init(NT, D, G, bx);
            pg8::EpiResidB<L == 0> E{x_in, xres};
            pg8::gemm_phase<pg8::EpiResidB<L == 0>, pg8::StaticOrder, GP_ALIGN, GP_SP2>(lds, g, S, E, tid);
            SEAM(pb + 4);
        }
        if (L == 0) {
            if (IN(6)) { PHASE_VARS for (int rep_ = 0; rep_ < R_NORM; ++rep_) for (int m = gw; m < NT; m += NGW) { f32x4 v[4]; rms_row_b(xres + (size_t)m * XP, args.in[23], HB + (size_t)m * D, lane, v); } SEAM(6); }
            if (IN(7)) { PHASE_VARS
                pg8::Gemm g{HB, WFGU, NT, 2 * DFF, D}; pg8::StaticOrder S; S.init(NT, 2 * DFF, G, bx);
                pg8::EpiSwiglu E{DACT, DFF, 2 * DFF / 256};
                for (int rep_ = 0; rep_ < R_FGU; ++rep_) pg8::gemm_phase<pg8::EpiSwiglu, pg8::StaticOrder, GP_ALIGN, GP_SP2>(lds, g, S, E, tid);
                SEAM(7);
            }
            if (IN(8)) { PHASE_VARS
                pg8::Gemm g{DACT, WFD, NT, D, DFF}; pg8::StaticOrder S; S.init(NT, D, G, bx);
                pg8::EpiResidB<false> E{nullptr, xres};
                pg8::gemm_phase<pg8::EpiResidB<false>, pg8::StaticOrder, GP_ALIGN, GP_SP2>(lds, g, S, E, tid);
                SEAM(8);
            }
            if (IN(9)) { PHASE_VARS for (int m = gw; m < NT; m += NGW) { f32x4 v[4]; rms_row_b(xres + (size_t)m * XP, args.in[1] + D, HB + (size_t)m * D, lane, v);
                unsigned* o4 = (unsigned*)(HB8 + (size_t)m * D) + lane;
#pragma unroll
                for (int j = 0; j < 4; ++j) o4[64 * j] = pg8::pk4_f8(v[j].x * F8_SX, v[j].y * F8_SX, v[j].z * F8_SX, v[j].w * F8_SX); } SEAM(9); }
        }
#endif
    }
#ifndef MK_STRIP

    if (IN(15)) { PHASE_VARS
        constexpr int I_G = 16 * (DFE / 32), I_E = 2 * I_G;
        auto job15 = [&](int it) -> TrJob { const int e = it / I_E; int r = it % I_E;
            if (r < I_G) return TrJob{args.in[29] + (size_t)e * D * DFE, D, DFE, (bf16*)(MWGU8 + (size_t)e * 2 * DFE * D), 1, 0, r, 0, 0, F8_SW1}; r -= I_G;
            return TrJob{args.in[30] + (size_t)e * D * DFE, D, DFE, (bf16*)(MWGU8 + (size_t)e * 2 * DFE * D), 1, 128, r, 0, 0, F8_SW1}; };
        LAS int* LE = MT + MT_LE;
        const int tok0 = bx * 128;
        const int ex15 = args.pad;
        auto tr15 = [&]() {
#ifdef TR_NOPIPE
        for (int it = gw; it < NE * I_E; it += NGW) { const TrJob j = job15(it); tr_item(j.W, j.K, j.N, j.WT, j.kind, j.aux, (LAS float*)(lds + 32768 + wave * 8448), j.item, lane); }
#else
        { f32x4 va[8], vb[8]; TrJob ja{}, jb{}; int it = bx * NWAVES + wave;
          if (it < NE * I_E) { ja = job15(it); tr_load(ja, lane, va, ex15); }
          for (; it < NE * I_E; it += 2 * NGW) {
              const bool hb = it + NGW < NE * I_E; if (hb) { jb = job15(it + NGW); tr_load(jb, lane, vb, ex15); }
              tr_write(ja, lane, va, (LAS float*)(lds + 32768 + wave * 8448), ex15);
              const bool ha = it + 2 * NGW < NE * I_E; if (ha) { ja = job15(it + 2 * NGW); tr_load(ja, lane, va, ex15); }
              if (hb) tr_write(jb, lane, vb, (LAS float*)(lds + 32768 + wave * 8448), ex15);
          } }
#endif
        };
        LAS unsigned char* GWT = lds;
        LAS float* LGW = (LAS float*)(lds + 100352 + wave * 640);
        auto rows15 = [&]() {
            for (int k = 0; k < 16; ++k) { const int m = tok0 + wave * 16 + k;
                const float rs = rms_row_b8(xres + (size_t)m * XP, args.in[23] + D, H28 + (size_t)m * D, lane, F8_SX);
                if (lane == 0) LGW[128 + k] = rs; }
            const int l15 = lane & 15, kq = lane >> 4;
            const bf16* xa = xres + (size_t)(tok0 + wave * 16 + l15) * XP + 8 * kq;
            f32x4v acc = (f32x4v){0.f, 0.f, 0.f, 0.f};
#pragma unroll 8
            for (int ks = 0; ks < 32; ++ks) {
                const bf16x8v xf = *(const bf16x8v*)(xa + 32 * ks);
                const bf16x8v bh = *(const LAS bf16x8v*)(GWT + ((ks * 4 + kq) * 8 + (l15 & 7)) * 16), bl = *(const LAS bf16x8v*)(GWT + 16384 + ((ks * 4 + kq) * 8 + (l15 & 7)) * 16);
                acc = __builtin_amdgcn_mfma_f32_16x16x32_bf16(xf, bh, acc, 0, 0, 0); acc = __builtin_amdgcn_mfma_f32_16x16x32_bf16(xf, bl, acc, 0, 0, 0);
            }
            if (l15 < 8) {
#pragma unroll
                for (int q = 0; q < 4; ++q) LGW[(4 * kq + q) * 8 + l15] = acc[q]; }
            LDS_WAIT();
            if (lane < 16) { const int il = wave * 16 + lane, m = tok0 + il; const float rs = LGW[128 + lane];
                float lg[8];
#pragma unroll
                for (int e = 0; e < 8; ++e) lg[e] = LGW[lane * 8 + e] * rs + args.in[28][e];
                int e0 = 0; float v0 = lg[0];
#pragma unroll
                for (int e = 1; e < 8; ++e) if (lg[e] > v0) { v0 = lg[e]; e0 = e; }
                int e1 = -1; float v1 = -3.0e38f;
#pragma unroll
                for (int e = 0; e < 8; ++e) if (e != e0 && lg[e] > v1) { v1 = lg[e]; e1 = e; }
                const float w1 = 1.0f / (1.0f + expf(v0 - v1)), w0 = 1.0f - w1;
                float* ro = ROUTE + (size_t)m * 4; ro[0] = __int_as_float(e0); ro[1] = __int_as_float(e1); ro[2] = w0; ro[3] = w1; LE[il] = e0; LE[128 + il] = e1; }
            LDS_WAIT();
        };
        for (int i = tid; i < D * 8; i += NTHR) { const int c = i >> 3, e = i & 7; const float gv = args.in[23][D + c] * args.in[27][(size_t)c * 8 + e];
            const unsigned hb = f2bf(gv); const float lo = gv - __uint_as_float(hb << 16); const int pos = (((c >> 5) * 4 + ((c >> 3) & 3)) * 8 + e) * 8 + (c & 7);
            ((LAS unsigned short*)GWT)[pos] = (unsigned short)hb; ((LAS unsigned short*)(GWT + 16384))[pos] = (unsigned short)f2bf(lo); }
        __syncthreads();
        if (ex15 == 1 || ex15 == 3 || ex15 == 4) tr15(); else if (ex15 == 2) rows15(); else if (wave & 1) { rows15(); tr15(); } else { tr15(); rows15(); }
            __syncthreads();
            if (tid < 16) { const int p = tid >> 3, e = tid & 7; int cnt = 0; for (int i = 0; i < 128; ++i) cnt += (LE[p * 128 + i] == e) ? 1 : 0; HIST[(tok0 / 128) * 16 + tid] = cnt; }
        SEAM(15);
    }
    if (IN(16)) { PHASE_VARS
        moe_tables(HIST, lds, tid);
        LAS int* LE = MT + MT_LE;
        const int p = (tid >> 7) & 1, i = tid & 127; const int m = bx * 128 + i;
        int e = 0; float wv = 0.f;
        if (tid < 256) { const float* ro = ROUTE + (size_t)m * 4; e = __float_as_int(ro[p]); wv = ro[2 + p]; LE[p * 128 + i] = e; }
        __syncthreads();
        if (tid < 256) { int rank = 0; for (int k = 0; k < i; ++k) rank += (LE[p * 128 + k] == e) ? 1 : 0;
            const int slot = MT[MT_OFFS + p * 8 + e] + MT[MT_BASE + p * 8 + e] + rank;
            TOK[p * (MAXT * 256) + slot] = m; WTS[p * (MAXT * 256) + slot] = wv;
            MT[MT_LE + 256 + p * 128 + i] = p * (MAXT * 256) + slot; }
        __syncthreads();
        for (int k = 0; k < 16; ++k) { const int i2 = wave * 16 + k, sl0 = MT[MT_LE + 256 + i2], sl1 = MT[MT_LE + 384 + i2]; const v4u sv = ((const v4u*)(H28 + (size_t)(bx * 128 + i2) * D))[lane];
            ((v4u*)(HP8 + (size_t)sl0 * D))[lane] = sv; ((v4u*)(HP8 + (size_t)sl1 * D))[lane] = sv; }
        for (int j = 0; j < 16; ++j) { const int tot = MT[MT_TOT + j], pad = (tot + 255) & ~255, off = (j >> 3) * (MAXT * 256) + MT[MT_OFFS + j];
            for (int s2 = tot + gw; s2 < pad; s2 += NGW) { v4u* dst = (v4u*)(HP8 + (size_t)(off + s2) * D) + lane; dst[0] = (v4u){0u, 0u, 0u, 0u}; } }
        if (bx == 0) { for (int j = 0; j < 16; ++j) { const int tot = MT[MT_TOT + j], pad = (tot + 255) & ~255, off = MT[MT_OFFS + j]; for (int s = tot + tid; s < pad; s += NTHR) { TOK[(j >> 3) * (MAXT * 256) + off + s] = -1; WTS[(j >> 3) * (MAXT * 256) + off + s] = 0.f; } } }
        SEAM(16);
    }
    if (IN(18)) { PHASE_VARS
        if (lo == 18) moe_tables(HIST, lds, tid);
        const int nT0 = MT[MT_NT], nT1 = MT[MT_NT + 1];
        pg8::Gemm g{(const bf16*)HP8, (const bf16*)MWGU8, (nT0 + nT1) * 256, 2 * DFE, D / 2}; pg8::MoeOrder S; S.so.init((nT0 + nT1) * 256, 2 * DFE, G, bx); S.tileExp = (const LAS int*)(MT + MT_TEXP); S.nT0 = nT0; S.jump = MAXT - nT0;
        pg8::EpiSwiglu8 E{ACT8, DFE, 2 * DFE / 256, 1.0f / (F8_SX * F8_SW1), F8_SACT};
        for (int rep_ = 0; rep_ < R_MGU; ++rep_) pg8::gemm_phase<pg8::EpiSwiglu8, pg8::MoeOrder, GP_ALIGN, GP_SP2, true>(lds, g, S, E, tid);
        SEAM(18);
    }
    if (IN(19)) { PHASE_VARS
        if (lo == 19) moe_tables(HIST, lds, tid);
        const int nT0 = MT[MT_NT], nT1 = MT[MT_NT + 1];
        pg8::Gemm g{(const bf16*)ACT8, (const bf16*)MWD8, (nT0 + nT1) * 256, D, DFE / 2}; pg8::MoeOrder S; S.so.init((nT0 + nT1) * 256, D, G, bx); S.tileExp = (const LAS int*)(MT + MT_TEXP); S.nT0 = nT0; S.jump = MAXT - nT0;
        pg8::EpiMoeDown E{xres, TOK, WTS, 1.0f / (F8_SACT * F8_SW2), X2B, MAXT};
        pg8::gemm_phase<pg8::EpiMoeDown, pg8::MoeOrder, GP_ALIGN, GP_SP2, true>(lds, g, S, E, tid);
        SEAM(19);
    }
    if (IN(22)) { PHASE_VARS
        for (int m = gw; m < NT; m += NGW) {
            const v2u* xb = (const v2u*)(xres + (size_t)m * XP) + lane; f32x4* xr = (f32x4*)(args.out + (size_t)m * D) + lane; const f32x4* gr = (const f32x4*)args.in[32] + lane;
            const v2u* x2 = (const v2u*)(X2B + (size_t)m * D) + lane;
            f32x4 v[4]; float s = 0.f;
#pragma unroll
            for (int j = 0; j < 4; ++j) { const v2u r = xb[64 * j], q = x2[64 * j];
                v[j] = (f32x4){__uint_as_float(r.x << 16) + __uint_as_float(q.x << 16), __uint_as_float(r.x & 0xffff0000u) + __uint_as_float(q.x & 0xffff0000u), __uint_as_float(r.y << 16) + __uint_as_float(q.y << 16), __uint_as_float(r.y & 0xffff0000u) + __uint_as_float(q.y & 0xffff0000u)};
                s += (v[j].x * v[j].x + v[j].y * v[j].y) + (v[j].z * v[j].z + v[j].w * v[j].w); }
            const float rs = 1.0f / sqrtf(wave_sum(s) * (1.f / D) + RMS_EPS);
#pragma unroll
            for (int j = 0; j < 4; ++j) xr[64 * j] = v[j] * rs * gr[64 * j];
        }
    }
#endif
#undef IN
#undef SEAM
}

__global__ void nan_fill(float* o, int n) { for (int i = blockIdx.x * blockDim.x + threadIdx.x; i < n; i += gridDim.x * blockDim.x) o[i] = __builtin_nanf(""); }


#ifdef MK_DUMP
__global__ void dump_k(int what, const unsigned char* ws, float* out) {
    for (size_t i = (size_t)blockIdx.x * blockDim.x + threadIdx.x; i < (size_t)NT * D; i += (size_t)gridDim.x * blockDim.x) {
        const size_t t = i / D; const int c = (int)(i % D); float v = 0.f;
        if (what == 1) v = bf2f(((const bf16*)(ws + WS_H))[i]);
        else if (what == 2) { const bf16* g = (const bf16*)(ws + WS_G) + t * 3072; v = bf2f(g[c]) + bf2f(g[c + 1024]) + bf2f(g[c + 2048]); }
        else if (what == 3) { if (c < W) for (int k = 0; k < 6; ++k) v += bf2f(((const bf16*)(ws + WS_P6))[(size_t)k * NT * W + t * W + c]); }
        else if (what == 4) { if (c < W) v = bf2f(((const bf16*)(ws + WS_Y5))[t * W + c]); }
        else if (what == 5) { if (c < W) v = bf2f(((const bf16*)(ws + WS_P6))[(size_t)1 * NT * W + t * W + c]); }
        else if (what == 6) { if (c < W) v = bf2f(((const bf16*)(ws + WS_P6))[(size_t)2 * NT * W + t * W + c]); }
        else if (what == 7) { if (c < W) v = bf2f(((const bf16*)(ws + WS_P6))[(size_t)0 * NT * W + t * W + c]); }
        else if (what == 9) { const bf16* o = (const bf16*)(ws + WS_P6) + t * INW; for (int k = 0; k < 5; ++k) v += bf2f(o[c + 1024 * k]); }
        else if (what == 8) v = bf2f(((const bf16*)(ws + WS_W + W_IN))[i % ((size_t)2 * INW * D)]);
        out[i] = v;
    }
}
#endif
#ifndef MK_PER_PHASE
#define MK_PER_PHASE 1
#endif
extern "C" void kernel_launch(void* const* d_in, const int* in_sizes, int n_in, void* d_out, int out_size, void* d_ws, size_t ws_size, hipStream_t stream) {
    static int grid = 0;
    if (grid == 0) {
        int dev = 0, cus = 0;
        if (n_in != 33 || out_size != NT * D || ws_size < WS_NEED || hipGetDevice(&dev) != hipSuccess || hipDeviceGetAttribute(&cus, hipDeviceAttributeMultiprocessorCount, dev) != hipSuccess ||
            hipFuncSetAttribute((const void*)hybrid_fwd, hipFuncAttributeMaxDynamicSharedMemorySize, LDS_BYTES) != hipSuccess) { fprintf(stderr, "kernel_launch: bad configuration (n_in %d out %d ws %zu)\n", n_in, out_size, ws_size); grid = -1; }
        else grid = cus;
    }
    if (grid < 0) { nan_fill<<<256, 256, 0, stream>>>((float*)d_out, out_size); return; }
    (void)hipMemsetAsync((char*)d_ws + WS_CTL, 0, CTL_ZERO_BYTES, stream);
#ifdef MK_ZERO_G
    (void)hipMemsetAsync((char*)d_ws + WS_G, 0, (size_t)NT * 3072 * 2, stream);
#endif
    Args a{};
    for (int i = 0; i < 33; ++i) a.in[i] = (const float*)d_in[i];
    a.out = (float*)d_out; a.ws = (unsigned char*)d_ws;
#if MK_PER_PHASE
#ifdef MK_FUSE01
    a.ph_lo = 0; a.ph_hi = MK_STOP; hipLaunchKernelGGL(hybrid_fwd, dim3(grid), dim3(NTHR), LDS_BYTES, stream, a);
#else
    for (int ph = 0; ph < MK_STOP; ++ph) { a.ph_lo = ph; a.ph_hi = ph + 1; hipLaunchKernelGGL(hybrid_fwd, dim3(grid), dim3(NTHR), LDS_BYTES, stream, a); }
#endif
#ifdef MK_DUMP
    dump_k<<<2048, 256, 0, stream>>>(MK_DUMP, (const unsigned char*)d_ws, (float*)d_out);
#endif
#else
#ifdef MK_EXPMIX
    a.ph_lo = 0; a.ph_hi = 3; a.li = 1; a.pad = MK_EXPMIX; hipLaunchKernelGGL(hybrid_fwd, dim3(grid), dim3(NTHR), LDS_BYTES, stream, a); a.pad = 0;
#endif
#ifdef MK_EXP15
    a.ph_lo = 15; a.ph_hi = 16; a.li = 1; a.pad = MK_EXP15; hipLaunchKernelGGL(hybrid_fwd, dim3(grid), dim3(NTHR), LDS_BYTES, stream, a); a.pad = 0;
#endif
#ifdef MK_PROF_K
    a.ph_lo = 0; a.ph_hi = MK_PROF_K; a.li = 1; hipLaunchKernelGGL(hybrid_fwd, dim3(grid), dim3(NTHR), LDS_BYTES, stream, a);
#endif
    a.ph_lo = 0; a.ph_hi = N_PHASES; a.li = 0; hipLaunchKernelGGL(hybrid_fwd, dim3(grid), dim3(NTHR), LDS_BYTES, stream, a);
#endif
}
```

```cpp
#include <hip/hip_runtime.h>
#include <cstdio>
#include <cstdint>
#define MK_PER_PHASE 0
namespace pg8 {
#define PG8_LAS __attribute__((address_space(3)))
typedef unsigned short bf16_t;
typedef short bf16x8 __attribute__((ext_vector_type(8)));
typedef float f32x4 __attribute__((ext_vector_type(4)));
typedef unsigned u32x4 __attribute__((ext_vector_type(4)));
constexpr int BM = 256, BK = 64, HALF = 128, HTB = HALF * BK * 2  , STAGE_BYTES = 8 * HTB, NXCD = 8, WGM = 8;

__host__ __device__ __forceinline__ int lds_byte(int r, int c) { const int st = (r >> 4) * 2 + (c >> 5), rr = r & 15, cc = c & 31, ob = rr * 64 + cc * 2; return st * 1024 + (ob ^ (((ob >> 9) & 1) << 5)); }
__host__ __device__ __forceinline__ void stage_rc(int b, int& R, int& C) { const int st = b / 1024, sb = b % 1024, swz = sb ^ (((sb >> 9) & 1) << 5); R = (st >> 1) * 16 + swz / 64; C = (st & 1) * 32 + (swz % 64) / 2; }
__host__ __device__ __forceinline__ int perm32(int rho) { const int n = rho >> 4, i = rho & 15; return 8 * (i >> 2) + 4 * n + (i & 3); }

struct Unit { int pm, pn; };
struct Gemm { const bf16_t* A; const bf16_t* Bt; int M, N, K; };

struct StaticOrder {
    int nM, nN, nwg, G, c;
    __host__ __device__ void init(int M, int N, int G_, int c_) { nM = M / BM; nN = N / BM; nwg = nM * nN; G = G_; c = c_; }
    __host__ __device__ bool next(int i, Unit& u) const {
        const long L = (long)i * G + c; if (L >= nwg) return false;
        int wgid = (int)L; { const int q = nwg / NXCD, r = nwg % NXCD, xcd = wgid % NXCD, off = wgid / NXCD; wgid = (xcd < r ? xcd * (q + 1) : r * (q + 1) + (xcd - r) * q) + off; }
        const int nig = WGM * nN, gid = wgid / nig, fm = gid * WGM, gsz = (nM - fm) < WGM ? (nM - fm) : WGM;
        u.pm = fm + ((wgid % nig) % gsz); u.pn = (wgid % nig) / gsz; return true;
    }
    __device__ __forceinline__ void a_ready(const Unit&) const {}
    __device__ __forceinline__ void done(const Unit&) const {}
};

__device__ __forceinline__ unsigned cvt_pk_bf16(float lo, float hi) { unsigned r; asm volatile("v_cvt_pk_bf16_f32 %0, %1, %2" : "=v"(r) : "v"(lo), "v"(hi)); return r; }
typedef float f32x2 __attribute__((ext_vector_type(2)));
__device__ __forceinline__ f32x2 gelu_pk(f32x2 v) {
    const f32x2 av = __builtin_elementwise_abs(v), d = av * 0.2316418882f + 1.0f;
    f32x2 t; t.x = __builtin_amdgcn_rcpf(d.x); t.y = __builtin_amdgcn_rcpf(d.y);
    f32x2 q = t * 0.5307027145f + (-0.7265760135f); q = q * t + 0.7107068705f; q = q * t + (-0.142248368f); q = q * t + 0.127414796f; q = q * t;
    const f32x2 s = (v * v) * (-0.72134752044f);
    f32x2 e; e.x = __builtin_amdgcn_exp2f(s.x); e.y = __builtin_amdgcn_exp2f(s.y);
    const f32x2 m = v * (q * e), r = v - m;
    f32x2 o; o.x = v.x < 0.f ? m.x : r.x; o.y = v.y < 0.f ? m.y : r.y; return o;
}

template <int ACT  > struct EpiBf16 {
    static constexpr bool PERM = true, AFTER_DRAIN = false; static_assert(ACT == 0 || ACT == 1, "EpiBf16: ACT is 0 (none) or 1 (gelu_pk)");
    bf16_t* O; int ldc; const float* bias; int split_cols; size_t split_stride; float scale0;
    __device__ __forceinline__ void operator()(const f32x4 (&acc)[2][2][4][2], const Unit& u, int wr, int wc, int fr, int fq) const {
        const int row0 = u.pm * BM + wr * 64 + fr; int colt = u.pn * BM; bf16_t* base = O;
        float sc = 1.f; if (split_cols) { const int t = colt / split_cols; base += (size_t)t * split_stride; colt -= t * split_cols; if (t == 0) sc = scale0; }
        const int col0 = colt + wc * 32 + 8 * fq, bcol0 = u.pn * BM + wc * 32 + 8 * fq;
        f32x4 bv[2][2];
#pragma unroll
        for (int bj = 0; bj < 2; ++bj)
#pragma unroll
            for (int n = 0; n < 2; ++n) bv[bj][n] = bias ? *(const f32x4*)(bias + bcol0 + bj * HALF + 4 * n) : (f32x4){0.f, 0.f, 0.f, 0.f};
#pragma unroll
        for (int ai = 0; ai < 2; ++ai)
#pragma unroll
            for (int m = 0; m < 4; ++m) { bf16_t* rowp = base + (size_t)(row0 + ai * HALF + m * 16) * ldc + col0;
#pragma unroll
                for (int bj = 0; bj < 2; ++bj) { f32x4 v0 = acc[ai][bj][m][0] + bv[bj][0], v1 = acc[ai][bj][m][1] + bv[bj][1];
                    if (ACT == 1) { f32x2 a = gelu_pk((f32x2){v0[0], v0[1]}), b = gelu_pk((f32x2){v0[2], v0[3]}), c = gelu_pk((f32x2){v1[0], v1[1]}), d = gelu_pk((f32x2){v1[2], v1[3]});
                        v0 = (f32x4){a.x, a.y, b.x, b.y}; v1 = (f32x4){c.x, c.y, d.x, d.y}; }
                    v0 = v0 * sc; v1 = v1 * sc; u32x4 w; w.x = cvt_pk_bf16(v0[0], v0[1]); w.y = cvt_pk_bf16(v0[2], v0[3]); w.z = cvt_pk_bf16(v1[0], v1[1]); w.w = cvt_pk_bf16(v1[2], v1[3]);
                    *(u32x4*)(rowp + bj * HALF) = w; } }
    }
};
constexpr int NTOK = 32768;
__device__ __forceinline__ float sigm(float x) { return __builtin_amdgcn_rcpf(1.0f + __expf(-x)); }
__device__ __forceinline__ float bf_lo(unsigned u) { return __uint_as_float(u << 16); }
__device__ __forceinline__ float bf_hi(unsigned u) { return __uint_as_float(u & 0xffff0000u); }
typedef __bf16 bf16x2c __attribute__((ext_vector_type(2)));
__device__ __forceinline__ unsigned cvt2(float lo, float hi) { const f32x2 v = {lo, hi}; return __builtin_bit_cast(unsigned, __builtin_convertvector(v, bf16x2c)); }
__device__ __forceinline__ u32x4 pack8(const f32x4& v0, const f32x4& v1) { u32x4 w; w.x = cvt2(v0[0], v0[1]); w.y = cvt2(v0[2], v0[3]); w.z = cvt2(v1[0], v1[1]); w.w = cvt2(v1[2], v1[3]); return w; }
__device__ __forceinline__ void unpack8(const u32x4& w, f32x4& v0, f32x4& v1) { v0 = (f32x4){bf_lo(w.x), bf_hi(w.x), bf_lo(w.y), bf_hi(w.y)}; v1 = (f32x4){bf_lo(w.z), bf_hi(w.z), bf_lo(w.w), bf_hi(w.w)}; }

#ifndef MK_SIG
#define MK_SIG sigm
#endif
typedef unsigned u32x2g __attribute__((ext_vector_type(2)));
struct EpiInProj {
    static constexpr bool PERM = true, AFTER_DRAIN = false, HOOK = false; static constexpr int HOOK_T0 = -1, HOOK_T1 = -1;
    bf16_t* P6; unsigned char* G8; const float* gate_b; float rin; int gbase;
    __device__ __forceinline__ void operator()(const f32x4 (&acc)[2][2][4][2], const Unit& u, int wr, int wc, int fr, int fq) const {
        const int row0 = u.pm * BM + wr * 64 + fr;
        if (u.pn < gbase) {
#pragma unroll
            for (int bj = 0; bj < 2; ++bj) {
                const int c = u.pn * BM + bj * HALF + wc * 32 + 8 * fq;
                const int blk = c / 384, off = c - blk * 384, dblk = (0x254310 >> (4 * blk)) & 0xf;
                bf16_t* base = P6 + (size_t)dblk * ((size_t)NTOK * 384) + off;
                if (blk == 3) {
#pragma unroll
                    for (int ai = 0; ai < 2; ++ai)
#pragma unroll
                        for (int m = 0; m < 4; ++m) { const int row = row0 + ai * HALF + m * 16, bb = row >> 11, t = row & 2047;
                            bf16_t* dst = P6 + (size_t)4 * ((size_t)NTOK * 384) + ((size_t)((bb * 6 + (off >> 6)) * 64 + (off & 63))) * 2048 + t;
                            const u32x4 w = pack8(acc[ai][bj][m][0], acc[ai][bj][m][1]);
                            dst[0] = (bf16_t)(w.x & 0xffffu); dst[2048] = (bf16_t)(w.x >> 16); dst[2 * 2048] = (bf16_t)(w.y & 0xffffu); dst[3 * 2048] = (bf16_t)(w.y >> 16);
                            dst[4 * 2048] = (bf16_t)(w.z & 0xffffu); dst[5 * 2048] = (bf16_t)(w.z >> 16); dst[6 * 2048] = (bf16_t)(w.w & 0xffffu); dst[7 * 2048] = (bf16_t)(w.w >> 16); }
                } else {
#pragma unroll
                for (int ai = 0; ai < 2; ++ai)
#pragma unroll
                    for (int m = 0; m < 4; ++m) { const int row = row0 + ai * HALF + m * 16; *(u32x4*)(base + (size_t)row * 384) = pack8(acc[ai][bj][m][0], acc[ai][bj][m][1]); }
                }
            }
        } else {
#pragma unroll
            for (int bj = 0; bj < 2; ++bj) {
                const int cg = (u.pn - gbase) * BM + bj * HALF + wc * 32 + 8 * fq;
                const f32x4 b0 = *(const f32x4*)(gate_b + cg), b1 = *(const f32x4*)(gate_b + cg + 4);
                const f32x4 nb0 = b0 * -1.44269504f, nb1 = b1 * -1.44269504f; const float sl = -1.44269504f * rin;
#pragma unroll
                for (int ai = 0; ai < 2; ++ai)
#pragma unroll
                    for (int m = 0; m < 4; ++m) { const int row = row0 + ai * HALF + m * 16;
                        const f32x4 t0 = acc[ai][bj][m][0] * sl + nb0, t1 = acc[ai][bj][m][1] * sl + nb1; f32x4 e0, e1, v0, v1;
#pragma unroll
                        for (int j = 0; j < 4; ++j) { e0[j] = __builtin_amdgcn_exp2f(t0[j]); e1[j] = __builtin_amdgcn_exp2f(t1[j]); }
                        const f32x4 d0 = e0 * (1.0f / 255.0f) + (1.0f / 255.0f), d1 = e1 * (1.0f / 255.0f) + (1.0f / 255.0f);
#pragma unroll
                        for (int j = 0; j < 4; ++j) { v0[j] = fmaxf(__builtin_amdgcn_rcpf(d0[j]), 1.0f); v1[j] = fmaxf(__builtin_amdgcn_rcpf(d1[j]), 1.0f); }
                        unsigned lo = 0u, hi = 0u;
                        lo = __builtin_amdgcn_cvt_pk_u8_f32(v0[0], 0, lo); lo = __builtin_amdgcn_cvt_pk_u8_f32(v0[1], 1, lo); lo = __builtin_amdgcn_cvt_pk_u8_f32(v0[2], 2, lo); lo = __builtin_amdgcn_cvt_pk_u8_f32(v0[3], 3, lo);
                        hi = __builtin_amdgcn_cvt_pk_u8_f32(v1[0], 0, hi); hi = __builtin_amdgcn_cvt_pk_u8_f32(v1[1], 1, hi); hi = __builtin_amdgcn_cvt_pk_u8_f32(v1[2], 2, hi); hi = __builtin_amdgcn_cvt_pk_u8_f32(v1[3], 3, hi);
                        *(u32x2g*)(G8 + (size_t)row * 3072 + cg) = (u32x2g){lo, hi}; }
            }
        }
    }
};
struct EpiGlu {
    static constexpr bool PERM = true, AFTER_DRAIN = false, HOOK = false; static constexpr int HOOK_T0 = -1, HOOK_T1 = -1;
    const bf16_t* Y5; bf16_t* OUT; const float* b_glu; int ldo;
    __device__ __forceinline__ void operator()(const f32x4 (&acc)[2][2][4][2], const Unit& u, int wr, int wc, int fr, int fq) const {
        const int row0 = u.pm * BM + wr * 64 + fr;
#pragma unroll
        for (int bj = 0; bj < 2; ++bj) {
            const int c = u.pn * BM + bj * HALF + wc * 32 + 8 * fq;
            if (c < 384) {
                const f32x4 b0 = *(const f32x4*)(b_glu + c), b1 = *(const f32x4*)(b_glu + c + 4);
                u32x4 yv[8];
#pragma unroll
                for (int i = 0; i < 8; ++i) yv[i] = *(const u32x4*)(Y5 + (size_t)(row0 + (i >> 2) * HALF + (i & 3) * 16) * 384 + c);
#pragma unroll
                for (int ai = 0; ai < 2; ++ai)
#pragma unroll
                    for (int m = 0; m < 4; ++m) { const int row = row0 + ai * HALF + m * 16; f32x4 v0 = acc[ai][bj][m][0] + b0, v1 = acc[ai][bj][m][1] + b1, y0, y1;
                        unpack8(yv[ai * 4 + m], y0, y1);
#pragma unroll
                        for (int j = 0; j < 4; ++j) { v0[j] = y0[j] * sigm(v0[j]); v1[j] = y1[j] * sigm(v1[j]); }
                        *(u32x4*)(OUT + (size_t)row * ldo + c) = pack8(v0, v1); }
                asm volatile("" ::: "memory");
            }
        }
    }
};
struct EpiMerged {
    static constexpr bool PERM = true, AFTER_DRAIN = false, HOOK = false; static constexpr int HOOK_T0 = -1, HOOK_T1 = -1;
    const unsigned char* G8; bf16_t* MG;
    __device__ __forceinline__ void operator()(const f32x4 (&acc)[2][2][4][2], const Unit& u, int wr, int wc, int fr, int fq) const {
        const int n = u.pm >> 7, pm = u.pm & 127, pn = u.pn & 3;
        const int row0 = pm * BM + wr * 64 + fr;
#pragma unroll
        for (int bj = 0; bj < 2; ++bj) {
            const int c = pn * BM + bj * HALF + wc * 32 + 8 * fq;
#pragma unroll
            for (int ai = 0; ai < 2; ++ai)
#pragma unroll
                for (int m = 0; m < 4; ++m) { const int row = row0 + ai * HALF + m * 16; f32x4 g0, g1;
                    { const u32x2g gw8 = *(const u32x2g*)(G8 + (size_t)row * 3072 + n * 1024 + c); const float k = 1.0f / 255.0f;
                      g0 = (f32x4){(float)(gw8.x & 0xffu), (float)((gw8.x >> 8) & 0xffu), (float)((gw8.x >> 16) & 0xffu), (float)(gw8.x >> 24)} * k;
                      g1 = (f32x4){(float)(gw8.y & 0xffu), (float)((gw8.y >> 8) & 0xffu), (float)((gw8.y >> 16) & 0xffu), (float)(gw8.y >> 24)} * k; }
                    f32x4 v0 = g0 * acc[ai][bj][m][0], v1 = g1 * acc[ai][bj][m][1];
                    if (n > 0) { f32x4 p0, p1; unpack8(*(const u32x4*)(MG + (size_t)row * 1024 + c), p0, p1); v0 += p0; v1 += p1; }
                    *(u32x4*)(MG + (size_t)row * 1024 + c) = pack8(v0, v1); asm volatile("" ::: "memory"); }
        }
    }
};
__device__ __forceinline__ void gate8(const unsigned char* p, f32x4& g0, f32x4& g1) { const u32x2g w = *(const u32x2g*)p;
    g0 = (f32x4){(float)(w.x & 0xffu), (float)((w.x >> 8) & 0xffu), (float)((w.x >> 16) & 0xffu), (float)(w.x >> 24)};
    g1 = (f32x4){(float)(w.y & 0xffu), (float)((w.y >> 8) & 0xffu), (float)((w.y >> 16) & 0xffu), (float)(w.y >> 24)};
#pragma unroll
    for (int j = 0; j < 4; ++j) { g0[j] = fmaxf(g0[j], 1.0f); g1[j] = fmaxf(g1[j], 1.0f); } }
__device__ __forceinline__ void gate8v(const u32x2g w, f32x4& g0, f32x4& g1) {
    g0 = (f32x4){(float)(w.x & 0xffu), (float)((w.x >> 8) & 0xffu), (float)((w.x >> 16) & 0xffu), (float)(w.x >> 24)};
    g1 = (f32x4){(float)(w.y & 0xffu), (float)((w.y >> 8) & 0xffu), (float)((w.y >> 16) & 0xffu), (float)(w.y >> 24)}; }
struct EpiMergedF {
    static constexpr bool PERM = true, AFTER_DRAIN = false, HOOK = true; static constexpr int HOOK_T0 = 6, HOOK_T1 = 12;
    const unsigned char* G8; bf16_t* MG;
    __device__ __forceinline__ void hook(f32x4 (&acc)[2][2][4][2], const Unit& u, int t, int wr, int wc, int fr, int fq) const {
        const int n = t / 6 - 1, row0 = u.pm * BM + wr * 64 + fr;
        const int c = u.pn * BM + wc * 32 + 8 * fq;
        u32x2g ga[2][8], gb[2][8];
#pragma unroll
        for (int bj = 0; bj < 2; ++bj)
#pragma unroll
            for (int i = 0; i < 8; ++i) { const unsigned char* gp = G8 + (size_t)(row0 + (i >> 2) * HALF + (i & 3) * 16) * 3072 + n * 1024 + c + bj * HALF; ga[bj][i] = *(const u32x2g*)gp; gb[bj][i] = *(const u32x2g*)(gp + 1024); }
#pragma unroll
        for (int bj = 0; bj < 2; ++bj)
#pragma unroll
            for (int ai = 0; ai < 2; ++ai)
#pragma unroll
                for (int m = 0; m < 4; ++m) { f32x4 a0, a1, b0, b1;
                    gate8v(ga[bj][ai * 4 + m], a0, a1); gate8v(gb[bj][ai * 4 + m], b0, b1);
                    const f32x4 r0 = (f32x4){__builtin_amdgcn_rcpf(b0[0]), __builtin_amdgcn_rcpf(b0[1]), __builtin_amdgcn_rcpf(b0[2]), __builtin_amdgcn_rcpf(b0[3])};
                    const f32x4 r1 = (f32x4){__builtin_amdgcn_rcpf(b1[0]), __builtin_amdgcn_rcpf(b1[1]), __builtin_amdgcn_rcpf(b1[2]), __builtin_amdgcn_rcpf(b1[3])};
                    acc[ai][bj][m][0] = acc[ai][bj][m][0] * (a0 * r0); acc[ai][bj][m][1] = acc[ai][bj][m][1] * (a1 * r1); }
        asm volatile("" ::: "memory");
    }
    __device__ __forceinline__ void operator()(const f32x4 (&acc)[2][2][4][2], const Unit& u, int wr, int wc, int fr, int fq) const {
        const int row0 = u.pm * BM + wr * 64 + fr;
#pragma unroll
        for (int bj = 0; bj < 2; ++bj) {
            const int c = u.pn * BM + bj * HALF + wc * 32 + 8 * fq;
            u32x2g gv[8];
#pragma unroll
            for (int i = 0; i < 8; ++i) gv[i] = *(const u32x2g*)(G8 + (size_t)(row0 + (i >> 2) * HALF + (i & 3) * 16) * 3072 + 2048 + c);
#pragma unroll
            for (int ai = 0; ai < 2; ++ai)
#pragma unroll
                for (int m = 0; m < 4; ++m) { const int row = row0 + ai * HALF + m * 16; f32x4 g0, g1; gate8v(gv[ai * 4 + m], g0, g1);
                    const float k = 1.0f / 255.0f;
                    *(u32x4*)(MG + (size_t)row * 1024 + c) = pack8(acc[ai][bj][m][0] * (g0 * k), acc[ai][bj][m][1] * (g1 * k)); }
            asm volatile("" ::: "memory");
        }
    }
};
struct EpiResid {
    static constexpr bool PERM = false, AFTER_DRAIN = false, HOOK = false; static constexpr int HOOK_T0 = -1, HOOK_T1 = -1;
    const float* base; float* out;
    __device__ __forceinline__ void operator()(const f32x4 (&acc)[2][2][4][2], const Unit& u, int wr, int wc, int fr, int fq) const {
        const int row0 = u.pm * BM + wr * 64 + fr, col0 = u.pn * BM + wc * 32 + 4 * fq;
#pragma unroll
        for (int ai = 0; ai < 2; ++ai)
#pragma unroll
            for (int m = 0; m < 4; ++m) { const size_t off = (size_t)(row0 + ai * HALF + m * 16) * 1024 + col0;
#pragma unroll
                for (int bj = 0; bj < 2; ++bj)
#pragma unroll
                    for (int n = 0; n < 2; ++n) { const f32x4 bs = *(const f32x4*)(base + off + bj * HALF + n * 16); *(f32x4*)(out + off + bj * HALF + n * 16) = bs + acc[ai][bj][m][n]; } asm volatile("" ::: "memory"); }
    }
};
constexpr int XP = 2048;
template <bool BASE_F32> struct EpiResidB {
    static constexpr bool PERM = true, AFTER_DRAIN = false, HOOK = false; static constexpr int HOOK_T0 = -1, HOOK_T1 = -1;
    const float* basef; bf16_t* X;
    __device__ __forceinline__ void operator()(const f32x4 (&acc)[2][2][4][2], const Unit& u, int wr, int wc, int fr, int fq) const {
        const int row0 = u.pm * BM + wr * 64 + fr;
#pragma unroll
        for (int bj = 0; bj < 2; ++bj) {
            const int c = u.pn * BM + bj * HALF + wc * 32 + 8 * fq;
            if (BASE_F32) {
#pragma unroll
                for (int ai = 0; ai < 2; ++ai) { f32x4 bv[4][2];
#pragma unroll
                    for (int m = 0; m < 4; ++m) { const float* bp = basef + (size_t)(row0 + ai * HALF + m * 16) * 1024 + c; bv[m][0] = *(const f32x4*)bp; bv[m][1] = *(const f32x4*)(bp + 4); }
#pragma unroll
                    for (int m = 0; m < 4; ++m) { const int row = row0 + ai * HALF + m * 16; *(u32x4*)(X + (size_t)row * XP + c) = pack8(bv[m][0] + acc[ai][bj][m][0], bv[m][1] + acc[ai][bj][m][1]); }
                    asm volatile("" ::: "memory"); }
            } else {
                u32x4 xv[8];
#pragma unroll
                for (int i = 0; i < 8; ++i) xv[i] = *(const u32x4*)(X + (size_t)(row0 + (i >> 2) * HALF + (i & 3) * 16) * XP + c);
#pragma unroll
                for (int ai = 0; ai < 2; ++ai)
#pragma unroll
                    for (int m = 0; m < 4; ++m) { const int row = row0 + ai * HALF + m * 16; f32x4 b0, b1; unpack8(xv[ai * 4 + m], b0, b1);
                        *(u32x4*)(X + (size_t)row * XP + c) = pack8(b0 + acc[ai][bj][m][0], b1 + acc[ai][bj][m][1]); }
                asm volatile("" ::: "memory");
            }
        }
    }
};
__device__ __forceinline__ unsigned pk4_f8(float a, float b, float c, float d) {
    a = __builtin_amdgcn_fmed3f(a, -448.f, 448.f); b = __builtin_amdgcn_fmed3f(b, -448.f, 448.f); c = __builtin_amdgcn_fmed3f(c, -448.f, 448.f); d = __builtin_amdgcn_fmed3f(d, -448.f, 448.f);
    int r = __builtin_amdgcn_cvt_pk_fp8_f32(a, b, 0, false); r = __builtin_amdgcn_cvt_pk_fp8_f32(c, d, r, true); return (unsigned)r; }
template <bool BASE_F32, bool F8, bool BFO = true, int INV = 1> struct EpiResidNorm {
    static constexpr bool PERM = true, AFTER_DRAIN = false, HOOK = false; static constexpr int HOOK_T0 = -1, HOOK_T1 = -1;
    static constexpr float sc = 1.0f / (float)INV, f8s = 4.0f, eps = 1e-6f;
    const float* basef; bf16_t* X; const float* gain; bf16_t* HN; unsigned char* HN8; unsigned* xbuf; unsigned* cnt; PG8_LAS unsigned char* lm; float* RS = nullptr;
    __device__ __forceinline__ void operator()(const f32x4 (&acc_)[2][2][4][2], const Unit& u, int wr, int wc, int fr, int fq) const {
        f32x4 (&a)[2][2][4][2] = const_cast<f32x4 (&)[2][2][4][2]>(acc_);
        const int row0 = u.pm * BM + wr * 64 + fr, lane = fq * 16 + fr, wid = wr * 4 + wc;
#pragma unroll
        for (int bj = 0; bj < 2; ++bj) {
            const int c = u.pn * BM + bj * HALF + wc * 32 + 8 * fq;
            if (BASE_F32) {
#pragma unroll
                for (int ai = 0; ai < 2; ++ai)
#pragma unroll
                  for (int mh = 0; mh < 2; ++mh) { f32x4 bv[2][2];
#pragma unroll
                    for (int mm = 0; mm < 2; ++mm) { const float* bp = basef + (size_t)(row0 + ai * HALF + (2 * mh + mm) * 16) * 1024 + c; bv[mm][0] = *(const f32x4*)bp; bv[mm][1] = *(const f32x4*)(bp + 4); }
#pragma unroll
                    for (int mm = 0; mm < 2; ++mm) { const int m = 2 * mh + mm; const int row = row0 + ai * HALF + m * 16; a[ai][bj][m][0] = bv[mm][0] + sc * a[ai][bj][m][0]; a[ai][bj][m][1] = bv[mm][1] + sc * a[ai][bj][m][1];
                        *(u32x4*)(X + (size_t)row * XP + c) = pack8(a[ai][bj][m][0], a[ai][bj][m][1]); }
                    asm volatile("" ::: "memory"); }
            } else {
#pragma unroll
                for (int ai = 0; ai < 2; ++ai) { u32x4 xv[4];
#pragma unroll
                    for (int m = 0; m < 4; ++m) xv[m] = *(const u32x4*)(X + (size_t)(row0 + ai * HALF + m * 16) * XP + c);
#pragma unroll
                    for (int m = 0; m < 4; ++m) { const int row = row0 + ai * HALF + m * 16; f32x4 b0, b1; unpack8(xv[m], b0, b1);
                        a[ai][bj][m][0] = b0 + sc * a[ai][bj][m][0]; a[ai][bj][m][1] = b1 + sc * a[ai][bj][m][1];
                        *(u32x4*)(X + (size_t)row * XP + c) = pack8(a[ai][bj][m][0], a[ai][bj][m][1]); }
                    asm volatile("" ::: "memory"); }
            }
        }
        PG8_LAS float* P = (PG8_LAS float*)lm; PG8_LAS float* S = P + 1024;
#pragma unroll
        for (int ai = 0; ai < 2; ++ai)
#pragma unroll
            for (int m = 0; m < 4; ++m) { float q = 0.f;
#pragma unroll
                for (int bj = 0; bj < 2; ++bj)
#pragma unroll
                    for (int n = 0; n < 2; ++n) { const f32x4 x = a[ai][bj][m][n]; q += (x[0] * x[0] + x[1] * x[1]) + (x[2] * x[2] + x[3] * x[3]); }
                q += __shfl_xor(q, 16); q += __shfl_xor(q, 32);
                if (fq == 0) P[(ai * HALF + wr * 64 + m * 16 + fr) * 4 + wc] = q; }
        asm volatile("s_waitcnt lgkmcnt(0)" ::: "memory"); __builtin_amdgcn_s_barrier(); asm volatile("" ::: "memory");
        const int prow = wid * 32 + (lane & 31);
        if (lane < 32) { const float t = (P[prow * 4 + 0] + P[prow * 4 + 1]) + (P[prow * 4 + 2] + P[prow * 4 + 3]);
            __hip_atomic_store(xbuf + ((size_t)(u.pm * BM + prow) * 4 + (u.pn & 3)), __builtin_bit_cast(unsigned, t), __ATOMIC_RELAXED, __HIP_MEMORY_SCOPE_AGENT); }
        asm volatile("s_waitcnt vmcnt(0)" ::: "memory");
        if (lane == 0) __hip_atomic_fetch_add(cnt + 64 * u.pm, 1u, __ATOMIC_RELAXED, __HIP_MEMORY_SCOPE_AGENT);
        if (wid == 0) {
            for (unsigned sp = 0; sp < (1u << 20); ++sp) {
                if ((unsigned)__builtin_amdgcn_readfirstlane((int)__hip_atomic_load(cnt + 64 * u.pm, __ATOMIC_RELAXED, __HIP_MEMORY_SCOPE_AGENT)) >= 32u) break;
                __builtin_amdgcn_s_sleep(2); }
            __builtin_amdgcn_fence(__ATOMIC_ACQUIRE, "agent");
        }
        asm volatile("s_waitcnt vmcnt(0) lgkmcnt(0)" ::: "memory"); __builtin_amdgcn_s_barrier(); asm volatile("" ::: "memory");
        if (lane < 32) { const unsigned* sl = xbuf + (size_t)(u.pm * BM + prow) * 4; float t = 0.f;
#pragma unroll
            for (int k = 0; k < 4; ++k) t += __builtin_bit_cast(float, __hip_atomic_load(sl + k, __ATOMIC_RELAXED, __HIP_MEMORY_SCOPE_AGENT));
            const float rsv = 1.0f / sqrtf(t * (1.0f / 1024.0f) + eps); S[prow] = rsv;
            if (RS != nullptr && (u.pn & 3) == 0) RS[u.pm * BM + prow] = rsv; }
        asm volatile("s_waitcnt vmcnt(0) lgkmcnt(0)" ::: "memory"); __builtin_amdgcn_s_barrier(); asm volatile("" ::: "memory");
#pragma unroll
        for (int bj = 0; bj < 2; ++bj) {
            const int c = u.pn * BM + bj * HALF + wc * 32 + 8 * fq;
            const f32x4 g0 = *(const f32x4*)(gain + c), g1 = *(const f32x4*)(gain + c + 4);
#pragma unroll
            for (int ai = 0; ai < 2; ++ai)
#pragma unroll
                for (int m = 0; m < 4; ++m) { const int r = ai * HALF + wr * 64 + m * 16 + fr; const float rs = S[r];
                    const f32x4 v0 = a[ai][bj][m][0] * (g0 * rs), v1 = a[ai][bj][m][1] * (g1 * rs);
                    if (BFO) *(u32x4*)(HN + (size_t)(u.pm * BM + r) * 1024 + c) = pack8(v0, v1);
                    if (F8) { const f32x4 w0 = v0 * f8s, w1 = v1 * f8s; typedef unsigned u32x2e __attribute__((ext_vector_type(2)));
                        u32x2e o; o.x = pk4_f8(w0[0], w0[1], w0[2], w0[3]); o.y = pk4_f8(w1[0], w1[1], w1[2], w1[3]); *(u32x2e*)(HN8 + (size_t)(u.pm * BM + r) * 1024 + c) = o; }
                    asm volatile("" ::: "memory"); }
        }
    }
};
struct EpiSwiglu {
    static constexpr bool PERM = true, AFTER_DRAIN = false, HOOK = false; static constexpr int HOOK_T0 = -1, HOOK_T1 = -1;
    bf16_t* ACT; int ld; int nct;
    __device__ __forceinline__ void operator()(const f32x4 (&acc)[2][2][4][2], const Unit& u, int wr, int wc, int fr, int fq) const {
        const int row0 = u.pm * BM + wr * 64 + fr, c = (u.pn % nct) * HALF + wc * 32 + 8 * fq;
#pragma unroll
        for (int ai = 0; ai < 2; ++ai)
#pragma unroll
            for (int m = 0; m < 4; ++m) { const int row = row0 + ai * HALF + m * 16; f32x4 v0, v1;
                {
                    const f32x4 ag0 = acc[ai][0][m][0], ag1 = acc[ai][0][m][1];
                    const f32x4 e0 = ag0 * -1.44269504f, e1 = ag1 * -1.44269504f;
                    f32x4 s0, s1;
#pragma unroll
                    for (int j = 0; j < 4; ++j) { s0[j] = __builtin_amdgcn_rcpf(1.0f + __builtin_amdgcn_exp2f(e0[j])); s1[j] = __builtin_amdgcn_rcpf(1.0f + __builtin_amdgcn_exp2f(e1[j])); }
                    v0 = (ag0 * acc[ai][1][m][0]) * s0; v1 = (ag1 * acc[ai][1][m][1]) * s1; }
                *(u32x4*)(ACT + (size_t)row * ld + c) = pack8(v0, v1); }
    }
};
struct EpiSwiglu8 {
    static constexpr bool PERM = true, AFTER_DRAIN = false, HOOK = false; static constexpr int HOOK_T0 = -1, HOOK_T1 = -1;
    unsigned char* ACT; int ld; int nct; float rin, sout;
    __device__ __forceinline__ void operator()(const f32x4 (&acc)[2][2][4][2], const Unit& u, int wr, int wc, int fr, int fq) const {
        const int row0 = u.pm * BM + wr * 64 + fr, c = (u.pn % nct) * HALF + wc * 32 + 8 * fq;
#pragma unroll
        for (int ai = 0; ai < 2; ++ai)
#pragma unroll
            for (int m = 0; m < 4; ++m) { const int row = row0 + ai * HALF + m * 16; f32x4 v0, v1;
                {
                    const f32x4 ag0 = acc[ai][0][m][0], ag1 = acc[ai][0][m][1];
                    const f32x4 e0 = ag0 * (-1.44269504f * rin), e1 = ag1 * (-1.44269504f * rin);
                    f32x4 s0, s1;
#pragma unroll
                    for (int j = 0; j < 4; ++j) { s0[j] = __builtin_amdgcn_rcpf(1.0f + __builtin_amdgcn_exp2f(e0[j])); s1[j] = __builtin_amdgcn_rcpf(1.0f + __builtin_amdgcn_exp2f(e1[j])); }
                    v0 = (ag0 * acc[ai][1][m][0]) * (s0 * (rin * rin * sout)); v1 = (ag1 * acc[ai][1][m][1]) * (s1 * (rin * rin * sout)); }
                typedef unsigned u32x2 __attribute__((ext_vector_type(2)));
                u32x2 o; o.x = pk4_f8(v0[0], v0[1], v0[2], v0[3]); o.y = pk4_f8(v1[0], v1[1], v1[2], v1[3]);
                *(u32x2*)(ACT + (size_t)row * ld + c) = o; }
    }
};
struct EpiMoeDown {
    static constexpr bool PERM = true, AFTER_DRAIN = false, HOOK = false; static constexpr int HOOK_T0 = -1, HOOK_T1 = -1;
    bf16_t* X; const int* tok; const float* wt; float sc;
    bf16_t* X2 = nullptr; int split = 1 << 30;
    __device__ __forceinline__ void operator()(const f32x4 (&acc)[2][2][4][2], const Unit& u, int wr, int wc, int fr, int fq) const {
        const int slot0 = u.pm * BM + wr * 64 + fr, c0 = (u.pn & 3) * BM + wc * 32 + 8 * fq;
        int tk[8]; float wv[8];
#pragma unroll
        for (int i = 0; i < 8; ++i) { const int slot = slot0 + (i >> 2) * HALF + (i & 3) * 16; tk[i] = tok[slot]; wv[i] = wt[slot] * sc; }
        if (u.pm >= split) {
#pragma unroll
            for (int bj = 0; bj < 2; ++bj)
#pragma unroll
                for (int ai = 0; ai < 2; ++ai)
#pragma unroll
                    for (int m = 0; m < 4; ++m) { const int i = ai * 4 + m;
                        if (tk[i] >= 0) *(u32x4*)(X2 + (size_t)tk[i] * 1024 + c0 + bj * HALF) = pack8(wv[i] * acc[ai][bj][m][0], wv[i] * acc[ai][bj][m][1]); }
            asm volatile("" ::: "memory");
            return;
        }
#pragma unroll
        for (int bj = 0; bj < 2; ++bj) {
            u32x4 xv[8];
#pragma unroll
            for (int i = 0; i < 8; ++i) xv[i] = *(const u32x4*)(X + (size_t)(tk[i] < 0 ? 0 : tk[i]) * XP + c0 + bj * HALF);
#pragma unroll
            for (int ai = 0; ai < 2; ++ai)
#pragma unroll
                for (int m = 0; m < 4; ++m) { const int i = ai * 4 + m; f32x4 b0, b1; unpack8(xv[i], b0, b1);
                    if (tk[i] >= 0) *(u32x4*)(X + (size_t)tk[i] * XP + c0 + bj * HALF) = pack8(b0 + wv[i] * acc[ai][bj][m][0], b1 + wv[i] * acc[ai][bj][m][1]); }
            asm volatile("" ::: "memory");
        }
    }
};
struct MergedOrder {
    StaticOrder so;
    __device__ bool next(int i, Unit& u) const { Unit t; if (!so.next(i / 3, t)) return false; const int n = i % 3; u.pm = n * 128 + t.pm; u.pn = n * 4 + t.pn; return true; }
    __device__ __forceinline__ void a_ready(const Unit&) const {}
    __device__ __forceinline__ void done(const Unit&) const {}
};
struct MoeOrder {
    StaticOrder so; const PG8_LAS int* tileExp; int nT0 = 1 << 30, jump = 0;
    __device__ bool next(int i, Unit& u) const { Unit t; if (!so.next(i, t)) return false; u.pm = t.pm + (t.pm >= nT0 ? jump : 0); u.pn = tileExp[u.pm] * so.nN + t.pn; return true; }
    __device__ __forceinline__ void a_ready(const Unit&) const {}
    __device__ __forceinline__ void done(const Unit&) const {}
};
typedef int pg8_i32x4 __attribute__((ext_vector_type(4)));
typedef int pg8_i32x8 __attribute__((ext_vector_type(8)));
__device__ __forceinline__ pg8_i32x8 cat8(bf16x8 a, bf16x8 b) { const pg8_i32x4 x = __builtin_bit_cast(pg8_i32x4, a), y = __builtin_bit_cast(pg8_i32x4, b); return __builtin_shufflevector(x, y, 0, 1, 2, 3, 4, 5, 6, 7); }
template <class Epi, class Sched, bool ALIGN_EPI = false, bool SP2 = false, bool FP8 = false>
__device__ __forceinline__ void gemm_phase(PG8_LAS unsigned char* lds, const Gemm g, const Sched& S, const Epi& E, int tid_in) {
    int tid_l = tid_in; asm volatile("" : "+v"(tid_l));
    const int tid = tid_l, wid = __builtin_amdgcn_readfirstlane(tid >> 6), lane = tid & 63, wr = wid >> 2, wc = wid & 3, fr = lane & 15, fq = lane >> 4;
    int K_l = g.K; asm volatile("" : "+s"(K_l));
    const int K = K_l, nt = K / BK;
    unsigned voffA[2], voffB[2];
#pragma unroll
    for (int i = 0; i < 2; ++i) { int R, C; stage_rc(tid * 16 + i * 8192, R, C); const int Rb = Epi::PERM ? ((R & ~31) + perm32(R & 31)) : R;
        voffA[i] = (unsigned)(R * K + C) * 2u; voffB[i] = (unsigned)(Rb * K + C) * 2u; }
    const size_t kstep = (size_t)(BK * 2);
    const size_t hstep = (size_t)HALF * K * 2;
    const size_t tstep = 2 * hstep;
    const unsigned ldsw = (unsigned)wid * 1024u;
    const int aoff = lds_byte(wr * 64 + fr, fq * 8), boff = lds_byte(wc * 32 + fr, fq * 8);
#define PG8_SA(b, h) (((b) * 2 + (h)) * HTB)
#define PG8_SB(b, h) ((4 + (b) * 2 + (h)) * HTB)
#define PG8_STAGE(bufoff, gbase, voff) do { _Pragma("unroll") for (int _i = 0; _i < 2; ++_i) \
        __builtin_amdgcn_global_load_lds((const unsigned*)((const char*)(gbase) + (voff)[_i]), (PG8_LAS unsigned*)(lds + (bufoff) + ldsw + _i * 8192), 16, 0, 0); } while (0)
#define PG8_LDA(dst, b, h) do { _Pragma("unroll") for (int m = 0; m < 4; ++m) _Pragma("unroll") for (int k = 0; k < 2; ++k) dst[m][k] = *(const PG8_LAS bf16x8*)(lds + PG8_SA(b, h) + aoff + m * 2048 + k * 1024); } while (0)
#define PG8_LDB(dst, b, h) do { _Pragma("unroll") for (int n = 0; n < 2; ++n) _Pragma("unroll") for (int k = 0; k < 2; ++k) dst[n][k] = *(const PG8_LAS bf16x8*)(lds + PG8_SB(b, h) + boff + n * 2048 + k * 1024); } while (0)
#define PG8_MMA(ai, bj, At, Bt) do { __builtin_amdgcn_s_setprio(1); _Pragma("unroll") for (int m = 0; m < 4; ++m) _Pragma("unroll") for (int n = 0; n < 2; ++n) { \
        if constexpr (FP8) { const pg8_i32x8 a8_ = cat8(Bt[n][0], Bt[n][1]), b8_ = cat8(At[m][0], At[m][1]); asm volatile("v_mfma_f32_16x16x128_f8f6f4 %0, %1, %2, %0" : "+v"(acc[ai][bj][m][n]) : "v"(a8_), "v"(b8_)); } \
        else { _Pragma("unroll") for (int k = 0; k < 2; ++k) acc[ai][bj][m][n] = __builtin_amdgcn_mfma_f32_16x16x32_bf16(Bt[n][k], At[m][k], acc[ai][bj][m][n], 0, 0, 0); } } __builtin_amdgcn_s_setprio(0); } while (0)
#define PG8_WAIT_V(n) asm volatile("s_waitcnt vmcnt(" #n ")" ::: "memory")
#define PG8_WAIT_L(n) asm volatile("s_waitcnt lgkmcnt(" #n ")" ::: "memory")
#define PG8_BAR __builtin_amdgcn_s_barrier()
#define PG8_SCHED __builtin_amdgcn_sched_barrier(0)
    Unit cur, nxt; int ui = 0;
    if (!S.next(0, cur)) return;
    f32x4 acc[2][2][4][2];
#pragma unroll
    for (int a = 0; a < 2; ++a)
#pragma unroll
        for (int b = 0; b < 2; ++b)
#pragma unroll
            for (int m = 0; m < 4; ++m)
#pragma unroll
                for (int n = 0; n < 2; ++n) acc[a][b][m][n] = (f32x4){0.f, 0.f, 0.f, 0.f};
    bf16x8 At[4][2], B0[2][2], B1[2][2];
    const char* cA = (const char*)g.A + (size_t)cur.pm * tstep; const char* cB = (const char*)g.Bt + (size_t)cur.pn * tstep;
    S.a_ready(cur);
    if constexpr (SP2) {
        PG8_STAGE(PG8_SB(0, 0), cB, voffB); PG8_STAGE(PG8_SB(0, 1), cB + hstep, voffB); PG8_STAGE(PG8_SA(0, 0), cA, voffA); PG8_STAGE(PG8_SA(0, 1), cA + hstep, voffA);
        if (wr == 1) PG8_BAR;
        PG8_WAIT_V(2); PG8_BAR;
        PG8_STAGE(PG8_SB(1, 0), cB + kstep, voffB); PG8_STAGE(PG8_SA(1, 0), cA + kstep, voffA); PG8_STAGE(PG8_SB(1, 1), cB + hstep + kstep, voffB);
        PG8_WAIT_V(6); PG8_BAR;
    } else {
        PG8_STAGE(PG8_SB(0, 0), cB, voffB); PG8_STAGE(PG8_SA(0, 0), cA, voffA); PG8_STAGE(PG8_SB(0, 1), cB + hstep, voffB); PG8_STAGE(PG8_SA(0, 1), cA + hstep, voffA);
        if (wr == 1) PG8_BAR;
        PG8_WAIT_V(4); PG8_BAR;
        PG8_STAGE(PG8_SB(1, 0), cB + kstep, voffB); PG8_STAGE(PG8_SA(1, 0), cA + kstep, voffA); PG8_STAGE(PG8_SB(1, 1), cB + hstep + kstep, voffB);
        PG8_WAIT_V(6); PG8_BAR;
    }
    for (;;) {
        const bool has_next = S.next(ui + 1, nxt);
        const char* nA = has_next ? (const char*)g.A + (size_t)nxt.pm * tstep : cA; const char* nB = has_next ? (const char*)g.Bt + (size_t)nxt.pn * tstep : cB;
        for (int t = 0; t < nt; t += 2) {
            if constexpr (Epi::HOOK) { if (t == Epi::HOOK_T0 || t == Epi::HOOK_T1) {
                if constexpr (ALIGN_EPI) { if (wr == 0) PG8_BAR; }
                E.hook(acc, cur, t, wr, wc, fr, fq);
                if constexpr (ALIGN_EPI) { if (wr == 1) PG8_BAR; } } }
            const bool last = (t == nt - 2);
            const char* a1 = cA + (size_t)(t + 1) * kstep;
            const char* a2 = last ? nA : cA + (size_t)(t + 2) * kstep; const char* b2 = last ? nB : cB + (size_t)(t + 2) * kstep;
            const char* a3 = a2 + kstep; const char* b3 = b2 + kstep;
            if (last && has_next) S.a_ready(nxt);
            if constexpr (SP2) {
            PG8_LDB(B0, 0, 0); PG8_LDB(B1, 0, 1); PG8_SCHED; PG8_LDA(At, 0, 0); PG8_STAGE(PG8_SA(1, 1), a1 + hstep, voffA);
            PG8_WAIT_V(8); PG8_WAIT_L(0); PG8_BAR; PG8_MMA(0, 0, At, B0); PG8_MMA(0, 1, At, B1); PG8_BAR; PG8_SCHED;
            PG8_LDA(At, 0, 1); PG8_STAGE(PG8_SB(0, 0), b2, voffB); PG8_STAGE(PG8_SB(0, 1), b2 + hstep, voffB); PG8_STAGE(PG8_SA(0, 0), a2, voffA);
            PG8_WAIT_V(8); PG8_WAIT_L(0); PG8_BAR; PG8_MMA(1, 0, At, B0); PG8_MMA(1, 1, At, B1); PG8_BAR; PG8_SCHED;
            PG8_LDB(B0, 1, 0); PG8_LDB(B1, 1, 1); PG8_SCHED; PG8_LDA(At, 1, 0); PG8_STAGE(PG8_SA(0, 1), a2 + hstep, voffA);
            PG8_WAIT_V(8); PG8_WAIT_L(0); PG8_BAR; PG8_MMA(0, 0, At, B0); PG8_MMA(0, 1, At, B1); PG8_BAR; PG8_SCHED;
            PG8_LDA(At, 1, 1); PG8_STAGE(PG8_SB(1, 0), b3, voffB); PG8_STAGE(PG8_SB(1, 1), b3 + hstep, voffB); PG8_STAGE(PG8_SA(1, 0), a3, voffA);
            PG8_WAIT_V(8); PG8_WAIT_L(0); PG8_BAR; PG8_MMA(1, 0, At, B0); PG8_MMA(1, 1, At, B1); PG8_BAR; PG8_SCHED;
            } else {
            PG8_LDB(B0, 0, 0); PG8_SCHED; PG8_LDA(At, 0, 0); PG8_STAGE(PG8_SA(1, 1), a1 + hstep, voffA);
            PG8_WAIT_L(8); PG8_BAR; PG8_WAIT_L(0); PG8_MMA(0, 0, At, B0); PG8_BAR; PG8_SCHED;
            PG8_LDB(B1, 0, 1); PG8_STAGE(PG8_SB(0, 0), b2, voffB);
            PG8_BAR; PG8_WAIT_L(0); PG8_MMA(0, 1, At, B1); PG8_BAR;
            PG8_LDA(At, 0, 1); PG8_STAGE(PG8_SA(0, 0), a2, voffA);
            PG8_BAR; PG8_WAIT_L(0); PG8_MMA(1, 0, At, B0); PG8_BAR; PG8_SCHED;
            PG8_STAGE(PG8_SB(0, 1), b2 + hstep, voffB);
            PG8_WAIT_V(6); PG8_BAR; PG8_MMA(1, 1, At, B1); PG8_BAR;
            PG8_LDB(B0, 1, 0); PG8_SCHED; PG8_LDA(At, 1, 0); PG8_STAGE(PG8_SA(0, 1), a2 + hstep, voffA);
            PG8_WAIT_L(8); PG8_BAR; PG8_WAIT_L(0); PG8_MMA(0, 0, At, B0); PG8_BAR; PG8_SCHED;
            PG8_LDB(B1, 1, 1); PG8_STAGE(PG8_SB(1, 0), b3, voffB);
            PG8_BAR; PG8_WAIT_L(0); PG8_MMA(0, 1, At, B1); PG8_BAR;
            PG8_LDA(At, 1, 1); PG8_STAGE(PG8_SA(1, 0), a3, voffA);
            PG8_BAR; PG8_WAIT_L(0); PG8_MMA(1, 0, At, B0); PG8_BAR; PG8_SCHED;
            PG8_STAGE(PG8_SB(1, 1), b3 + hstep, voffB);
            PG8_WAIT_V(6); PG8_BAR; PG8_MMA(1, 1, At, B1); PG8_BAR;
            }
        }
        if constexpr (FP8) asm volatile("s_nop 15\n\ts_nop 15" ::: "memory");
        if constexpr (ALIGN_EPI) { if (wr == 0) PG8_BAR; }
        if constexpr (!Epi::AFTER_DRAIN) { E(acc, cur, wr, wc, fr, fq); S.done(cur); }
        if (!has_next) break;
#pragma unroll
        for (int a = 0; a < 2; ++a)
#pragma unroll
            for (int b = 0; b < 2; ++b)
#pragma unroll
                for (int m = 0; m < 4; ++m)
#pragma unroll
                    for (int n = 0; n < 2; ++n) acc[a][b][m][n] = (f32x4){0.f, 0.f, 0.f, 0.f};
        cur = nxt; cA = nA; cB = nB; ++ui;
        if constexpr (ALIGN_EPI) { if (wr == 1) PG8_BAR; }
    }
    PG8_WAIT_V(0);
    if constexpr (!ALIGN_EPI) { if (wr == 0) PG8_BAR; }
    PG8_BAR;
    if constexpr (Epi::AFTER_DRAIN) { E.fused(acc, cur, wr, wc, fr, fq, lds, wid, lane); S.done(cur); }
#undef PG8_SA
#undef PG8_SB
#undef PG8_STAGE
#undef PG8_LDA
#undef PG8_LDB
#undef PG8_MMA
#undef PG8_WAIT_V
#undef PG8_WAIT_L
#undef PG8_BAR
#undef PG8_SCHED
}
}

#define GAS __attribute__((address_space(1)))
#define LAS __attribute__((address_space(3)))
typedef unsigned short bf16;
typedef unsigned v4u __attribute__((ext_vector_type(4)));
typedef unsigned v2u __attribute__((ext_vector_type(2)));
typedef float f32x4 __attribute__((ext_vector_type(4)));
#define LDS_WAIT() asm volatile("s_waitcnt lgkmcnt(0)" ::: "memory")
#define VM_WAIT() asm volatile("s_waitcnt vmcnt(0)" ::: "memory")

constexpr int NWAVES = 8, NTHR = 512;
constexpr int D = 1024, NB = 16, T = 2048, NT = NB * T, W = 384, INW = 5376, DFF = 2816, NE = 8, DFE = 3584, NG = 24, NP = 64, NH = 16;
constexpr float RMS_EPS = 1e-6f;
constexpr int MAXT = 136;
static_assert(NT == pg8::NTOK, "token count");

constexpr size_t MiB = 1u << 20;
constexpr size_t WS_CTL = 0, CTL_ZERO_BYTES = 163840;
constexpr size_t WS_MISC = 1 * MiB;
constexpr size_t MS_S5PAR = 0, MS_AGG = 524288, MS_ROUTE = 1572864, MS_HIST = 2097152, MS_TOK = 2162688, MS_WTS = 2621440, MS_LRUW = 3145728;
constexpr size_t WS_W = 5 * MiB;
constexpr size_t W_IN = 0, W_GLU = W_IN + (size_t)2 * INW * D * 2, W_BR = W_GLU + (size_t)2 * 512 * W * 2, W_OUT = W_BR + (size_t)2 * 3 * D * W * 2,
                 W_FGU = W_OUT + (size_t)2 * D * D * 2, W_FD = W_FGU + (size_t)2 * DFF * D * 2, W_END = W_FD + (size_t)D * DFF * 2;
static_assert(W_END <= 47 * MiB, "weights region");
constexpr size_t WS_H = 52 * MiB, WS_Y5 = 116 * MiB, WS_P6 = 144 * MiB, WS_G = 288 * MiB, WS_Y5B = 384 * MiB, WS_HPK = 408 * MiB;
constexpr size_t P6_BLK = (size_t)NT * W * 2;
constexpr size_t WS_DACT = WS_P6;
constexpr size_t WS_MWGU = 5 * MiB, WS_MWD = 116 * MiB, WS_H2 = 173 * MiB, WS_HP = 237 * MiB, WS_ACT = 305 * MiB, WS_NEED = 556 * MiB;
static_assert(WS_MWGU + (size_t)NE * 2 * DFE * D <= WS_MWD && WS_MWD + (size_t)NE * D * DFE <= WS_P6 && WS_HPK + (size_t)NT * W * 4 <= 476 * MiB && WS_P6 + 6 * (size_t)NT * W * 2 <= WS_G && WS_G + (size_t)NT * 3072 <= WS_Y5B && WS_HP + (size_t)2 * MAXT * 256 * D <= WS_ACT && WS_ACT + (size_t)2 * MAXT * 256 * DFE <= WS_NEED && 478 * MiB + (size_t)NT * 3 * W * 2 <= WS_NEED, "moe / branch-buffer map");
constexpr int CW_BAR = 4096;
constexpr int RING_BYTES = 131072, MISC_OFF = RING_BYTES + 320, LDS_BYTES = 147456;
constexpr int MT_OFF = MISC_OFF + 128;
constexpr int MT_TEXP = 0, MT_NT = 2 * MAXT, MT_OFFS = MT_NT + 2, MT_BASE = MT_OFFS + 16, MT_TOT = MT_BASE + 16, MT_LE = MT_TOT + 16, MT_WORDS = MT_LE + 256 + 256;
static_assert(MT_OFF + MT_WORDS * 4 <= LDS_BYTES, "LDS map");

#define XB_TMO      128
#define XB_XCNT(j)  (256  + 64 * (j))
#define XB_XSUB(j)  (1280 + 64 * (j))
#define XB_XGEN(j)  (2304 + 64 * (j))
#define XB_TOP      3328
#define XB_TOPGEN   3392
#define XCD_BAR_WORDS 3456
#define XB_SPIN_CAP (1u << 18)
__device__ __forceinline__ unsigned xb_ld(unsigned* p)              { return __hip_atomic_load(p, __ATOMIC_RELAXED, __HIP_MEMORY_SCOPE_AGENT); }
__device__ __forceinline__ unsigned xb_add(unsigned* p, unsigned v) { return __hip_atomic_fetch_add(p, v, __ATOMIC_RELAXED, __HIP_MEMORY_SCOPE_AGENT); }
__device__ __forceinline__ unsigned xb_xcc_id() { return (unsigned)__builtin_amdgcn_s_getreg((3 << 11) | 20) & 0xFu; }
#define XB_SPIN(cond, bar) do { unsigned _sp = 0; while (cond) { __builtin_amdgcn_s_sleep(1); \
    if ((++_sp & 255u) == 0u) { if (xb_ld(&(bar)[XB_TMO])) break; if (_sp > XB_SPIN_CAP) { atomicAdd(&(bar)[XB_TMO], 1u); break; } } } } while (0)
struct XcdBarrier { unsigned* bar; unsigned x; volatile LAS unsigned* st; };
__device__ __forceinline__ XcdBarrier xcd_barrier_post(unsigned* bar, volatile LAS unsigned* st) {
    XcdBarrier b; b.bar = bar; b.x = xb_xcc_id(); b.st = st;
    if (threadIdx.x == 0) (void)xb_add(&bar[XB_XCNT(b.x)], 1u);
    return b;
}
__device__ __forceinline__ void xcd_barrier_complete(unsigned* bar, unsigned x, unsigned& nloc, unsigned& nx) {
    const unsigned G = gridDim.x * gridDim.y * gridDim.z;
    unsigned sum, cnt, mine, sp = 0u;
    for (;;) {
        sum = 0u; cnt = 0u; mine = 0u;
#pragma unroll
        for (unsigned j = 0; j < 16; ++j) { const unsigned c = xb_ld(&bar[XB_XCNT(j)]); sum += c; cnt += (c > 0u) ? 1u : 0u; mine = (j == x) ? c : mine; }
        if (sum == G) break;
        __builtin_amdgcn_s_sleep(1);
        if ((++sp & 255u) == 0u) { if (xb_ld(&bar[XB_TMO])) break; if (sp > XB_SPIN_CAP) { atomicAdd(&bar[XB_TMO], 1u); break; } }
    }
    nloc = mine > 0u ? mine : 1u; nx = cnt > 0u ? cnt : 1u;
}
__device__ __forceinline__ void xcd_barrier(const XcdBarrier& b, int w0) {
    asm volatile("s_waitcnt vmcnt(0)" ::: "memory");
    __syncthreads();
    if (w0 == 0 && __builtin_amdgcn_mbcnt_hi(~0u, __builtin_amdgcn_mbcnt_lo(~0u, 0u)) == 0u) {
        unsigned* bar = b.bar;
        __builtin_amdgcn_s_waitcnt(0);
        const unsigned nloc = b.st[0], nx = b.st[1];
        const unsigned old = xb_add(&bar[XB_XSUB(b.x)], 1u);
        const unsigned gen = old / nloc;
        if (old + 1u == (gen + 1u) * nloc) {
            __builtin_amdgcn_fence(__ATOMIC_RELEASE, "agent");
            asm volatile("s_waitcnt vmcnt(0)" ::: "memory");
            const unsigned og = xb_add(&bar[XB_TOP], 1u);
            const unsigned tg = og / nx;
            if (og + 1u == (tg + 1u) * nx) xb_add(&bar[XB_TOPGEN], 1u);
            else XB_SPIN(xb_ld(&bar[XB_TOPGEN]) == tg, bar);
            __builtin_amdgcn_fence(__ATOMIC_ACQUIRE, "agent");
            xb_add(&bar[XB_XGEN(b.x)], 1u);
            asm volatile("s_waitcnt vmcnt(0)" ::: "memory");
        } else {
            XB_SPIN(xb_ld(&bar[XB_XGEN(b.x)]) == gen, bar);
            __builtin_amdgcn_fence(__ATOMIC_ACQUIRE, "agent");
            asm volatile("s_waitcnt vmcnt(0)" ::: "memory");
        }
    }
    __syncthreads();
}

__device__ __forceinline__ void xcd_barrier_census(const XcdBarrier& b) {
    if (threadIdx.x == 0) { unsigned nloc, nx; xcd_barrier_complete(b.bar, b.x, nloc, nx); b.st[0] = nloc; b.st[1] = nx; }
    __syncthreads();
}

__device__ __forceinline__ unsigned f2bf(float f) { unsigned u = __builtin_bit_cast(unsigned, f); return (u + 0x7fffu + ((u >> 16) & 1u)) >> 16; }
__device__ __forceinline__ unsigned pk2(float lo, float hi) { return f2bf(lo) | (f2bf(hi) << 16); }
__device__ __forceinline__ float bf2f(unsigned short b) { return __uint_as_float(((unsigned)b) << 16); }
__device__ __forceinline__ float wave_sum(float v) {
#pragma unroll
    for (int o = 1; o < 64; o <<= 1) v += __shfl_xor(v, o);
    return v;
}
__device__ __forceinline__ float rdlane(float v, int l) { return __int_as_float(__builtin_amdgcn_readlane(__float_as_int(v), l)); }
__device__ __forceinline__ float sigmf(float x) { return __builtin_amdgcn_rcpf(1.0f + __expf(-x)); }
__device__ __forceinline__ float one_m_exp(float x, float ex) { const float p = -x * (1.0f + x * (0.5f + x * (0.16666667f + x * (0.041666668f + x * 0.0083333338f)))); return x > -0.25f ? p : 1.0f - ex; }
__device__ __forceinline__ float gelu_tanh(float x) { const float z = 0.7978845608028654f * (x + 0.044715f * x * x * x); return x * sigmf(2.0f * z); }
__device__ __forceinline__ float softplusf(float z) { return fmaxf(z, 0.f) + log1pf(__expf(-fabsf(z))); }

__device__ __forceinline__ void tr_item(const float* W, int K, int N, bf16* WT, int kind, int aux, LAS float* scr, int item, int lane) {
    const int nblk = N / 32, kb = item / nblk, nb = item - kb * nblk, k0 = 64 * kb, n0 = 32 * nb;
    const int drow0 = (kind == 0) ? (aux + n0) : (256 * (n0 >> 7) + aux + (n0 & 127));
#pragma unroll 8
    for (int i = 0; i < 32; ++i) { const int kk = 2 * i + (lane >> 5); scr[kk * 33 + (lane & 31)] = W[(size_t)(k0 + kk) * N + n0 + (lane & 31)]; }
    LDS_WAIT();
    const int c = lane & 7;
#pragma unroll
    for (int j = 0; j < 4; ++j) { const int n = (lane >> 3) + 8 * j; const LAS float* s = scr + (8 * c) * 33 + n;
        v4u o; o.x = pk2(s[0 * 33], s[1 * 33]); o.y = pk2(s[2 * 33], s[3 * 33]); o.z = pk2(s[4 * 33], s[5 * 33]); o.w = pk2(s[6 * 33], s[7 * 33]);
        *(GAS v4u*)(WT + (size_t)(drow0 + n) * K + k0 + 8 * c) = o; }
    LDS_WAIT();
}
struct TrJob { const float* W; int K, N; bf16* WT; int kind, aux, item; int ldk = 0, koff = 0; float f8sc = 0.f; int f8row = 0; unsigned char* WT8 = nullptr; int emu = 0; };
__device__ __forceinline__ void tr_load(const TrJob& j, int lane, f32x4 (&v)[8], int ex = 0) {
    if (ex == 4) {
#pragma unroll
        for (int i = 0; i < 8; ++i) v[i] = (f32x4){0.f, 0.f, 0.f, 0.f};
        return; }
    const int nblk = j.N / 32, kb = j.item / nblk, nb = j.item - kb * nblk, k0 = 64 * kb, n0 = 32 * nb;
#pragma unroll
    for (int i = 0; i < 8; ++i) v[i] = *(const f32x4*)(j.W + (size_t)(k0 + 8 * i + (lane >> 3)) * j.N + n0 + 4 * (lane & 7));
}
__device__ __forceinline__ void tr_write(const TrJob& j, int lane, const f32x4 (&v)[8], LAS float* scr, int ex = 0) {
    const int nblk = j.N / 32, kb = j.item / nblk, nb = j.item - kb * nblk, k0 = 64 * kb, n0 = 32 * nb;
    const int drow0 = (j.kind == 0) ? (j.aux + n0) : (256 * (n0 >> 7) + j.aux + (n0 & 127));
#pragma unroll
    for (int i = 0; i < 8; ++i) { LAS float* d = scr + (8 * i + (lane >> 3)) * 33 + 4 * (lane & 7); d[0] = v[i].x; d[1] = v[i].y; d[2] = v[i].z; d[3] = v[i].w; }
    LDS_WAIT();
    const int c = lane & 7;
    if (j.f8sc != 0.f && drow0 >= j.f8row) {
        const float sc = j.f8sc; unsigned char* w8 = j.WT8 ? j.WT8 : (unsigned char*)j.WT;
#pragma unroll
        for (int q = 0; q < 4; ++q) { const int n = (lane >> 3) + 8 * q; const LAS float* sp = scr + (8 * c) * 33 + n;
            v2u o; o.x = pg8::pk4_f8(sp[0 * 33] * sc, sp[1 * 33] * sc, sp[2 * 33] * sc, sp[3 * 33] * sc); o.y = pg8::pk4_f8(sp[4 * 33] * sc, sp[5 * 33] * sc, sp[6 * 33] * sc, sp[7 * 33] * sc);
            *(GAS v2u*)(w8 + (size_t)(drow0 + n - j.f8row) * (j.ldk ? j.ldk : j.K) + j.koff + k0 + 8 * c) = o; }
        LDS_WAIT();
        return;
    }
#ifdef MK_F8EMU
    if (j.emu) {
#pragma unroll
        for (int q = 0; q < 4; ++q) { const int n = (lane >> 3) + 8 * q; LAS float* sp = scr + (8 * c) * 33 + n;
#pragma unroll
            for (int k = 0; k < 8; k += 2) { const int pk = __builtin_amdgcn_cvt_pk_fp8_f32(sp[k * 33] * 32.f, sp[(k + 1) * 33] * 32.f, 0, false);
                typedef float f2_ __attribute__((ext_vector_type(2))); const f2_ r = __builtin_amdgcn_cvt_pk_f32_fp8(pk, false); sp[k * 33] = r.x * (1.f / 32.f); sp[(k + 1) * 33] = r.y * (1.f / 32.f); } }
    }
#endif
#pragma unroll
    for (int q = 0; q < 4; ++q) { const int n = (lane >> 3) + 8 * q; const LAS float* sp = scr + (8 * c) * 33 + n;
        v4u o; o.x = pk2(sp[0 * 33], sp[1 * 33]); o.y = pk2(sp[2 * 33], sp[3 * 33]); o.z = pk2(sp[4 * 33], sp[5 * 33]); o.w = pk2(sp[6 * 33], sp[7 * 33]);
        if (ex != 3) *(GAS v4u*)(j.WT + (size_t)(drow0 + n) * (j.ldk ? j.ldk : j.K) + j.koff + k0 + 8 * c) = o; else asm volatile("" :: "v"(o.x), "v"(o.y), "v"(o.z), "v"(o.w)); }
    LDS_WAIT();
}
__device__ __forceinline__ void rms_row(const float* xrow, const float* gain, bf16* orow, int lane, f32x4 (&v)[4]) {
    const f32x4* xr = (const f32x4*)xrow + lane; const f32x4* gr = (const f32x4*)gain + lane;
    float s = 0.f;
#pragma unroll
    for (int j = 0; j < 4; ++j) { v[j] = xr[64 * j]; s += (v[j].x * v[j].x + v[j].y * v[j].y) + (v[j].z * v[j].z + v[j].w * v[j].w); }
    const float rs = 1.0f / sqrtf(wave_sum(s) * (1.f / D) + RMS_EPS);
    unsigned long long* o8 = (unsigned long long*)orow + lane;
#pragma unroll
    for (int j = 0; j < 4; ++j) { v[j] = v[j] * rs * gr[64 * j]; o8[64 * j] = (unsigned long long)pk2(v[j].x, v[j].y) | ((unsigned long long)pk2(v[j].z, v[j].w) << 32); }
}

__device__ __forceinline__ float rms_row_b(const bf16* xrow, const float* gain, bf16* orow, int lane, f32x4 (&v)[4]) {
    const v2u* xr = (const v2u*)xrow + lane; const f32x4* gr = (const f32x4*)gain + lane;
    float s = 0.f;
#pragma unroll
    for (int j = 0; j < 4; ++j) { const v2u r = xr[64 * j]; v[j] = (f32x4){__uint_as_float(r.x << 16), __uint_as_float(r.x & 0xffff0000u), __uint_as_float(r.y << 16), __uint_as_float(r.y & 0xffff0000u)};
        s += (v[j].x * v[j].x + v[j].y * v[j].y) + (v[j].z * v[j].z + v[j].w * v[j].w); }
    const float rs = 1.0f / sqrtf(wave_sum(s) * (1.f / D) + RMS_EPS);
    unsigned long long* o8 = (unsigned long long*)orow + lane;
#pragma unroll
    for (int j = 0; j < 4; ++j) { v[j] = v[j] * rs * gr[64 * j]; o8[64 * j] = (unsigned long long)pk2(v[j].x, v[j].y) | ((unsigned long long)pk2(v[j].z, v[j].w) << 32); }
    return rs;
}

__device__ __forceinline__ void s5_simple(const bf16* U, bf16* Y5, const float* par, const float* c_re, const float* c_im, const float* dvec, LAS unsigned char* lds, int G, int tid) {
    const int lane = tid & 63, w = tid >> 6;
    LAS float* E = (LAS float*)lds;
    LAS float* CM = E + 1024;
    LAS float* SB = CM + 2048 + w * (16 * 130);
    for (int item = blockIdx.x; item < NB * NG; item += G) {
        const int b = item / NG, g = item % NG;
#pragma unroll
        for (int k = 0; k < 4; ++k) { const int idx = tid + 512 * k, pq = idx >> 4, h = idx & 15;
            CM[idx] = pq < 64 ? c_re[(g * 16 + h) * 64 + pq] : -c_im[(g * 16 + h) * 64 + pq - 64]; }
        const float* pp = par + (size_t)(g * 64 + lane) * 34;
        const float are = pp[0], aim = pp[1];
        float bre[16], bim[16];
#pragma unroll
        for (int h = 0; h < 16; ++h) { bre[h] = pp[2 + h]; bim[h] = pp[18 + h]; }
        const int t0 = 256 * w;
        const bf16* ub = U + (size_t)(b * T + t0) * W + 16 * g;
        const int lt = lane >> 4, lh = lane & 15;
        float sre = 0.f, sim = 0.f;
        for (int blk = 0; blk < 16; ++blk) {
            float uu[4];
#pragma unroll
            for (int q = 0; q < 4; ++q) uu[q] = bf2f(ub[(size_t)(blk * 16 + q * 4 + lt) * W + lh]);
#pragma unroll
            for (int tl = 0; tl < 16; ++tl) {
                float br = 0.f, bi = 0.f;
#pragma unroll
                for (int h = 0; h < 16; ++h) { const float uv = rdlane(uu[tl >> 2], (tl & 3) * 16 + h); br += bre[h] * uv; bi += bim[h] * uv; }
                const float nre = are * sre - aim * sim + br, nim = are * sim + aim * sre + bi; sre = nre; sim = nim;
            }
        }
        E[w * 128 + lane] = sre; E[w * 128 + 64 + lane] = sim;
        __syncthreads();
        float pr = are, pi = aim;
#pragma unroll
        for (int k = 0; k < 8; ++k) { const float nr = pr * pr - pi * pi, ni = 2.f * pr * pi; pr = nr; pi = ni; }
        sre = 0.f; sim = 0.f;
        for (int k = 0; k < w; ++k) { const float er = E[k * 128 + lane], ei = E[k * 128 + 64 + lane]; const float nre = pr * sre - pi * sim + er, nim = pr * sim + pi * sre + ei; sre = nre; sim = nim; }
        const int ctl = lane >> 2, chq = lane & 3;
        const f32x4 dv = *(const f32x4*)(dvec + 16 * g + 4 * chq);
        for (int blk = 0; blk < 16; ++blk) {
            float uu[4];
#pragma unroll
            for (int q = 0; q < 4; ++q) uu[q] = bf2f(ub[(size_t)(blk * 16 + q * 4 + lt) * W + lh]);
            const v2u ur = *(const v2u*)(ub + (size_t)(blk * 16 + ctl) * W + 4 * chq);
#pragma unroll
            for (int tl = 0; tl < 16; ++tl) {
                float br = 0.f, bi = 0.f;
#pragma unroll
                for (int h = 0; h < 16; ++h) { const float uv = rdlane(uu[tl >> 2], (tl & 3) * 16 + h); br += bre[h] * uv; bi += bim[h] * uv; }
                const float nre = are * sre - aim * sim + br, nim = are * sim + aim * sre + bi; sre = nre; sim = nim;
                SB[tl * 130 + lane] = sre; SB[tl * 130 + 64 + lane] = sim;
            }
            LDS_WAIT();
            f32x4 acc = (f32x4){0.f, 0.f, 0.f, 0.f};
            const LAS float* srow = SB + ctl * 130;
            for (int pq = 0; pq < 128; ++pq) { const float sv = srow[pq]; const f32x4 cv = *(const LAS f32x4*)(CM + pq * 16 + 4 * chq); acc += sv * cv; }
            LDS_WAIT();
            const float u0 = __uint_as_float(ur.x << 16), u1 = __uint_as_float(ur.x & 0xffff0000u), u2 = __uint_as_float(ur.y << 16), u3 = __uint_as_float(ur.y & 0xffff0000u);
            const float y0 = gelu_tanh(acc.x + dv.x * u0), y1 = gelu_tanh(acc.y + dv.y * u1), y2 = gelu_tanh(acc.z + dv.z * u2), y3 = gelu_tanh(acc.w + dv.w * u3);
            v2u o; o.x = pk2(y0, y1); o.y = pk2(y2, y3);
            *(v2u*)(Y5 + (size_t)(b * T + t0 + blk * 16 + ctl) * W + 16 * g + 4 * chq) = o;
        }
        __syncthreads();
    }
}

__device__ __forceinline__ void attn_simple(const bf16* Q, const bf16* Kb, const bf16* Vb, bf16* O, int gtid, int nthreads) {
    for (int idx = gtid; idx < NB * 6 * T; idx += nthreads) {
        const int t = idx % T, bh = idx / T, b = bh / 6, h = bh % 6;
        const size_t tok = (size_t)b * T + t;
        float q[64], acc[64];
        { const v4u* qp = (const v4u*)(Q + tok * W + 64 * h);
#pragma unroll
          for (int i = 0; i < 8; ++i) { const v4u r = qp[i];
              q[8 * i + 0] = 0.125f * __uint_as_float(r.x << 16); q[8 * i + 1] = 0.125f * __uint_as_float(r.x & 0xffff0000u); q[8 * i + 2] = 0.125f * __uint_as_float(r.y << 16); q[8 * i + 3] = 0.125f * __uint_as_float(r.y & 0xffff0000u);
              q[8 * i + 4] = 0.125f * __uint_as_float(r.z << 16); q[8 * i + 5] = 0.125f * __uint_as_float(r.z & 0xffff0000u); q[8 * i + 6] = 0.125f * __uint_as_float(r.w << 16); q[8 * i + 7] = 0.125f * __uint_as_float(r.w & 0xffff0000u); } }
#pragma unroll
        for (int i = 0; i < 64; ++i) acc[i] = 0.f;
        float R = 0.f;
        for (int s = t - 1; s >= 0 && R > -100.f; --s) {
            const size_t ks = ((size_t)b * T + s) * W + 64 * h;
            const v4u* kp = (const v4u*)(Kb + ks);
            float z = 0.f;
#pragma unroll
            for (int i = 0; i < 8; ++i) { const v4u r = kp[i];
                z += q[8 * i + 0] * __uint_as_float(r.x << 16) + q[8 * i + 1] * __uint_as_float(r.x & 0xffff0000u) + q[8 * i + 2] * __uint_as_float(r.y << 16) + q[8 * i + 3] * __uint_as_float(r.y & 0xffff0000u)
                   + q[8 * i + 4] * __uint_as_float(r.z << 16) + q[8 * i + 5] * __uint_as_float(r.z & 0xffff0000u) + q[8 * i + 6] * __uint_as_float(r.w << 16) + q[8 * i + 7] * __uint_as_float(r.w & 0xffff0000u); }
            const float sp = softplusf(z);
            const float wgt = __expf(z - sp + R);
            R -= sp;
            const v4u* vp = (const v4u*)(Vb + ks);
#pragma unroll
            for (int i = 0; i < 8; ++i) { const v4u r = vp[i];
                acc[8 * i + 0] += wgt * __uint_as_float(r.x << 16); acc[8 * i + 1] += wgt * __uint_as_float(r.x & 0xffff0000u); acc[8 * i + 2] += wgt * __uint_as_float(r.y << 16); acc[8 * i + 3] += wgt * __uint_as_float(r.y & 0xffff0000u);
                acc[8 * i + 4] += wgt * __uint_as_float(r.z << 16); acc[8 * i + 5] += wgt * __uint_as_float(r.z & 0xffff0000u); acc[8 * i + 6] += wgt * __uint_as_float(r.w << 16); acc[8 * i + 7] += wgt * __uint_as_float(r.w & 0xffff0000u); }
        }
        v4u* op = (v4u*)(O + tok * W + 64 * h);
#pragma unroll
        for (int i = 0; i < 8; ++i) { v4u o; o.x = pk2(acc[8 * i], acc[8 * i + 1]); o.y = pk2(acc[8 * i + 2], acc[8 * i + 3]); o.z = pk2(acc[8 * i + 4], acc[8 * i + 5]); o.w = pk2(acc[8 * i + 6], acc[8 * i + 7]); op[i] = o; }
    }
}


__device__ __forceinline__ float rms_row_b8(const bf16* xrow, const float* gain, unsigned char* orow, int lane, float sc) {
    const v2u* xr = (const v2u*)xrow + lane; const f32x4* gr = (const f32x4*)gain + lane;
    f32x4 v[4]; float s = 0.f;
#pragma unroll
    for (int j = 0; j < 4; ++j) { const v2u r = xr[64 * j]; v[j] = (f32x4){__uint_as_float(r.x << 16), __uint_as_float(r.x & 0xffff0000u), __uint_as_float(r.y << 16), __uint_as_float(r.y & 0xffff0000u)};
        s += (v[j].x * v[j].x + v[j].y * v[j].y) + (v[j].z * v[j].z + v[j].w * v[j].w); }
    const float rs = 1.0f / sqrtf(wave_sum(s) * (1.f / D) + RMS_EPS);
    unsigned* o4 = (unsigned*)orow + lane;
#pragma unroll
    for (int j = 0; j < 4; ++j) { v[j] = v[j] * (rs * sc) * gr[64 * j]; o4[64 * j] = pg8::pk4_f8(v[j].x, v[j].y, v[j].z, v[j].w); }
    return rs;
}

typedef short bf16x8v __attribute__((ext_vector_type(8)));
typedef float f32x16 __attribute__((ext_vector_type(16)));
typedef float f32x2v __attribute__((ext_vector_type(2)));
typedef __bf16 bf16x2cv __attribute__((ext_vector_type(2)));
__device__ __forceinline__ unsigned cvt2f(float lo, float hi) { const f32x2v v = {lo, hi}; return __builtin_bit_cast(unsigned, __builtin_convertvector(v, bf16x2cv)); }
__device__ __forceinline__ void attn_item(int item, const bf16* Q, const bf16* Kb, const bf16* VT, bf16* O, int ldo, int lane) {
    const int r = lane & 31, hf = lane >> 5;
    {
        const int qb = 63 - (item & 63), bh = item >> 6, b = bh / 6, h = bh % 6, q0 = qb * 32;
        const bf16* qrow = Q + (size_t)(b * T + q0 + r) * W + 64 * h + 8 * hf;
        bf16x8v qf[4];
#pragma unroll
        for (int ks = 0; ks < 4; ++ks) qf[ks] = *(const bf16x8v*)(qrow + 16 * ks);
        f32x16 o0, o1;
#pragma unroll
        for (int i = 0; i < 16; ++i) { o0[i] = 0.f; o1[i] = 0.f; }
        float R = 1.0f;
        const bf16* kbase = Kb + (size_t)(b * T) * W + 64 * h + 8 * hf;
        const bf16* vbase = VT + (size_t)(bh * 64 + r) * T + 4 * hf;
        bf16x8v kf[4], vf[2][2];
#define ATT_LOAD(KF, VF, K0) do { _Pragma("unroll") for (int ks = 0; ks < 4; ++ks) KF[ks] = *(const bf16x8v*)(kbase + (size_t)((K0) + r) * W + 16 * ks); \
            _Pragma("unroll") for (int mb = 0; mb < 2; ++mb) _Pragma("unroll") for (int s2 = 0; s2 < 2; ++s2) { const bf16* vp = vbase + (size_t)(32 * mb) * T + (K0) + 16 * s2; const v2u lo_ = *(const v2u*)vp, hi_ = *(const v2u*)(vp + 8); \
                const v4u pk_ = (v4u){lo_.x, lo_.y, hi_.x, hi_.y}; VF[mb][s2] = __builtin_bit_cast(bf16x8v, pk_); } } while (0)
        ATT_LOAD(kf, vf, q0);
        bf16x8v kf1[4], vf1[2][2];
        { const int k1 = qb > 0 ? (qb - 1) * 32 : 0; ATT_LOAD(kf1, vf1, k1); }
        for (int kt = qb; kt >= 0; --kt) {
            bf16x8v kfn[4], vfn[2][2];
            { const int kn = kt > 1 ? (kt - 2) * 32 : 0; ATT_LOAD(kfn, vfn, kn); }
            f32x16 sa;
#pragma unroll
            for (int i = 0; i < 16; ++i) sa[i] = 0.f;
#pragma unroll
            for (int ks = 0; ks < 4; ++ks) sa = __builtin_amdgcn_mfma_f32_32x32x16_bf16(kf[ks], qf[ks], sa, 0, 0, 0);
            const bool diag = (kt == qb);
            float om[16], be[16];
#pragma unroll
            for (int i = 0; i < 16; ++i) { const float e = __builtin_amdgcn_exp2f(-fabsf(sa[i]) * (0.125f * 1.44269504f)); const float rr = __builtin_amdgcn_rcpf(1.0f + e); const float er = e * rr;
                const bool pos = sa[i] >= 0.f; be[i] = pos ? rr : er; om[i] = pos ? er : rr; }
            if (diag) {
#pragma unroll
                for (int i = 0; i < 16; ++i) { const bool valid = (((i & 3) + 8 * (i >> 2) + 4 * hf) < r); be[i] = valid ? be[i] : 0.f; om[i] = valid ? om[i] : 1.0f; }
            }
            float gs[4], pg[4];
#pragma unroll
            for (int g = 0; g < 4; ++g) { gs[g] = (om[4 * g] * om[4 * g + 1]) * (om[4 * g + 2] * om[4 * g + 3]); pg[g] = __shfl_xor(gs[g], 32); }
            float sg[4], tail = 1.0f;
#pragma unroll
            for (int g = 3; g >= 0; --g) { sg[g] = hf == 0 ? tail * pg[g] : tail; tail *= gs[g] * pg[g]; }
            float w[16];
#pragma unroll
            for (int g = 0; g < 4; ++g) { const float base = R * sg[g];
                const float e2 = base * om[4 * g + 3], e1 = e2 * om[4 * g + 2], e0 = e1 * om[4 * g + 1];
                w[4 * g + 3] = be[4 * g + 3] * base; w[4 * g + 2] = be[4 * g + 2] * e2; w[4 * g + 1] = be[4 * g + 1] * e1; w[4 * g] = be[4 * g] * e0; }
            R *= tail;
            bf16x8v wf[2];
#pragma unroll
            for (int s = 0; s < 2; ++s) { const v4u pk = (v4u){cvt2f(w[8 * s], w[8 * s + 1]), cvt2f(w[8 * s + 2], w[8 * s + 3]), cvt2f(w[8 * s + 4], w[8 * s + 5]), cvt2f(w[8 * s + 6], w[8 * s + 7])}; wf[s] = __builtin_bit_cast(bf16x8v, pk); }
#pragma unroll
            for (int s = 0; s < 2; ++s) { o0 = __builtin_amdgcn_mfma_f32_32x32x16_bf16(vf[0][s], wf[s], o0, 0, 0, 0); o1 = __builtin_amdgcn_mfma_f32_32x32x16_bf16(vf[1][s], wf[s], o1, 0, 0, 0); }
            if (__all(R < 1.0e-12f)) break;
#pragma unroll
            for (int ks = 0; ks < 4; ++ks) { kf[ks] = kf1[ks]; kf1[ks] = kfn[ks]; }
#pragma unroll
            for (int mb = 0; mb < 2; ++mb) { vf[mb][0] = vf1[mb][0]; vf[mb][1] = vf1[mb][1]; vf1[mb][0] = vfn[mb][0]; vf1[mb][1] = vfn[mb][1]; }
        }
#undef ATT_LOAD
        bf16* orow = O + (size_t)(b * T + q0 + r) * ldo + 64 * h + 4 * hf;
#pragma unroll
        for (int g = 0; g < 4; ++g) { v2u a, c2; a.x = cvt2f(o0[4 * g], o0[4 * g + 1]); a.y = cvt2f(o0[4 * g + 2], o0[4 * g + 3]); c2.x = cvt2f(o1[4 * g], o1[4 * g + 1]); c2.y = cvt2f(o1[4 * g + 2], o1[4 * g + 3]);
            *(v2u*)(orow + 8 * g) = a; *(v2u*)(orow + 32 + 8 * g) = c2; }
    }
}


typedef float f32x4v __attribute__((ext_vector_type(4)));
struct Cplx { float re, im; };
__device__ __forceinline__ Cplx cmul(Cplx a, Cplx b) { return Cplx{a.re * b.re - a.im * b.im, a.re * b.im + a.im * b.re}; }
__device__ __forceinline__ Cplx cfma(Cplx a, Cplx s, Cplx c) { return Cplx{a.re * s.re - a.im * s.im + c.re, a.re * s.im + a.im * s.re + c.im}; }
__device__ __forceinline__ bf16x8v pack8f(const float* v) { const v4u pk = (v4u){cvt2f(v[0], v[1]), cvt2f(v[2], v[3]), cvt2f(v[4], v[5]), cvt2f(v[6], v[7])}; return __builtin_bit_cast(bf16x8v, pk); }
__device__ __forceinline__ void s5_scan_state(float (&re)[16], float (&im)[16], Cplx a1, Cplx a2, Cplx a3, Cplx a4, Cplx& carry, int hf) {
    Cplx e[4], pe[4];
#pragma unroll
    for (int g = 0; g < 4; ++g) {
        Cplx l = Cplx{re[4 * g], im[4 * g]};
#pragma unroll
        for (int k = 1; k < 4; ++k) { l = cfma(a1, l, Cplx{re[4 * g + k], im[4 * g + k]}); re[4 * g + k] = l.re; im[4 * g + k] = l.im; }
        e[g] = l; pe[g].re = __shfl_xor(l.re, 32); pe[g].im = __shfl_xor(l.im, 32);
    }
    Cplx S = carry, sst[4];
#pragma unroll
    for (int g = 0; g < 4; ++g) {
        const Cplx elo = hf == 0 ? e[g] : pe[g], ehi = hf == 0 ? pe[g] : e[g];
        const Cplx S1 = cfma(a4, S, elo);
        sst[g] = hf == 0 ? S : S1;
        S = cfma(a4, S1, ehi);
    }
    carry = S;
#pragma unroll
    for (int g = 0; g < 4; ++g) {
        const Cplx f0 = cmul(a1, sst[g]), f1 = cmul(a2, sst[g]), f2 = cmul(a3, sst[g]), f3 = cmul(a4, sst[g]);
        re[4 * g] += f0.re; im[4 * g] += f0.im; re[4 * g + 1] += f1.re; im[4 * g + 1] += f1.im; re[4 * g + 2] += f2.re; im[4 * g + 2] += f2.im; re[4 * g + 3] += f3.re; im[4 * g + 3] += f3.im;
    }
}
constexpr int S5_LROW = 304;
__device__ __forceinline__ void s5_item(int item, const bf16* U, bf16* Y5, const float* par, const float* c_re, const float* c_im, const float* dvec, LAS unsigned char* ldsw, int lane) {
    const int b = item / NG, g = item % NG, r = lane & 31, hf = lane >> 5, l15 = lane & 15, kq = lane >> 4;
    bf16x8v bB[4], cB[4], dB;
    Cplx aA1, aB1;
    { const float* pa = par + (size_t)(g * 64 + r) * 34; const float* pb = par + (size_t)(g * 64 + 32 + r) * 34;
      aA1 = Cplx{pa[0], pa[1]}; aB1 = Cplx{pb[0], pb[1]};
      float t8[8];
#pragma unroll
      for (int j = 0; j < 8; ++j) t8[j] = pa[2 + 8 * hf + j]; bB[0] = pack8f(t8);
#pragma unroll
      for (int j = 0; j < 8; ++j) t8[j] = pb[2 + 8 * hf + j]; bB[1] = pack8f(t8);
#pragma unroll
      for (int j = 0; j < 8; ++j) t8[j] = pa[18 + 8 * hf + j]; bB[2] = pack8f(t8);
#pragma unroll
      for (int j = 0; j < 8; ++j) t8[j] = pb[18 + 8 * hf + j]; bB[3] = pack8f(t8); }
    {
        const float* cr = c_re + (size_t)(g * 16 + l15) * 64; const float* ci = c_im + (size_t)(g * 16 + l15) * 64;
#pragma unroll
        for (int ks = 0; ks < 4; ++ks) { float t8[8];
#pragma unroll
            for (int j = 0; j < 8; ++j) { const int kk = 32 * ks + 8 * kq + j, rr = kk >> 2, c = kk & 3; t8[j] = c == 0 ? cr[rr] : c == 1 ? cr[32 + rr] : c == 2 ? -ci[rr] : -ci[32 + rr]; }
            cB[ks] = pack8f(t8); }
        const float dh = dvec[16 * g + l15]; float t8[8];
#pragma unroll
        for (int j = 0; j < 8; ++j) t8[j] = (8 * kq + j == l15) ? dh : 0.f;
        dB = pack8f(t8);
    }
    const Cplx aA2 = cmul(aA1, aA1), aA3 = cmul(aA2, aA1), aA4 = cmul(aA2, aA2), aB2 = cmul(aB1, aB1), aB3 = cmul(aB2, aB1), aB4 = cmul(aB2, aB2);
    Cplx cyA = Cplx{0.f, 0.f}, cyB = Cplx{0.f, 0.f};
    const GAS bf16* ua = (const GAS bf16*)(U + (size_t)(b * T + r) * W + 16 * g + 8 * hf);
    GAS bf16* yo = (GAS bf16*)(Y5 + (size_t)(b * T + 4 * kq) * W + 16 * g + l15);
    bf16x8v rA[4];
#pragma unroll
    for (int j = 0; j < 3; ++j) rA[j] = *(const GAS bf16x8v*)(ua + (size_t)(32 * j) * W);
    for (int c4 = 0; c4 < T / 32; c4 += 4) {
#pragma unroll
      for (int jj = 0; jj < 4; ++jj) {
        const int c = c4 + jj, t0 = 32 * c;
        { const int cn = c + 3 < T / 32 ? c + 3 : T / 32 - 1; const int sl = (jj + 3) & 3;
          rA[sl] = *(const GAS bf16x8v*)(ua + (size_t)(32 * cn) * W); }
        const bf16x8v uA = rA[jj];
        *(LAS bf16x8v*)(ldsw + r * S5_LROW + 256 + 16 * hf) = uA;
        f32x16 z16;
#pragma unroll
        for (int i = 0; i < 16; ++i) z16[i] = 0.f;
        f32x16 b0 = __builtin_amdgcn_mfma_f32_32x32x16_bf16(uA, bB[0], z16, 0, 0, 0), b1 = __builtin_amdgcn_mfma_f32_32x32x16_bf16(uA, bB[1], z16, 0, 0, 0);
        f32x16 b2 = __builtin_amdgcn_mfma_f32_32x32x16_bf16(uA, bB[2], z16, 0, 0, 0), b3 = __builtin_amdgcn_mfma_f32_32x32x16_bf16(uA, bB[3], z16, 0, 0, 0);
        float reA[16], imA[16], reB[16], imB[16];
#pragma unroll
        for (int i = 0; i < 16; ++i) { reA[i] = b0[i]; reB[i] = b1[i]; imA[i] = b2[i]; imB[i] = b3[i]; }
        s5_scan_state(reA, imA, aA1, aA2, aA3, aA4, cyA, hf);
        s5_scan_state(reB, imB, aB1, aB2, aB3, aB4, cyB, hf);
#pragma unroll
        for (int i = 0; i < 16; ++i) { const int tl = (i & 3) + 8 * (i >> 2) + 4 * hf; v2u o; o.x = cvt2f(reA[i], reB[i]); o.y = cvt2f(imA[i], imB[i]); *(LAS v2u*)(ldsw + tl * S5_LROW + 8 * r) = o; }
        LDS_WAIT();
#pragma unroll
        for (int tb = 0; tb < 2; ++tb) {
            f32x4v acc = (f32x4v){0.f, 0.f, 0.f, 0.f};
#pragma unroll
            for (int ks = 0; ks < 4; ++ks) { const bf16x8v aS = *(const LAS bf16x8v*)(ldsw + (16 * tb + l15) * S5_LROW + (32 * ks + 8 * kq) * 2); acc = __builtin_amdgcn_mfma_f32_16x16x32_bf16(aS, cB[ks], acc, 0, 0, 0); }
            { bf16x8v uD = *(const LAS bf16x8v*)(ldsw + (16 * tb + l15) * S5_LROW + 256 + 16 * (kq & 1)); if (kq >= 2) uD = (bf16x8v){0, 0, 0, 0, 0, 0, 0, 0}; acc = __builtin_amdgcn_mfma_f32_16x16x32_bf16(uD, dB, acc, 0, 0, 0); }
#pragma unroll
            for (int q = 0; q < 4; ++q) yo[(size_t)(t0 + 16 * tb + q) * W] = (bf16)(cvt2f(gelu_tanh(acc[q]), 0.f) & 0xffffu);
        }
        LDS_WAIT();
      }
    }
}

constexpr int LRU_LROW = 144;
__device__ __forceinline__ void lru_item(int pass, int item, const bf16* XL, const bf16* YL, bf16* OB, float* AGG, const float* conv_w, const float* conv_b, const bf16* wT, const float* b_a, const float* b_x,
                                         const float* lam, LAS unsigned char* ldsw, int lane, unsigned* HPK = nullptr) {
    const int c = item & 15, bh = item >> 4, b = bh / 6, hd = bh % 6, ch = 64 * hd + lane, r = lane & 31, hf = lane >> 5;
    const bf16* wTl = wT + (size_t)(hd * 64 + r) * 64 + 8 * hf;
    const float cw0 = conv_w[0 * W + ch], cw1 = conv_w[1 * W + ch], cw2 = conv_w[2 * W + ch], cw3 = conv_w[3 * W + ch], cb = conv_b[ch];
    const float lm = lam[ch];
    const float ls8 = 8.0f * (fminf(lm, 0.f) - log1pf(__expf(-fabsf(lm))));
    const int t0 = 128 * c;
    const bf16* xb = XL + (size_t)(b * T) * W + ch;
    const bf16* yb = YL + (size_t)(b * T) * W + ch;
    bf16* ob = OB + (size_t)(b * T) * (3 * W) + 2 * W + ch;
    float xm3 = t0 >= 3 ? bf2f(xb[(size_t)(t0 - 3) * W]) : 0.f, xm2 = t0 >= 2 ? bf2f(xb[(size_t)(t0 - 2) * W]) : 0.f, xm1 = t0 >= 1 ? bf2f(xb[(size_t)(t0 - 1) * W]) : 0.f;
    float hst = 0.f, sumlog = 0.f, prod = 1.0f;
    unsigned* hpk = HPK + (size_t)(b * T) * W + ch;
    if (pass == 2) { const float* ag = AGG + (size_t)(bh * 16) * 128 + lane;
        for (int k = 0; k < c; ++k) hst = ag[k * 128] * hst + ag[k * 128 + 64]; }
    typedef unsigned short us2 __attribute__((ext_vector_type(2)));
    us2 xnx[16];
#pragma unroll
    for (int k = 0; k < 16; ++k) { xnx[k].x = xb[(size_t)(t0 + 2 * k) * W]; xnx[k].y = xb[(size_t)(t0 + 2 * k + 1) * W]; }
    for (int blk = 0; blk < 4; ++blk) {
        const int tb0 = t0 + 32 * blk;
        float xc[32];
#pragma unroll
        for (int k = 0; k < 16; ++k) { xc[2 * k] = bf2f(xnx[k].x); xc[2 * k + 1] = bf2f(xnx[k].y); }
        { const int tn = blk < 3 ? tb0 + 32 : tb0;
#pragma unroll
          for (int k = 0; k < 16; ++k) { xnx[k].x = xb[(size_t)(tn + 2 * k) * W]; xnx[k].y = xb[(size_t)(tn + 2 * k + 1) * W]; } }
        us2 yv2[16];
        if (pass == 2) {
#pragma unroll
            for (int k = 0; k < 16; ++k) { yv2[k].x = yb[(size_t)(tb0 + 2 * k) * W]; yv2[k].y = yb[(size_t)(tb0 + 2 * k + 1) * W]; }
        }
#pragma unroll
        for (int k = 0; k < 32; ++k) { const float xv = xc[k]; xc[k] = cw0 * xm3 + cw1 * xm2 + cw2 * xm1 + cw3 * xv + cb; xm3 = xm2; xm2 = xm1; xm1 = xv; }
#pragma unroll
        for (int k = 0; k < 32; k += 2) { const unsigned pk = cvt2f(xc[k], xc[k + 1]); *(LAS unsigned short*)(ldsw + k * LRU_LROW + 2 * lane) = (unsigned short)(pk & 0xffffu); *(LAS unsigned short*)(ldsw + (k + 1) * LRU_LROW + 2 * lane) = (unsigned short)(pk >> 16); }
        LDS_WAIT();
        bf16x8v aX[4];
#pragma unroll
        for (int ks = 0; ks < 4; ++ks) aX[ks] = *(const LAS bf16x8v*)(ldsw + r * LRU_LROW + (16 * ks + 8 * hf) * 2);
        LDS_WAIT();
        float lo[2][16], hi[2][16];
#pragma unroll
        for (int mat = 0; mat < 2; ++mat) {
            f32x16 d0, d1;
#pragma unroll
            for (int i = 0; i < 16; ++i) { d0[i] = 0.f; d1[i] = 0.f; }
#pragma unroll
            for (int ks = 0; ks < 4; ++ks) { const bf16x8v w0 = *(const bf16x8v*)(wTl + (size_t)mat * 6 * 4096 + 16 * ks), w1 = *(const bf16x8v*)(wTl + (size_t)mat * 6 * 4096 + 32 * 64 + 16 * ks);
                d0 = __builtin_amdgcn_mfma_f32_32x32x16_bf16(aX[ks], w0, d0, 0, 0, 0); d1 = __builtin_amdgcn_mfma_f32_32x32x16_bf16(aX[ks], w1, d1, 0, 0, 0); }
            const float bz0 = (mat == 0 ? b_a : b_x)[64 * hd + r], bz1 = (mat == 0 ? b_a : b_x)[64 * hd + 32 + r];
#pragma unroll
            for (int i = 0; i < 16; ++i) { const float x0 = d0[i] + bz0, x1 = d1[i] + bz1;
                const auto rr = __builtin_amdgcn_permlane32_swap(__float_as_uint(x0), __float_as_uint(x1), false, false); lo[mat][i] = __uint_as_float(rr[0]); hi[mat][i] = __uint_as_float(rr[1]); }
            asm volatile("s_nop 7\n\ts_nop 7" : "+v"(lo[mat][0]), "+v"(lo[mat][1]), "+v"(lo[mat][2]), "+v"(lo[mat][3]), "+v"(lo[mat][4]), "+v"(lo[mat][5]), "+v"(lo[mat][6]), "+v"(lo[mat][7]), "+v"(lo[mat][8]), "+v"(lo[mat][9]), "+v"(lo[mat][10]), "+v"(lo[mat][11]), "+v"(lo[mat][12]), "+v"(lo[mat][13]), "+v"(lo[mat][14]), "+v"(lo[mat][15]));
            asm volatile("" : "+v"(hi[mat][0]), "+v"(hi[mat][1]), "+v"(hi[mat][2]), "+v"(hi[mat][3]), "+v"(hi[mat][4]), "+v"(hi[mat][5]), "+v"(hi[mat][6]), "+v"(hi[mat][7]), "+v"(hi[mat][8]), "+v"(hi[mat][9]), "+v"(hi[mat][10]), "+v"(hi[mat][11]), "+v"(hi[mat][12]), "+v"(hi[mat][13]), "+v"(hi[mat][14]), "+v"(hi[mat][15]));
        }
#pragma unroll
        for (int k8 = 0; k8 < 32; k8 += 8) {
#pragma unroll
            for (int kk = 0; kk < 8; ++kk) {
                const int k = k8 + kk;
                const int i = 4 * (k >> 3) + (k & 3); const bool up = ((k >> 2) & 1) != 0;
                const float ra = (up ? hi[0][i] : lo[0][i]), ri = (up ? hi[1][i] : lo[1][i]);
                const float rg = sigmf(ra), ig = sigmf(ri), log_a = ls8 * rg, a = __expf(log_a);
                const float bb = __builtin_amdgcn_sqrtf(fmaxf(one_m_exp(2.0f * log_a, a * a), 0.f)) * (ig * xc[k]);
                hst = a * hst + bb;
                if (pass == 1) { prod *= a; hpk[(size_t)(tb0 + k) * W] = cvt2f(hst, prod); }
                else ob[(size_t)(tb0 + k) * (3 * W)] = (bf16)(cvt2f(hst * gelu_tanh(bf2f((k & 1) ? yv2[k >> 1].y : yv2[k >> 1].x)), 0.f) & 0xffffu);
            }
        }
    }
    if (pass == 1) { float* ag = AGG + (size_t)(bh * 16 + c) * 128 + lane; ag[0] = prod; ag[64] = hst; }
    (void)sumlog;
}
__device__ __forceinline__ void lru2_item(int item, const unsigned* HPK, const bf16* YL, bf16* OB, const float* AGG, int lane) {
    const int c = item & 15, bh = item >> 4, b = bh / 6, hd = bh % 6, cg = lane & 7, ts = lane >> 3, ch0 = 64 * hd + 8 * cg;
    float carry[8];
#pragma unroll
    for (int j = 0; j < 8; ++j) carry[j] = 0.f;
    const float* ag = AGG + (size_t)(bh * 16) * 128 + 8 * cg;
    for (int k0 = 0; k0 < c; k0 += 4) {
        f32x4v av[4][2], hv[4][2];
#pragma unroll
        for (int kk = 0; kk < 4; ++kk) { const float* q = ag + (size_t)(k0 + kk) * 128; av[kk][0] = *(const f32x4v*)q; av[kk][1] = *(const f32x4v*)(q + 4); hv[kk][0] = *(const f32x4v*)(q + 64); hv[kk][1] = *(const f32x4v*)(q + 68); }
#pragma unroll
        for (int kk = 0; kk < 4; ++kk) { const bool on = (k0 + kk) < c;
#pragma unroll
            for (int j = 0; j < 8; ++j) { const float a = on ? av[kk][j >> 2][j & 3] : 1.0f, h = on ? hv[kk][j >> 2][j & 3] : 0.f; carry[j] = a * carry[j] + h; } }
    }
    const size_t row0 = (size_t)(b * T + 128 * c + ts);
#pragma unroll 4
    for (int s = 0; s < 16; ++s) {
        const size_t row = row0 + 8 * s;
        const v4u p0 = *(const v4u*)(HPK + row * W + ch0), p1 = *(const v4u*)(HPK + row * W + ch0 + 4);
        const v4u yv = *(const v4u*)(YL + row * W + ch0);
        const unsigned pp[8] = {p0.x, p0.y, p0.z, p0.w, p1.x, p1.y, p1.z, p1.w};
        const unsigned yy[4] = {yv.x, yv.y, yv.z, yv.w};
        float o[8];
#pragma unroll
        for (int j = 0; j < 8; ++j) { const float hl = __uint_as_float(pp[j] << 16), pr = __uint_as_float(pp[j] & 0xffff0000u);
            const float y = __uint_as_float((j & 1) ? (yy[j >> 1] & 0xffff0000u) : (yy[j >> 1] << 16));
            o[j] = (hl + pr * carry[j]) * gelu_tanh(y); }
        const v4u ov = (v4u){cvt2f(o[0], o[1]), cvt2f(o[2], o[3]), cvt2f(o[4], o[5]), cvt2f(o[6], o[7])};
        *(v4u*)(OB + row * (3 * W) + 2 * W + ch0) = ov;
    }
}

__device__ __forceinline__ void lru_pass(int pass, const bf16* XL, bf16* YL, float* AGG, const float* conv_w, const float* conv_b, const float* w_a, const float* b_a, const float* w_x, const float* b_x,
                                         const float* lam, int gw, int ngw, int lane) {
    for (int item = gw; item < NB * 6 * 16; item += ngw) {
        const int c = item & 15, bh = item >> 4, b = bh / 6, hd = bh % 6, ch = 64 * hd + lane;
        float wa[64], wx[64];
#pragma unroll
        for (int i = 0; i < 64; ++i) { wa[i] = w_a[(hd * 64 + i) * 64 + lane]; wx[i] = w_x[(hd * 64 + i) * 64 + lane]; }
        const float cw0 = conv_w[0 * W + ch], cw1 = conv_w[1 * W + ch], cw2 = conv_w[2 * W + ch], cw3 = conv_w[3 * W + ch], cb = conv_b[ch];
        const float ba = b_a[ch], bx = b_x[ch];
        const float lm = lam[ch];
        const float ls8 = 8.0f * (fminf(lm, 0.f) - log1pf(__expf(-fabsf(lm))));
        const int t0 = 128 * c;
        const bf16* xb = XL + (size_t)(b * T) * W + ch;
        bf16* yb = YL + (size_t)(b * T) * W + ch;
        float xm3 = t0 >= 3 ? bf2f(xb[(size_t)(t0 - 3) * W]) : 0.f, xm2 = t0 >= 2 ? bf2f(xb[(size_t)(t0 - 2) * W]) : 0.f, xm1 = t0 >= 1 ? bf2f(xb[(size_t)(t0 - 1) * W]) : 0.f;
        float hst = 0.f, sumlog = 0.f;
        if (pass == 2) { const float* ag = AGG + (size_t)(bh * 16) * 128 + lane;
            for (int k = 0; k < c; ++k) hst = ag[k * 128] * hst + ag[k * 128 + 64]; }
        for (int tb = 0; tb < 128; tb += 8) {
            float xv[8], yv[8];
#pragma unroll
            for (int k = 0; k < 8; ++k) { xv[k] = bf2f(xb[(size_t)(t0 + tb + k) * W]); yv[k] = (pass == 2) ? bf2f(yb[(size_t)(t0 + tb + k) * W]) : 0.f; }
#pragma unroll
            for (int k = 0; k < 8; ++k) {
                const float xc = cw0 * xm3 + cw1 * xm2 + cw2 * xm1 + cw3 * xv[k] + cb;
                xm3 = xm2; xm2 = xm1; xm1 = xv[k];
                float ra = ba, ri = bx;
#pragma unroll
                for (int i = 0; i < 64; ++i) { const float xi = rdlane(xc, i); ra += xi * wa[i]; ri += xi * wx[i]; }
                const float r = sigmf(ra), ig = sigmf(ri);
                const float log_a = ls8 * r;
                const float a = __expf(log_a);
                const float bb = sqrtf(fmaxf(-expm1f(2.0f * log_a), 0.f)) * (ig * xc);
                hst = a * hst + bb;
                if (pass == 1) sumlog += log_a;
                else yb[(size_t)(t0 + tb + k) * W] = (bf16)f2bf(hst * gelu_tanh(yv[k]));
            }
        }
        if (pass == 1) { float* ag = AGG + (size_t)(bh * 16 + c) * 128 + lane; ag[0] = __expf(sumlog); ag[64] = hst; }
    }
}

__device__ __forceinline__ void moe_tables(const int* HIST, LAS unsigned char* lds, int tid) {
    LAS int* HL = (LAS int*)lds;
    LAS int* MT = (LAS int*)(lds + MT_OFF);
    for (int i = tid; i < 4096; i += NTHR) HL[i] = __hip_atomic_load(HIST + i, __ATOMIC_RELAXED, __HIP_MEMORY_SCOPE_AGENT);
    __syncthreads();
    { const int col = tid & 15, part = tid >> 4; int tot = 0, base = 0;
#pragma unroll
      for (int k = 0; k < 8; ++k) { const int c = part * 8 + k, v = HL[c * 16 + col]; tot += v; base += (c < (int)blockIdx.x) ? v : 0; }
      __syncthreads();
      HL[tid] = tot; HL[512 + tid] = base; }
    __syncthreads();
    if (tid < 16) { int tot = 0, base = 0; for (int q = 0; q < 32; ++q) { tot += HL[q * 16 + tid]; base += HL[512 + q * 16 + tid]; } MT[MT_TOT + tid] = tot; MT[MT_BASE + tid] = base; }
    __syncthreads();
    if (tid < 2) { int off = 0, tiles = 0;
        for (int e = 0; e < 8; ++e) { const int pad = (MT[MT_TOT + tid * 8 + e] + 255) & ~255; MT[MT_OFFS + tid * 8 + e] = off; for (int k = 0; k < (pad >> 8) && tiles < MAXT; ++k) MT[MT_TEXP + tid * MAXT + tiles++] = e; off += pad; }
        MT[MT_NT + tid] = tiles; }
    __syncthreads();
}

struct Args { const float* in[33]; float* out; unsigned char* ws; int ph_lo, ph_hi, li, pad; };
constexpr int N_PHASES = 23;
#ifndef R_PREP
#define R_PREP 1
#endif
#ifndef R_INPROJ
#define R_INPROJ 1
#endif
#ifndef R_S5
#define R_S5 1
#endif
#ifndef R_ATTN
#define R_ATTN 1
#endif
#ifndef R_LRU1
#define R_LRU1 1
#endif
#ifndef R_LRU2
#define R_LRU2 1
#endif
#ifndef R_GLU
#define R_GLU 1
#endif
#ifndef R_MERGED
#define R_MERGED 1
#endif
#ifndef R_OUT0
#define R_OUT0 1
#endif
#ifndef R_NORM
#define R_NORM 1
#endif
#ifndef R_FGU
#define R_FGU 1
#endif
#ifndef R_P15
#define R_P15 1
#endif
#ifndef R_MGU
#define R_MGU 1
#endif

#ifndef GP_ALIGN
#define GP_ALIGN true
#endif
#ifndef GP_SP2
#define GP_SP2 true
#endif
#ifndef MK_STOP
#define MK_STOP N_PHASES
#endif

__global__ void __launch_bounds__(NTHR, 2) hybrid_fwd(Args args) {
    extern __shared__ __attribute__((aligned(16))) unsigned char lds_raw[];
    LAS unsigned char* lds = (LAS unsigned char*)lds_raw;
    volatile LAS unsigned* MISC = (volatile LAS unsigned*)(lds + MISC_OFF);
    LAS int* MT = (LAS int*)(lds + MT_OFF);
    const int tid0 = threadIdx.x;
    int wave0 = __builtin_amdgcn_readfirstlane(tid0 >> 6); asm volatile("" : "+s"(wave0));
    const int G = gridDim.x, bx0 = blockIdx.x;
    const int NGW = G * NWAVES, NTH = G * NTHR;
    unsigned char* ws0 = args.ws;
    unsigned* ctl = (unsigned*)(ws0 + WS_CTL);
    const int lo = args.ph_lo, hi = args.ph_hi;
    for (int u = tid0; u < (LDS_BYTES - RING_BYTES) / 4; u += NTHR) ((LAS unsigned*)(lds + RING_BYTES))[u] = 0u;
    __syncthreads();
    XcdBarrier bar; bar.bar = ctl + CW_BAR + args.li * XCD_BAR_WORDS; bar.x = 0; bar.st = nullptr;
    if (hi - lo > 1) { bar = xcd_barrier_post(ctl + CW_BAR + args.li * XCD_BAR_WORDS, MISC + 8); xcd_barrier_census(bar); }
#define PHASE_VARS int tid = wave0 * 64 + (int)__builtin_amdgcn_mbcnt_hi(~0u, __builtin_amdgcn_mbcnt_lo(~0u, 0u)); asm volatile("" : "+v"(tid)); int bx = bx0; asm volatile("" : "+s"(bx)); unsigned char* ws = ws0; asm volatile("" : "+s"(ws)); \
    const int lane = tid & 63, wave = __builtin_amdgcn_readfirstlane(tid >> 6), gw = wave * G + bx, gtid = bx * NTHR + tid; (void)lane; (void)wave; (void)gw; (void)gtid; (void)ws;
#define IN(k) (lo <= (k) && (k) < hi)
#ifndef R_MERGED
#define R_MERGED 1
#endif
#ifndef PROBE_MASK
#define PROBE_MASK 0u
#endif
    unsigned long long pt0_ = PROBE_MASK ? __builtin_amdgcn_s_memrealtime() : 0ull;
#define PROBE_T1(k) do { if ((PROBE_MASK >> (k)) & 1u) { __syncthreads(); const unsigned long long d_ = __builtin_amdgcn_s_memrealtime() - pt0_; while (__builtin_amdgcn_s_memrealtime() - pt0_ < 2ull * d_) __builtin_amdgcn_s_sleep(8); } } while (0)
#define SEAM(k) do { PROBE_T1(k); if (IN((k) + 1)) xcd_barrier(bar, wave0); if (PROBE_MASK) pt0_ = __builtin_amdgcn_s_memrealtime(); } while (0)

#define x_in (args.in[0])
#define xres ((bf16*)args.out)
constexpr int XP = pg8::XP;
#define S5PAR ((float*)(ws + WS_MISC + MS_S5PAR))
#define AGG ((float*)(ws + 476 * MiB + (size_t)L * 1048576))
#define ROUTE ((float*)(ws + WS_MISC + MS_ROUTE))
#define HIST ((int*)(ws + WS_MISC + MS_HIST))
#define TOK ((int*)(ws + WS_MISC + MS_TOK))
#define WTS ((float*)(ws + WS_MISC + MS_WTS))
#define LRUW ((bf16*)(ws + WS_MISC + MS_LRUW))
#define WIN ((bf16*)(ws + WS_W + W_IN))
#define WGLU ((bf16*)(ws + WS_W + W_GLU))
#define WBR ((bf16*)(ws + WS_W + W_BR))
#define WOUT ((bf16*)(ws + WS_W + W_OUT))
#define WFGU ((bf16*)(ws + WS_W + W_FGU))
#define WFD ((bf16*)(ws + WS_W + W_FD))
#define HB ((bf16*)(ws + WS_H))
#define Y5 ((bf16*)(ws + (L == 0 ? WS_Y5 : WS_Y5B)))
#define P6 ((bf16*)(ws + WS_P6))
#define GT ((bf16*)(ws + WS_G))
#define DACT ((bf16*)(ws + WS_DACT))
#define MWGU ((bf16*)(ws + WS_MWGU))
#define MWD ((bf16*)(ws + WS_MWD))
#define H2 ((bf16*)(ws + WS_H2))
#define HP ((bf16*)(ws + WS_HP))
#define ACT ((bf16*)(ws + WS_ACT))
#define MWGU8 ((unsigned char*)(ws + WS_MWGU))
#define MWD8 ((unsigned char*)(ws + WS_MWD))
#define H28 ((unsigned char*)(ws + WS_H2))
#define HP8 ((unsigned char*)(ws + WS_HP))
#define ACT8 ((unsigned char*)(ws + WS_ACT))
#define X2B ((bf16*)(ws + WS_H2))
#define HB8 ((unsigned char*)(ws + 478 * MiB))
#define WG8 ((unsigned char*)(ws + 550 * MiB))
#define HBN ((bf16*)(ws + 478 * MiB))
#define PN_CNT(i) ((unsigned*)(ws + 65536 + (size_t)(i) * 32768))
#define PN_XB(i) ((unsigned*)(ws + WS_MISC + ((i) == 0 ? 524288 : (i) == 1 ? 1048576 : 3407872)))
#define PN_RS ((float*)(ws + WS_MISC + 3932160))
#define F8_SX 4.0f
#define F8_SW1 32.0f
#define F8_SACT 8.0f
#define F8_SW2 64.0f
#define PU P6
#define PQ (P6 + (size_t)NT * W)
#define PYL (P6 + (size_t)2 * NT * W)
#define PK (P6 + (size_t)3 * NT * W)
#define PV (P6 + (size_t)4 * NT * W)
#define PXL (P6 + (size_t)5 * NT * W)
#define scr ((LAS float*)(lds + wave * 16384))
#define PREP_JOBS \
        constexpr int I_IN = 16 * (INW / 32), I_GLU = 6 * 12, I_BR = 6 * 32, I_OUT = 16 * 32, I_FG = 16 * (DFF / 32), I_FD = (DFF / 64) * 32; \
        constexpr int NITEMS = 2 * I_IN + 2 * I_GLU + 6 * I_BR + 2 * I_OUT + 2 * I_FG + I_FD, N_EARLY = I_IN + 2 * I_GLU, N_DEFER = NITEMS - N_EARLY; (void)N_DEFER; \
        auto job0 = [&](int it) -> TrJob { int r = it; \
            if (r < 2 * I_IN) { const int l = r / I_IN; return TrJob{args.in[2] + (size_t)l * D * INW, D, INW, WIN + (size_t)l * INW * D, 0, 0, r % I_IN, 0, 0, F8_SW1, 2304, WG8 + (size_t)l * 3072 * D}; } r -= 2 * I_IN; \
            if (r < 2 * I_GLU) { const int l = r / I_GLU; return TrJob{args.in[12] + (size_t)l * W * W, W, W, WGLU + (size_t)l * 512 * W, 0, 0, r % I_GLU}; } r -= 2 * I_GLU; \
            if (r < 6 * I_BR) { const int ln = r / I_BR; return TrJob{args.in[21] + (size_t)ln * W * D, W, D, WBR + (size_t)(ln / 3) * D * 3 * W, 0, 0, r % I_BR, 3 * W, (ln % 3) * W, 0.f, 0, nullptr, EMU_BIT(0)}; } r -= 6 * I_BR; \
            if (r < 2 * I_OUT) { const int l = r / I_OUT; return TrJob{args.in[22] + (size_t)l * D * D, D, D, WOUT + (size_t)l * D * D, 0, 0, r % I_OUT, 0, 0, 0.f, 0, nullptr, EMU_BIT(1)}; } r -= 2 * I_OUT; \
            if (r < I_FG) return TrJob{args.in[24], D, DFF, WFGU, 1, 0, r, 0, 0, 0.f, 0, nullptr, EMU_BIT(3)}; r -= I_FG; \
            if (r < I_FG) return TrJob{args.in[25], D, DFF, WFGU, 1, 128, r, 0, 0, 0.f, 0, nullptr, EMU_BIT(4)}; r -= I_FG; \
            return TrJob{args.in[26], DFF, D, WFD, 0, 0, r, 0, 0, F8_SW2}; };
#ifdef MK_F8EMU
#define EMU_BIT(b) (((MK_F8EMU) >> (b)) & 1)
#else
#define EMU_BIT(b) 0
#endif
#define TR_MAP_ID(v) (v)
#define TR_MAP_EARLY(v) ((v) < I_IN ? (v) : (v) + I_IN)
#define TR_MAP_DEFER(v) ((v) < I_IN ? (v) + I_IN : (v) + I_IN + 2 * I_GLU)
#define TR_RUN(NV, START, STRIDE, MAP) { f32x4 va[8], vb[8]; TrJob ja{}, jb{}; int it = (START); \
          if (it < (NV)) { ja = job0(MAP(it)); tr_load(ja, lane, va); } \
          for (; it < (NV); it += 2 * (STRIDE)) { \
              const bool hb = it + (STRIDE) < (NV); if (hb) { jb = job0(MAP(it + (STRIDE))); tr_load(jb, lane, vb); } \
              tr_write(ja, lane, va, scr); \
              const bool ha = it + 2 * (STRIDE) < (NV); if (ha) { ja = job0(MAP(it + 2 * (STRIDE))); tr_load(ja, lane, va); } \
              if (hb) tr_write(jb, lane, vb, scr); \
          } }
#define HPK ((unsigned*)(ws + WS_HPK))
#define BR3 ((bf16*)(ws + 478 * MiB))

    if (IN(0)) { PHASE_VARS
      for (int rep_ = 0; rep_ < R_PREP; ++rep_) {
        PREP_JOBS
        TR_RUN(N_EARLY, bx * NWAVES + wave, NGW, TR_MAP_EARLY)
        for (int i = gtid; i < 2 * 128 * W / 8; i += NTH) { const int l = i / (128 * W / 8), r = i % (128 * W / 8); *(v4u*)(WGLU + (size_t)l * 512 * W + (size_t)384 * W + (size_t)r * 8) = (v4u){0u, 0u, 0u, 0u}; }
        for (int i = gtid; i < 2 * 2 * 6 * 4096; i += NTH) { const int ii = i & 63, j = (i >> 6) & 63, hd = (i >> 12) % 6, lm = (i >> 12) / 6, mat = lm & 1, l = lm >> 1;
            LRUW[i] = (bf16)f2bf((mat == 0 ? args.in[16] : args.in[18])[(size_t)((l * 6 + hd) * 64 + ii) * 64 + j]); }
        for (int i = gtid; i < 2 * NG * NP; i += NTH) {
            const int l = i / (NG * NP), gp = i % (NG * NP), g = gp / NP;
            const float lre = args.in[4][i], lim = args.in[5][i], dt = expf(args.in[6][l * NG + g]);
            const float ea = expf(lre * dt), are = ea * cosf(lim * dt), aim = ea * sinf(lim * dt), den = lre * lre + lim * lim, nr = are - 1.0f;
            const float cre = (nr * lre + aim * lim) / den, cim = (aim * lre - nr * lim) / den;
            float* o = S5PAR + (size_t)i * 34; o[0] = are; o[1] = aim;
            for (int h = 0; h < 16; ++h) { const float br = args.in[7][(size_t)i * 16 + h], bi = args.in[8][(size_t)i * 16 + h]; o[2 + h] = cre * br - cim * bi; o[18 + h] = cre * bi + cim * br; }
        }
        for (int m = gw; m < NT; m += 2 * NGW) {
            const int m2 = m + NGW;
            const f32x4* xa = (const f32x4*)(x_in + (size_t)m * D) + lane; const f32x4* xb2 = (const f32x4*)(x_in + (size_t)m2 * D) + lane; const f32x4* gr = (const f32x4*)args.in[1] + lane;
            f32x4 va[4], vb[4]; float sa = 0.f, sb = 0.f;
#pragma unroll
            for (int j = 0; j < 4; ++j) { va[j] = xa[64 * j]; vb[j] = xb2[64 * j]; }
#pragma unroll
            for (int j = 0; j < 4; ++j) { sa += (va[j].x * va[j].x + va[j].y * va[j].y) + (va[j].z * va[j].z + va[j].w * va[j].w); sb += (vb[j].x * vb[j].x + vb[j].y * vb[j].y) + (vb[j].z * vb[j].z + vb[j].w * vb[j].w); }
#pragma unroll
            for (int o = 1; o < 64; o <<= 1) { sa += __shfl_xor(sa, o); sb += __shfl_xor(sb, o); }
            const float ra = 1.0f / sqrtf(sa * (1.f / D) + RMS_EPS), rb = 1.0f / sqrtf(sb * (1.f / D) + RMS_EPS);
            unsigned long long* oa = (unsigned long long*)(HB + (size_t)m * D) + lane; unsigned long long* ob = (unsigned long long*)(HB + (size_t)m2 * D) + lane;
            unsigned* qa = (unsigned*)(HB8 + (size_t)m * D) + lane; unsigned* qb = (unsigned*)(HB8 + (size_t)m2 * D) + lane;
#pragma unroll
            for (int j = 0; j < 4; ++j) { const f32x4 g = gr[64 * j]; const f32x4 a = va[j] * ra * g, b = vb[j] * rb * g;
                oa[64 * j] = (unsigned long long)pk2(a.x, a.y) | ((unsigned long long)pk2(a.z, a.w) << 32); ob[64 * j] = (unsigned long long)pk2(b.x, b.y) | ((unsigned long long)pk2(b.z, b.w) << 32);
                qa[64 * j] = pg8::pk4_f8(a.x * F8_SX, a.y * F8_SX, a.z * F8_SX, a.w * F8_SX); qb[64 * j] = pg8::pk4_f8(b.x * F8_SX, b.y * F8_SX, b.z * F8_SX, b.w * F8_SX); }
        }
      }
        SEAM(0);
    }

    { constexpr int L = 0;
        const int pb = 1 + 9 * L;
        if (IN(pb)) { PHASE_VARS
            { pg8::Gemm g8{(const bf16*)HB8, (const bf16*)(WG8 + (size_t)L * 3072 * D), NT, 3072, D / 2}; pg8::StaticOrder S8; S8.init(NT, 3072, G, bx);
              pg8::EpiInProj E8{P6, (unsigned char*)GT, args.in[3] + L * 3 * D, 1.0f / (F8_SX * F8_SW1), 0};
              pg8::gemm_phase<pg8::EpiInProj, pg8::StaticOrder, GP_ALIGN, GP_SP2, true>(lds, g8, S8, E8, tid); }
            pg8::Gemm g{HB, WIN + (size_t)L * INW * D, NT, 2304, D}; pg8::StaticOrder S; S.init(NT, 2304, G, bx);
            pg8::EpiInProj E{P6, (unsigned char*)GT, args.in[3] + L * 3 * D, 1.0f, 9};
            for (int rep_ = 0; rep_ < R_INPROJ; ++rep_) pg8::gemm_phase<pg8::EpiInProj, pg8::StaticOrder, GP_ALIGN, GP_SP2>(lds, g, S, E, tid);
            if (L == 0 && bx >= G / 2) {
                PREP_JOBS
                TR_RUN(N_DEFER, (bx - G / 2) * NWAVES + wave, (G / 2) * NWAVES, TR_MAP_DEFER)
            }
            if (L == 1 && bx >= G / 2) {
                constexpr int I_D = (DFE / 64) * 32;
                auto job0 = [&](int it) -> TrJob { const int e = it / I_D; return TrJob{args.in[31] + (size_t)e * DFE * D, DFE, D, (bf16*)(MWD8 + (size_t)e * D * DFE), 0, 0, it % I_D, 0, 0, F8_SW2}; };
                TR_RUN(NE * I_D, (bx - G / 2) * NWAVES + wave, (G / 2) * NWAVES, TR_MAP_ID)
            }
            SEAM(pb);
        }
#ifndef MK_STRIP
        if (IN(pb + 1)) { PHASE_VARS
#ifdef MIX_SIMPLE
            s5_simple(PU, Y5, S5PAR + (size_t)L * NG * NP * 34, args.in[9] + (size_t)L * NG * NH * NP, args.in[10] + (size_t)L * NG * NH * NP, args.in[11] + L * W, lds, G, tid);
            for (int it = gw; it < NB * 6 * 64; it += NGW) attn_item(it, PQ, PK, PV, BR3 + W, 3 * W, lane);
            lru_pass(1, PXL, PYL, AGG, args.in[14] + L * 4 * W, args.in[15] + L * W, args.in[16] + L * 6 * 64 * 64, args.in[17] + L * W, args.in[18] + L * 6 * 64 * 64, args.in[19] + L * W, args.in[20] + L * W, gw, NGW, lane);
#else
            LAS int* qc = (LAS int*)(lds + MT_OFF);
            if (tid == 0) *qc = 0;
            __syncthreads();
            if (gw < NB * NG) {
                __builtin_amdgcn_s_setprio(3);
                for (int rep_ = 0; rep_ < R_S5; ++rep_) s5_item(gw, PU, Y5, S5PAR + (size_t)L * NG * NP * 34, args.in[9] + (size_t)L * NG * NH * NP, args.in[10] + (size_t)L * NG * NH * NP, args.in[11] + L * W, lds + wave * 9728, lane);
                __builtin_amdgcn_s_setprio(0); }
            { const int nA = bx < G / 2 ? 22 : 26, a0 = bx < G / 2 ? 22 * bx : 22 * (G / 2) + 26 * (bx - G / 2);
              for (;;) {
                int k = 0; if (lane == 0) k = __hip_atomic_fetch_add(qc, 1, __ATOMIC_RELAXED, __HIP_MEMORY_SCOPE_WORKGROUP);
                k = __builtin_amdgcn_readfirstlane(k);
                if (k >= 6 + nA) break;
                if (k < 6) lru_item(1, bx * 6 + k, PXL, PYL, BR3, AGG, args.in[14] + L * 4 * W, args.in[15] + L * W, LRUW + (size_t)L * 2 * 6 * 4096, args.in[17] + L * W, args.in[19] + L * W, args.in[20] + L * W, lds + 20480 + wave * 4608, lane, HPK);
                else attn_item(a0 + k - 6, PQ, PK, PV, BR3 + W, 3 * W, lane);
              } }
#endif
            SEAM(pb + 1);
        }
        if (IN(pb + 2)) { PHASE_VARS
#ifdef MIX_SIMPLE
            lru_pass(2, PXL, PYL, AGG, args.in[14] + L * 4 * W, args.in[15] + L * W, args.in[16] + L * 6 * 64 * 64, args.in[17] + L * W, args.in[18] + L * 6 * 64 * 64, args.in[19] + L * W, args.in[20] + L * W, gw, NGW, lane);
#else
            for (int it = gw; it < NB * 6 * 16; it += NGW) lru2_item(it, HPK, PYL, BR3, AGG, lane);
#endif
            __syncthreads();
            pg8::Gemm g{Y5, WGLU + (size_t)L * 512 * W, NT, 512, W}; pg8::StaticOrder S; S.init(NT, 512, G, bx);
            pg8::EpiGlu E{Y5, BR3, args.in[13] + L * W, 3 * W};
            for (int rep_ = 0; rep_ < R_GLU; ++rep_) pg8::gemm_phase<pg8::EpiGlu, pg8::StaticOrder, GP_ALIGN, GP_SP2>(lds, g, S, E, tid);
            SEAM(pb + 2);
        }
        if (IN(pb + 3)) { PHASE_VARS
            pg8::Gemm g{BR3, WBR + (size_t)L * 3 * D * W, NT, D, 3 * W}; pg8::StaticOrder S; S.init(NT, D, G, bx);
            pg8::EpiMergedF E{(const unsigned char*)GT, HB};
            for (int rep_ = 0; rep_ < R_MERGED; ++rep_) pg8::gemm_phase<pg8::EpiMergedF, pg8::StaticOrder, GP_ALIGN, GP_SP2>(lds, g, S, E, tid);
            SEAM(pb + 3);
        }
        if (IN(pb + 4)) { PHASE_VARS
            pg8::Gemm g{HB, WOUT + (size_t)L * D * D, NT, D, D}; pg8::StaticOrder S; S.init(NT, D, G, bx);
            if (L == 0) {
                pg8::EpiResidNorm<true, false> E{x_in, xres, args.in[23], HBN, nullptr, PN_XB(0), PN_CNT(0), lds + MT_OFF};
                pg8::gemm_phase<pg8::EpiResidNorm<true, false>, pg8::StaticOrder, GP_ALIGN, GP_SP2>(lds, g, S, E, tid);
            } else {
                pg8::EpiResidNorm<false, true, false> E{nullptr, xres, args.in[23] + D, nullptr, H28, PN_XB(2), PN_CNT(2), lds + MT_OFF, PN_RS};
                pg8::gemm_phase<pg8::EpiResidNorm<false, true, false>, pg8::StaticOrder, GP_ALIGN, GP_SP2>(lds, g, S, E, tid);
            }
            SEAM(pb + 4);
        }
        if (L == 0) {
            if (IN(7)) { PHASE_VARS
                pg8::Gemm g{HBN, WFGU, NT, 2 * DFF, D}; pg8::StaticOrder S; S.init(NT, 2 * DFF, G, bx);
                pg8::EpiSwiglu8 E{(unsigned char*)DACT, DFF, 2 * DFF / 256, 1.0f, F8_SACT};
                for (int rep_ = 0; rep_ < R_FGU; ++rep_) pg8::gemm_phase<pg8::EpiSwiglu8, pg8::StaticOrder, GP_ALIGN, GP_SP2>(lds, g, S, E, tid);
                SEAM(7);
            }
            if (IN(8)) { PHASE_VARS
                pg8::Gemm g{DACT, WFD, NT, D, DFF / 2}; pg8::StaticOrder S; S.init(NT, D, G, bx);
                pg8::EpiResidNorm<false, true, true, 512> E{nullptr, xres, args.in[1] + D, HB, HB8, PN_XB(1), PN_CNT(1), lds + MT_OFF};
                pg8::gemm_phase<pg8::EpiResidNorm<false, true, true, 512>, pg8::StaticOrder, GP_ALIGN, GP_SP2, true>(lds, g, S, E, tid);
                SEAM(8);
            }
        }
#endif
    }
    { constexpr int L = 1;
        const int pb = 1 + 9 * L;
        if (IN(pb)) { PHASE_VARS
            { pg8::Gemm g8{(const bf16*)HB8, (const bf16*)(WG8 + (size_t)L * 3072 * D), NT, 3072, D / 2}; pg8::StaticOrder S8; S8.init(NT, 3072, G, bx);
              pg8::EpiInProj E8{P6, (unsigned char*)GT, args.in[3] + L * 3 * D, 1.0f / (F8_SX * F8_SW1), 0};
              pg8::gemm_phase<pg8::EpiInProj, pg8::StaticOrder, GP_ALIGN, GP_SP2, true>(lds, g8, S8, E8, tid); }
            pg8::Gemm g{HB, WIN + (size_t)L * INW * D, NT, 2304, D}; pg8::StaticOrder S; S.init(NT, 2304, G, bx);
            pg8::EpiInProj E{P6, (unsigned char*)GT, args.in[3] + L * 3 * D, 1.0f, 9};
            for (int rep_ = 0; rep_ < R_INPROJ; ++rep_) pg8::gemm_phase<pg8::EpiInProj, pg8::StaticOrder, GP_ALIGN, GP_SP2>(lds, g, S, E, tid);
            if (L == 0 && bx >= G / 2) {
                PREP_JOBS
                TR_RUN(N_DEFER, (bx - G / 2) * NWAVES + wave, (G / 2) * NWAVES, TR_MAP_DEFER)
            }
            if (L == 1 && bx >= G / 2) {
                constexpr int I_D = (DFE / 64) * 32;
                auto job0 = [&](int it) -> TrJob { const int e = it / I_D; return TrJob{args.in[31] + (size_t)e * DFE * D, DFE, D, (bf16*)(MWD8 + (size_t)e * D * DFE), 0, 0, it % I_D, 0, 0, F8_SW2}; };
                TR_RUN(NE * I_D, (bx - G / 2) * NWAVES + wave, (G / 2) * NWAVES, TR_MAP_ID)
            }
            SEAM(pb);
        }
#ifndef MK_STRIP
        if (IN(pb + 1)) { PHASE_VARS
#ifdef MIX_SIMPLE
            s5_simple(PU, Y5, S5PAR + (size_t)L * NG * NP * 34, args.in[9] + (size_t)L * NG * NH * NP, args.in[10] + (size_t)L * NG * NH * NP, args.in[11] + L * W, lds, G, tid);
            for (int it = gw; it < NB * 6 * 64; it += NGW) attn_item(it, PQ, PK, PV, BR3 + W, 3 * W, lane);
            lru_pass(1, PXL, PYL, AGG, args.in[14] + L * 4 * W, args.in[15] + L * W, args.in[16] + L * 6 * 64 * 64, args.in[17] + L * W, args.in[18] + L * 6 * 64 * 64, args.in[19] + L * W, args.in[20] + L * W, gw, NGW, lane);
#else
            LAS int* qc = (LAS int*)(lds + MT_OFF);
            if (tid == 0) *qc = 0;
            __syncthreads();
            if (gw < NB * NG) {
                __builtin_amdgcn_s_setprio(3);
                for (int rep_ = 0; rep_ < R_S5; ++rep_) s5_item(gw, PU, Y5, S5PAR + (size_t)L * NG * NP * 34, args.in[9] + (size_t)L * NG * NH * NP, args.in[10] + (size_t)L * NG * NH * NP, args.in[11] + L * W, lds + wave * 9728, lane);
                __builtin_amdgcn_s_setprio(0); }
            { const int nA = bx < G / 2 ? 22 : 26, a0 = bx < G / 2 ? 22 * bx : 22 * (G / 2) + 26 * (bx - G / 2);
              for (;;) {
                int k = 0; if (lane == 0) k = __hip_atomic_fetch_add(qc, 1, __ATOMIC_RELAXED, __HIP_MEMORY_SCOPE_WORKGROUP);
                k = __builtin_amdgcn_readfirstlane(k);
                if (k >= 6 + nA) break;
                if (k < 6) lru_item(1, bx * 6 + k, PXL, PYL, BR3, AGG, args.in[14] + L * 4 * W, args.in[15] + L * W, LRUW + (size_t)L * 2 * 6 * 4096, args.in[17] + L * W, args.in[19] + L * W, args.in[20] + L * W, lds + 20480 + wave * 4608, lane, HPK);
                else attn_item(a0 + k - 6, PQ, PK, PV, BR3 + W, 3 * W, lane);
              } }
#endif
            SEAM(pb + 1);
        }
        if (IN(pb + 2)) { PHASE_VARS
#ifdef MIX_SIMPLE
            lru_pass(2, PXL, PYL, AGG, args.in[14] + L * 4 * W, args.in[15] + L * W, args.in[16] + L * 6 * 64 * 64, args.in[17] + L * W, args.in[18] + L * 6 * 64 * 64, args.in[19] + L * W, args.in[20] + L * W, gw, NGW, lane);
#else
            for (int it = gw; it < NB * 6 * 16; it += NGW) lru2_item(it, HPK, PYL, BR3, AGG, lane);
#endif
            __syncthreads();
            pg8::Gemm g{Y5, WGLU + (size_t)L * 512 * W, NT, 512, W}; pg8::StaticOrder S; S.init(NT, 512, G, bx);
            pg8::EpiGlu E{Y5, BR3, args.in[13] + L * W, 3 * W};
            for (int rep_ = 0; rep_ < R_GLU; ++rep_) pg8::gemm_phase<pg8::EpiGlu, pg8::StaticOrder, GP_ALIGN, GP_SP2>(lds, g, S, E, tid);
            SEAM(pb + 2);
        }
        if (IN(pb + 3)) { PHASE_VARS
            pg8::Gemm g{BR3, WBR + (size_t)L * 3 * D * W, NT, D, 3 * W}; pg8::StaticOrder S; S.init(NT, D, G, bx);
            pg8::EpiMergedF E{(const unsigned char*)GT, HB};
            for (int rep_ = 0; rep_ < R_MERGED; ++rep_) pg8::gemm_phase<pg8::EpiMergedF, pg8::StaticOrder, GP_ALIGN, GP_SP2>(lds, g, S, E, tid);
            SEAM(pb + 3);
        }
        if (IN(pb + 4)) { PHASE_VARS
            pg8::Gemm g{HB, WOUT + (size_t)L * D * D, NT, D, D}; pg8::StaticOrder S; S.init(NT, D, G, bx);
            if (L == 0) {
                pg8::EpiResidNorm<true, false> E{x_in, xres, args.in[23], HBN, nullptr, PN_XB(0), PN_CNT(0), lds + MT_OFF};
                pg8::gemm_phase<pg8::EpiResidNorm<true, false>, pg8::StaticOrder, GP_ALIGN, GP_SP2>(lds, g, S, E, tid);
            } else {
                pg8::EpiResidNorm<false, true, false> E{nullptr, xres, args.in[23] + D, nullptr, H28, PN_XB(2), PN_CNT(2), lds + MT_OFF, PN_RS};
                pg8::gemm_phase<pg8::EpiResidNorm<false, true, false>, pg8::StaticOrder, GP_ALIGN, GP_SP2>(lds, g, S, E, tid);
            }
            SEAM(pb + 4);
        }
        if (L == 0) {
            if (IN(7)) { PHASE_VARS
                pg8::Gemm g{HBN, WFGU, NT, 2 * DFF, D}; pg8::StaticOrder S; S.init(NT, 2 * DFF, G, bx);
                pg8::EpiSwiglu8 E{(unsigned char*)DACT, DFF, 2 * DFF / 256, 1.0f, F8_SACT};
                for (int rep_ = 0; rep_ < R_FGU; ++rep_) pg8::gemm_phase<pg8::EpiSwiglu8, pg8::StaticOrder, GP_ALIGN, GP_SP2>(lds, g, S, E, tid);
                SEAM(7);
            }
            if (IN(8)) { PHASE_VARS
                pg8::Gemm g{DACT, WFD, NT, D, DFF / 2}; pg8::StaticOrder S; S.init(NT, D, G, bx);
                pg8::EpiResidNorm<false, true, true, 512> E{nullptr, xres, args.in[1] + D, HB, HB8, PN_XB(1), PN_CNT(1), lds + MT_OFF};
                pg8::gemm_phase<pg8::EpiResidNorm<false, true, true, 512>, pg8::StaticOrder, GP_ALIGN, GP_SP2, true>(lds, g, S, E, tid);
                SEAM(8);
            }
        }
#endif
    }
#ifndef MK_STRIP

    if (IN(15)) { PHASE_VARS
        constexpr int I_G = 16 * (DFE / 32), I_E = 2 * I_G;
        auto job15 = [&](int it) -> TrJob { const int e = it / I_E; int r = it % I_E;
            if (r < I_G) return TrJob{args.in[29] + (size_t)e * D * DFE, D, DFE, (bf16*)(MWGU8 + (size_t)e * 2 * DFE * D), 1, 0, r, 0, 0, F8_SW1}; r -= I_G;
            return TrJob{args.in[30] + (size_t)e * D * DFE, D, DFE, (bf16*)(MWGU8 + (size_t)e * 2 * DFE * D), 1, 128, r, 0, 0, F8_SW1}; };
        LAS int* LE = MT + MT_LE;
        const int tok0 = bx * 128;
        const int ex15 = args.pad;
        auto tr15 = [&]() {
#ifdef TR_NOPIPE
        for (int it = gw; it < NE * I_E; it += NGW) { const TrJob j = job15(it); tr_item(j.W, j.K, j.N, j.WT, j.kind, j.aux, (LAS float*)(lds + 32768 + wave * 8448), j.item, lane); }
#else
        { f32x4 va[8], vb[8]; TrJob ja{}, jb{}; int it = bx * NWAVES + wave;
          if (it < NE * I_E) { ja = job15(it); tr_load(ja, lane, va, ex15); }
          for (; it < NE * I_E; it += 2 * NGW) {
              const bool hb = it + NGW < NE * I_E; if (hb) { jb = job15(it + NGW); tr_load(jb, lane, vb, ex15); }
              tr_write(ja, lane, va, (LAS float*)(lds + 32768 + wave * 8448), ex15);
              const bool ha = it + 2 * NGW < NE * I_E; if (ha) { ja = job15(it + 2 * NGW); tr_load(ja, lane, va, ex15); }
              if (hb) tr_write(jb, lane, vb, (LAS float*)(lds + 32768 + wave * 8448), ex15);
          } }
#endif
        };
        LAS unsigned char* GWT = lds;
        LAS float* LGW = (LAS float*)(lds + 100352 + wave * 640);
        auto rows15 = [&]() {
            if (lane < 16) LGW[128 + lane] = __hip_atomic_load(PN_RS + tok0 + wave * 16 + lane, __ATOMIC_RELAXED, __HIP_MEMORY_SCOPE_AGENT);
            const int l15 = lane & 15, kq = lane >> 4;
            const bf16* xa = xres + (size_t)(tok0 + wave * 16 + l15) * XP + 8 * kq;
            f32x4v acc = (f32x4v){0.f, 0.f, 0.f, 0.f};
#pragma unroll 8
            for (int ks = 0; ks < 32; ++ks) {
                const bf16x8v xf = *(const bf16x8v*)(xa + 32 * ks);
                const bf16x8v bh = *(const LAS bf16x8v*)(GWT + ((ks * 4 + kq) * 8 + (l15 & 7)) * 16), bl = *(const LAS bf16x8v*)(GWT + 16384 + ((ks * 4 + kq) * 8 + (l15 & 7)) * 16);
                acc = __builtin_amdgcn_mfma_f32_16x16x32_bf16(xf, bh, acc, 0, 0, 0); acc = __builtin_amdgcn_mfma_f32_16x16x32_bf16(xf, bl, acc, 0, 0, 0);
            }
            if (l15 < 8) {
#pragma unroll
                for (int q = 0; q < 4; ++q) LGW[(4 * kq + q) * 8 + l15] = acc[q]; }
            LDS_WAIT();
            if (lane < 16) { const int il = wave * 16 + lane, m = tok0 + il; const float rs = LGW[128 + lane];
                float lg[8];
#pragma unroll
                for (int e = 0; e < 8; ++e) lg[e] = LGW[lane * 8 + e] * rs + args.in[28][e];
                int e0 = 0; float v0 = lg[0];
#pragma unroll
                for (int e = 1; e < 8; ++e) if (lg[e] > v0) { v0 = lg[e]; e0 = e; }
                int e1 = -1; float v1 = -3.0e38f;
#pragma unroll
                for (int e = 0; e < 8; ++e) if (e != e0 && lg[e] > v1) { v1 = lg[e]; e1 = e; }
                const float w1 = 1.0f / (1.0f + expf(v0 - v1)), w0 = 1.0f - w1;
                float* ro = ROUTE + (size_t)m * 4; ro[0] = __int_as_float(e0); ro[1] = __int_as_float(e1); ro[2] = w0; ro[3] = w1; LE[il] = e0; LE[128 + il] = e1; }
            LDS_WAIT();
        };
        for (int i = tid; i < D * 8; i += NTHR) { const int c = i >> 3, e = i & 7; const float gv = args.in[23][D + c] * args.in[27][(size_t)c * 8 + e];
            const unsigned hb = f2bf(gv); const float lo = gv - __uint_as_float(hb << 16); const int pos = (((c >> 5) * 4 + ((c >> 3) & 3)) * 8 + e) * 8 + (c & 7);
            ((LAS unsigned short*)GWT)[pos] = (unsigned short)hb; ((LAS unsigned short*)(GWT + 16384))[pos] = (unsigned short)f2bf(lo); }
        __syncthreads();
        if (ex15 == 1 || ex15 == 3 || ex15 == 4) tr15(); else if (ex15 == 2) rows15(); else if (wave & 1) { rows15(); tr15(); } else { tr15(); rows15(); }
            __syncthreads();
            if (tid < 16) { const int p = tid >> 3, e = tid & 7; int cnt = 0; for (int i = 0; i < 128; ++i) cnt += (LE[p * 128 + i] == e) ? 1 : 0; HIST[(tok0 / 128) * 16 + tid] = cnt; }
        SEAM(15);
    }
    if (IN(16)) { PHASE_VARS
        moe_tables(HIST, lds, tid);
        LAS int* LE = MT + MT_LE;
        const int p = (tid >> 7) & 1, i = tid & 127; const int m = bx * 128 + i;
        int e = 0; float wv = 0.f;
        if (tid < 256) { const float* ro = ROUTE + (size_t)m * 4; e = __float_as_int(ro[p]); wv = ro[2 + p]; LE[p * 128 + i] = e; }
        __syncthreads();
        if (tid < 256) { int rank = 0; for (int k = 0; k < i; ++k) rank += (LE[p * 128 + k] == e) ? 1 : 0;
            const int slot = MT[MT_OFFS + p * 8 + e] + MT[MT_BASE + p * 8 + e] + rank;
            TOK[p * (MAXT * 256) + slot] = m; WTS[p * (MAXT * 256) + slot] = wv;
            MT[MT_LE + 256 + p * 128 + i] = p * (MAXT * 256) + slot; }
        __syncthreads();
        for (int k = 0; k < 16; ++k) { const int i2 = wave * 16 + k, sl0 = MT[MT_LE + 256 + i2], sl1 = MT[MT_LE + 384 + i2]; const v4u sv = ((const v4u*)(H28 + (size_t)(bx * 128 + i2) * D))[lane];
            ((v4u*)(HP8 + (size_t)sl0 * D))[lane] = sv; ((v4u*)(HP8 + (size_t)sl1 * D))[lane] = sv; }
        for (int j = 0; j < 16; ++j) { const int tot = MT[MT_TOT + j], pad = (tot + 255) & ~255, off = (j >> 3) * (MAXT * 256) + MT[MT_OFFS + j];
            for (int s2 = tot + gw; s2 < pad; s2 += NGW) { v4u* dst = (v4u*)(HP8 + (size_t)(off + s2) * D) + lane; dst[0] = (v4u){0u, 0u, 0u, 0u}; } }
        if (bx == 0) { for (int j = 0; j < 16; ++j) { const int tot = MT[MT_TOT + j], pad = (tot + 255) & ~255, off = MT[MT_OFFS + j]; for (int s = tot + tid; s < pad; s += NTHR) { TOK[(j >> 3) * (MAXT * 256) + off + s] = -1; WTS[(j >> 3) * (MAXT * 256) + off + s] = 0.f; } } }
        SEAM(16);
    }
    if (IN(18)) { PHASE_VARS
        if (lo == 18) moe_tables(HIST, lds, tid);
        const int nT0 = MT[MT_NT], nT1 = MT[MT_NT + 1];
        pg8::Gemm g{(const bf16*)HP8, (const bf16*)MWGU8, (nT0 + nT1) * 256, 2 * DFE, D / 2}; pg8::MoeOrder S; S.so.init((nT0 + nT1) * 256, 2 * DFE, G, bx); S.tileExp = (const LAS int*)(MT + MT_TEXP); S.nT0 = nT0; S.jump = MAXT - nT0;
        pg8::EpiSwiglu8 E{ACT8, DFE, 2 * DFE / 256, 1.0f / (F8_SX * F8_SW1), F8_SACT};
        for (int rep_ = 0; rep_ < R_MGU; ++rep_) pg8::gemm_phase<pg8::EpiSwiglu8, pg8::MoeOrder, GP_ALIGN, GP_SP2, true>(lds, g, S, E, tid);
        SEAM(18);
    }
    if (IN(19)) { PHASE_VARS
        if (lo == 19) moe_tables(HIST, lds, tid);
        const int nT0 = MT[MT_NT], nT1 = MT[MT_NT + 1];
        pg8::Gemm g{(const bf16*)ACT8, (const bf16*)MWD8, (nT0 + nT1) * 256, D, DFE / 2}; pg8::MoeOrder S; S.so.init((nT0 + nT1) * 256, D, G, bx); S.tileExp = (const LAS int*)(MT + MT_TEXP); S.nT0 = nT0; S.jump = MAXT - nT0;
        pg8::EpiMoeDown E{xres, TOK, WTS, 1.0f / (F8_SACT * F8_SW2), X2B, MAXT};
        pg8::gemm_phase<pg8::EpiMoeDown, pg8::MoeOrder, GP_ALIGN, GP_SP2, true>(lds, g, S, E, tid);
        SEAM(19);
    }
    if (IN(22)) { PHASE_VARS
        for (int m = gw; m < NT; m += 2 * NGW) {
            const int mm[2] = {m, m + NGW};
            f32x4 v[2][4]; float sq[2] = {0.f, 0.f};
#pragma unroll
            for (int r = 0; r < 2; ++r) {
                const v2u* xb = (const v2u*)(xres + (size_t)mm[r] * XP) + lane; const v2u* x2 = (const v2u*)(X2B + (size_t)mm[r] * D) + lane;
#pragma unroll
                for (int j = 0; j < 4; ++j) { const v2u rr = xb[64 * j], q = x2[64 * j];
                    v[r][j] = (f32x4){__uint_as_float(rr.x << 16) + __uint_as_float(q.x << 16), __uint_as_float(rr.x & 0xffff0000u) + __uint_as_float(q.x & 0xffff0000u), __uint_as_float(rr.y << 16) + __uint_as_float(q.y << 16), __uint_as_float(rr.y & 0xffff0000u) + __uint_as_float(q.y & 0xffff0000u)}; }
            }
#pragma unroll
            for (int r = 0; r < 2; ++r)
#pragma unroll
                for (int j = 0; j < 4; ++j) sq[r] += (v[r][j].x * v[r][j].x + v[r][j].y * v[r][j].y) + (v[r][j].z * v[r][j].z + v[r][j].w * v[r][j].w);
#pragma unroll
            for (int o = 1; o < 64; o <<= 1) { sq[0] += __shfl_xor(sq[0], o); sq[1] += __shfl_xor(sq[1], o); }
            const f32x4* gr = (const f32x4*)args.in[32] + lane;
#pragma unroll
            for (int r = 0; r < 2; ++r) { const float rs = 1.0f / sqrtf(sq[r] * (1.f / D) + RMS_EPS); f32x4* xr = (f32x4*)(args.out + (size_t)mm[r] * D) + lane;
#pragma unroll
                for (int j = 0; j < 4; ++j) xr[64 * j] = v[r][j] * rs * gr[64 * j]; }
        }
    }
#endif
#undef IN
#undef SEAM
}

__global__ void nan_fill(float* o, int n) { for (int i = blockIdx.x * blockDim.x + threadIdx.x; i < n; i += gridDim.x * blockDim.x) o[i] = __builtin_nanf(""); }


#ifdef MK_DUMP
__global__ void dump_k(int what, const unsigned char* ws, float* out) {
    for (size_t i = (size_t)blockIdx.x * blockDim.x + threadIdx.x; i < (size_t)NT * D; i += (size_t)gridDim.x * blockDim.x) {
        const size_t t = i / D; const int c = (int)(i % D); float v = 0.f;
        if (what == 1) v = bf2f(((const bf16*)(ws + WS_H))[i]);
        else if (what == 2) { const bf16* g = (const bf16*)(ws + WS_G) + t * 3072; v = bf2f(g[c]) + bf2f(g[c + 1024]) + bf2f(g[c + 2048]); }
        else if (what == 3) { if (c < W) for (int k = 0; k < 6; ++k) v += bf2f(((const bf16*)(ws + WS_P6))[(size_t)k * NT * W + t * W + c]); }
        else if (what == 4) { if (c < W) v = bf2f(((const bf16*)(ws + WS_Y5))[t * W + c]); }
        else if (what == 5) { if (c < W) v = bf2f(((const bf16*)(ws + WS_P6))[(size_t)1 * NT * W + t * W + c]); }
        else if (what == 6) { if (c < W) v = bf2f(((const bf16*)(ws + WS_P6))[(size_t)2 * NT * W + t * W + c]); }
        else if (what == 7) { if (c < W) v = bf2f(((const bf16*)(ws + WS_P6))[(size_t)0 * NT * W + t * W + c]); }
        else if (what == 9) { const bf16* o = (const bf16*)(ws + WS_P6) + t * INW; for (int k = 0; k < 5; ++k) v += bf2f(o[c + 1024 * k]); }
        else if (what == 8) v = bf2f(((const bf16*)(ws + WS_W + W_IN))[i % ((size_t)2 * INW * D)]);
        out[i] = v;
    }
}
#endif
#ifndef MK_PER_PHASE
#define MK_PER_PHASE 1
#endif
extern "C" void kernel_launch(void* const* d_in, const int* in_sizes, int n_in, void* d_out, int out_size, void* d_ws, size_t ws_size, hipStream_t stream) {
    static int grid = 0;
    if (grid == 0) {
        int dev = 0, cus = 0;
        if (n_in != 33 || out_size != NT * D || ws_size < WS_NEED || hipGetDevice(&dev) != hipSuccess || hipDeviceGetAttribute(&cus, hipDeviceAttributeMultiprocessorCount, dev) != hipSuccess ||
            hipFuncSetAttribute((const void*)hybrid_fwd, hipFuncAttributeMaxDynamicSharedMemorySize, LDS_BYTES) != hipSuccess) { fprintf(stderr, "kernel_launch: bad configuration (n_in %d out %d ws %zu)\n", n_in, out_size, ws_size); grid = -1; }
        else grid = cus;
    }
    if (grid < 0) { nan_fill<<<256, 256, 0, stream>>>((float*)d_out, out_size); return; }
    (void)hipMemsetAsync((char*)d_ws + WS_CTL, 0, CTL_ZERO_BYTES, stream);
#ifdef MK_ZERO_G
    (void)hipMemsetAsync((char*)d_ws + WS_G, 0, (size_t)NT * 3072 * 2, stream);
#endif
    Args a{};
    for (int i = 0; i < 33; ++i) a.in[i] = (const float*)d_in[i];
    a.out = (float*)d_out; a.ws = (unsigned char*)d_ws;
#if MK_PER_PHASE
#ifdef MK_FUSE01
    a.ph_lo = 0; a.ph_hi = MK_STOP; hipLaunchKernelGGL(hybrid_fwd, dim3(grid), dim3(NTHR), LDS_BYTES, stream, a);
#else
    for (int ph = 0; ph < MK_STOP; ++ph) { a.ph_lo = ph; a.ph_hi = ph + 1; hipLaunchKernelGGL(hybrid_fwd, dim3(grid), dim3(NTHR), LDS_BYTES, stream, a); }
#endif
#ifdef MK_DUMP
    dump_k<<<2048, 256, 0, stream>>>(MK_DUMP, (const unsigned char*)d_ws, (float*)d_out);
#endif
#else
#ifdef MK_EXPMIX
    a.ph_lo = 0; a.ph_hi = 3; a.li = 1; a.pad = MK_EXPMIX; hipLaunchKernelGGL(hybrid_fwd, dim3(grid), dim3(NTHR), LDS_BYTES, stream, a); a.pad = 0;
#endif
#ifdef MK_EXP15
    a.ph_lo = 15; a.ph_hi = 16; a.li = 1; a.pad = MK_EXP15; hipLaunchKernelGGL(hybrid_fwd, dim3(grid), dim3(NTHR), LDS_BYTES, stream, a); a.pad = 0;
#endif
#ifdef MK_PROF_K
    a.ph_lo = 0; a.ph_hi = MK_PROF_K; a.li = 1; hipLaunchKernelGGL(hybrid_fwd, dim3(grid), dim3(NTHR), LDS_BYTES, stream, a);
#endif
    a.ph_lo = 0; a.ph_hi = N_PHASES; a.li = 0; hipLaunchKernelGGL(hybrid_fwd, dim3(grid), dim3(NTHR), LDS_BYTES, stream, a);
#endif
}
```
